# Optimizing an MI355X kernel written in HIP

```python
import jax, jax.numpy as jnp
from jax import lax
import numpy as np

D_MODEL = 1024
BATCH = 4
SEQ = 8192
DEPTH = 2

RMS_EPS = 1e-6
LN_EPS = 1e-5
N_EVEN = (DEPTH + 1) // 2
N_ODD = DEPTH // 2

GLA_WIDTH = D_MODEL // 2
GLA_HEADS = 4
GLA_DK = GLA_WIDTH // 2 // GLA_HEADS
GLA_DV = GLA_WIDTH // GLA_HEADS
GLA_KEY = GLA_HEADS * GLA_DK
GLA_GATE_RANK = 16
GLA_TAU = 16.0
GLA_CHUNK = 64
SGU_WIDTH = D_MODEL - GLA_WIDTH
SGU_GROUPS = 4
SGU_GROUP_DIM = SGU_WIDTH // SGU_GROUPS
SGU_CHUNK = 128
EVEN_SPLITS = (GLA_KEY, GLA_KEY, GLA_WIDTH, GLA_WIDTH, GLA_GATE_RANK, SGU_WIDTH, SGU_WIDTH)
EVEN_IN = sum(EVEN_SPLITS)

RWKV_WIDTH = D_MODEL // 2
RWKV_HEAD = 64
RWKV_HEADS = RWKV_WIDTH // RWKV_HEAD
RWKV_DECAY_RANK = 32
RWKV_AAA_RANK = 32
RWKV_GATE_RANK = 96
RWKV_GN_EPS = 64e-5
RWKV_SPLITS = (RWKV_WIDTH, RWKV_WIDTH, RWKV_WIDTH, RWKV_DECAY_RANK, RWKV_AAA_RANK, RWKV_GATE_RANK)
RWKV_IN = sum(RWKV_SPLITS)
CONV_WIDTH = D_MODEL - RWKV_WIDTH
CONV_KERNEL = 31
ODD_IN = RWKV_IN + 2 * CONV_WIDTH

D_FF = 4 * D_MODEL

kernel_name = "hybrid_gla_sgu_rwkv7_conformer_trunk"


def _split(h, sizes):
    idx = [int(i) for i in np.cumsum(sizes)[:-1]]
    return jnp.split(h, idx, axis=-1)


def _rmsnorm(x, g):
    xf = x.astype(jnp.float32)
    y = xf * lax.rsqrt(jnp.mean(xf * xf, axis=-1, keepdims=True) + RMS_EPS)
    return (y * g.astype(jnp.float32)).astype(x.dtype)


def _layernorm(x, g, b, eps):
    mu = jnp.mean(x, axis=-1, keepdims=True)
    var = jnp.mean(jnp.square(x - mu), axis=-1, keepdims=True)
    return (x - mu) * lax.rsqrt(var + eps) * g.astype(jnp.float32) + b.astype(jnp.float32)


def _token_shift(x):
    return jnp.pad(x[:, :-1], ((0, 0), (1, 0), (0, 0)))


def _gla(q, k, v, g, alpha_lr, w_alpha2, b_alpha, gn_gain):
    B, T, _ = q.shape
    N = T // GLA_CHUNK
    log_a = jax.nn.log_sigmoid(alpha_lr @ w_alpha2.astype(jnp.float32) + b_alpha.astype(jnp.float32)) / GLA_TAU

    def heads(t, d):
        return t.reshape(B, N, GLA_CHUNK, GLA_HEADS, d).transpose(0, 3, 1, 2, 4)

    qh = heads(q, GLA_DK) * (GLA_DK ** -0.5)
    kh = heads(k, GLA_DK)
    vh = heads(v, GLA_DV)
    b = jnp.cumsum(heads(log_a, GLA_DK), axis=3)
    b_last = b[:, :, :, -1:, :]
    q_dec = qh * jnp.exp(b)
    k_dec = kh * jnp.exp(-b)
    k_state = kh * jnp.exp(b_last - b)
    mask = jnp.tril(jnp.ones((GLA_CHUNK, GLA_CHUNK), dtype=bool))
    att = jnp.where(mask, jnp.einsum('bhncd,bhnsd->bhncs', q_dec, k_dec), 0.0)
    o_intra = jnp.einsum('bhncs,bhnsv->bhncv', att, vh)

    def step(S, inp):
        qd, ks, vv, dl = inp
        o = jnp.einsum('bhcd,bhdv->bhcv', qd, S)
        S = S * dl[..., None] + jnp.einsum('bhcd,bhcv->bhdv', ks, vv)
        return S, o

    xs = (jnp.moveaxis(q_dec, 2, 0), jnp.moveaxis(k_state, 2, 0), jnp.moveaxis(vh, 2, 0),
          jnp.moveaxis(jnp.exp(b_last[:, :, :, 0, :]), 2, 0))
    S0 = jnp.zeros((B, GLA_HEADS, GLA_DK, GLA_DV), jnp.float32)
    _, o_inter = lax.scan(step, S0, xs)
    o = o_intra + jnp.moveaxis(o_inter, 0, 2)
    o = o * lax.rsqrt(jnp.mean(o * o, axis=-1, keepdims=True) + RMS_EPS)
    o = o.transpose(0, 2, 3, 1, 4).reshape(B, T, GLA_WIDTH) * gn_gain.astype(jnp.float32)
    return o * jax.nn.silu(g)


def _sgu(u, sv, ln_g, ln_b, w_s, b_s):
    B, T, _ = u.shape
    N = T // SGU_CHUNK
    u = jax.nn.gelu(u)
    sv = _layernorm(jax.nn.gelu(sv), ln_g, ln_b, LN_EPS)
    vh = sv.reshape(B, N, SGU_CHUNK, SGU_GROUPS, SGU_GROUP_DIM)
    mask = jnp.tril(jnp.ones((SGU_CHUNK, SGU_CHUNK), dtype=bool))
    w = jnp.where(mask[None], w_s.astype(jnp.float32), 0.0)
    s = jnp.einsum('gts,bnsgc->bntgc', w, vh) + b_s.astype(jnp.float32).T[:, :, None]
    return u * s.reshape(B, T, SGU_WIDTH)


def _rwkv7_scan(r, w, k, v, kk, a):
    B, T, H, N = r.shape

    def step(S, inp):
        r_t, w_t, k_t, v_t, kk_t, a_t = inp
        sa = -jnp.einsum('bhvk,bhk->bhv', S, kk_t)
        S = (S * w_t[:, :, None, :] + sa[..., None] * (kk_t * a_t)[:, :, None, :]
             + v_t[..., None] * k_t[:, :, None, :])
        return S, jnp.einsum('bhvk,bhk->bhv', S, r_t)

    xs = tuple(jnp.moveaxis(t, 1, 0) for t in (r, w, k, v, kk, a))
    _, y = lax.scan(step, jnp.zeros((B, H, N, N), jnp.float32), xs)
    return jnp.moveaxis(y, 0, 1)


def _rwkv7(h, mu, w0, w2, a0, a2, g2, k_k, k_a, r_k, gn_g, gn_b):
    B, T, _ = h.shape
    f32 = jnp.float32
    h = h + (_token_shift(h) - h) * mu.astype(f32)
    r, k, v, xw, xa, xg = _split(h, RWKV_SPLITS)
    wlog = -jax.nn.softplus(-(w0.astype(f32) + jnp.tanh(xw) @ w2.astype(f32))) - 0.5
    decay = jnp.exp(-jnp.exp(wlog))
    a = jax.nn.sigmoid(a0.astype(f32) + xa @ a2.astype(f32))
    g = jax.nn.sigmoid(xg) @ g2.astype(f32)
    hd = lambda t: t.reshape(B, T, RWKV_HEADS, RWKV_HEAD)
    kk = hd(k * k_k.astype(f32))
    kk = kk / jnp.maximum(jnp.sqrt(jnp.sum(kk * kk, axis=-1, keepdims=True)), 1e-12)
    k = k * (1.0 + (a - 1.0) * k_a.astype(f32))
    rh, kh, vh = hd(r), hd(k), hd(v)
    y = _rwkv7_scan(rh, hd(decay), kh, vh, kk, hd(a))
    mu_y = jnp.mean(y, axis=-1, keepdims=True)
    var_y = jnp.mean(jnp.square(y - mu_y), axis=-1, keepdims=True)
    y = ((y - mu_y) * lax.rsqrt(var_y + RWKV_GN_EPS)).reshape(B, T, RWKV_WIDTH)
    y = y * gn_g.astype(f32) + gn_b.astype(f32)
    bonus = jnp.sum(rh * kh * r_k.astype(f32), axis=-1, keepdims=True) * vh
    y = y + bonus.reshape(B, T, RWKV_WIDTH)
    return y * g


def _conformer_conv(h, conv_w, conv_b, ln_g, ln_b):
    a, gate = _split(h, (CONV_WIDTH, CONV_WIDTH))
    z = a * jax.nn.sigmoid(gate)
    z = jnp.pad(z, ((0, 0), (CONV_KERNEL - 1, 0), (0, 0)))
    y = lax.conv_general_dilated(z, conv_w.astype(jnp.float32)[:, None, :], window_strides=(1,),
                                 padding='VALID', dimension_numbers=('NWC', 'WIO', 'NWC'),
                                 feature_group_count=CONV_WIDTH)
    y = y + conv_b.astype(jnp.float32)
    return jax.nn.silu(_layernorm(y, ln_g, ln_b, LN_EPS))


def setup_inputs(seed: int = 0) -> dict:
    key = jax.random.key(seed)
    keys = jax.random.split(key, 40)
    f32 = jnp.float32
    D = D_MODEL

    def nrm(i, shape, scale):
        return scale * jax.random.normal(keys[i], shape, f32)

    def gain(i, shape):
        return 1.0 + nrm(i, shape, 0.05)

    w0_ramp = jnp.linspace(-6.5, -1.5, RWKV_WIDTH, dtype=f32)
    return {
        "x": nrm(0, (BATCH, SEQ, D), 1.0),
        "norm_mix": gain(1, (DEPTH, D)),
        "norm_ffn": gain(2, (DEPTH, D)),
        "w_up": nrm(3, (DEPTH, D, D_FF), D ** -0.5),
        "w_down": nrm(4, (DEPTH, D_FF, D), D_FF ** -0.5),
        "norm_final": gain(5, (D,)),
        "even_w_in": nrm(6, (N_EVEN, D, EVEN_IN), D ** -0.5),
        "even_w_out": nrm(7, (N_EVEN, D, D), D ** -0.5),
        "gla_w_alpha2": nrm(8, (N_EVEN, GLA_GATE_RANK, GLA_KEY), GLA_GATE_RANK ** -0.5),
        "gla_b_alpha": nrm(9, (N_EVEN, GLA_KEY), 0.5),
        "gla_norm": gain(10, (N_EVEN, GLA_WIDTH)),
        "sgu_ln_g": gain(11, (N_EVEN, SGU_WIDTH)),
        "sgu_ln_b": nrm(12, (N_EVEN, SGU_WIDTH), 0.02),
        "sgu_w": nrm(13, (N_EVEN, SGU_GROUPS, SGU_CHUNK, SGU_CHUNK), SGU_CHUNK ** -0.5),
        "sgu_b": gain(14, (N_EVEN, SGU_GROUPS, SGU_CHUNK)),
        "odd_w_in": nrm(15, (N_ODD, D, ODD_IN), D ** -0.5),
        "odd_w_out": nrm(16, (N_ODD, D, D), D ** -0.5),
        "rwkv_mu": jax.random.uniform(keys[17], (N_ODD, RWKV_IN), f32),
        "rwkv_w0": w0_ramp[None, :] + nrm(18, (N_ODD, RWKV_WIDTH), 0.1),
        "rwkv_w2": nrm(19, (N_ODD, RWKV_DECAY_RANK, RWKV_WIDTH), 0.5 * RWKV_DECAY_RANK ** -0.5),
        "rwkv_a0": nrm(20, (N_ODD, RWKV_WIDTH), 0.1),
        "rwkv_a2": nrm(21, (N_ODD, RWKV_AAA_RANK, RWKV_WIDTH), RWKV_AAA_RANK ** -0.5),
        "rwkv_g2": nrm(22, (N_ODD, RWKV_GATE_RANK, RWKV_WIDTH), RWKV_GATE_RANK ** -0.5),
        "rwkv_k_k": 0.85 + nrm(23, (N_ODD, RWKV_WIDTH), 0.05),
        "rwkv_k_a": gain(24, (N_ODD, RWKV_WIDTH)),
        "rwkv_r_k": nrm(25, (N_ODD, RWKV_HEADS, RWKV_HEAD), 0.1),
        "rwkv_gn_g": gain(26, (N_ODD, RWKV_WIDTH)),
        "rwkv_gn_b": nrm(27, (N_ODD, RWKV_WIDTH), 0.02),
        "conv_w": nrm(28, (N_ODD, CONV_KERNEL, CONV_WIDTH), CONV_KERNEL ** -0.5),
        "conv_b": nrm(29, (N_ODD, CONV_WIDTH), 0.02),
        "conv_ln_g": gain(30, (N_ODD, CONV_WIDTH)),
        "conv_ln_b": nrm(31, (N_ODD, CONV_WIDTH), 0.02),
    }


def reference(x, norm_mix, norm_ffn, w_up, w_down, norm_final, even_w_in, even_w_out,
              gla_w_alpha2, gla_b_alpha, gla_norm, sgu_ln_g, sgu_ln_b, sgu_w, sgu_b,
              odd_w_in, odd_w_out, rwkv_mu, rwkv_w0, rwkv_w2, rwkv_a0, rwkv_a2, rwkv_g2,
              rwkv_k_k, rwkv_k_a, rwkv_r_k, rwkv_gn_g, rwkv_gn_b, conv_w, conv_b,
              conv_ln_g, conv_ln_b):
    for layer in range(DEPTH):
        j = layer // 2
        h = _rmsnorm(x, norm_mix[layer])
        if layer % 2 == 0:
            p = (h @ even_w_in[j]).astype(jnp.float32)
            q, k, v, g, alr, u, sv = _split(p, EVEN_SPLITS)
            o_a = _gla(q, k, v, g, alr, gla_w_alpha2[j], gla_b_alpha[j], gla_norm[j])
            o_b = _sgu(u, sv, sgu_ln_g[j], sgu_ln_b[j], sgu_w[j], sgu_b[j])
            m = jnp.concatenate([o_a, o_b], axis=-1).astype(x.dtype)
            x = x + m @ even_w_out[j]
        else:
            p = (h @ odd_w_in[j]).astype(jnp.float32)
            o_c = _rwkv7(p[..., :RWKV_IN], rwkv_mu[j], rwkv_w0[j], rwkv_w2[j], rwkv_a0[j],
                         rwkv_a2[j], rwkv_g2[j], rwkv_k_k[j], rwkv_k_a[j], rwkv_r_k[j],
                         rwkv_gn_g[j], rwkv_gn_b[j])
            o_d = _conformer_conv(p[..., RWKV_IN:], conv_w[j], conv_b[j], conv_ln_g[j], conv_ln_b[j])
            m = jnp.concatenate([o_c, o_d], axis=-1).astype(x.dtype)
            x = x + m @ odd_w_out[j]
        f = jnp.square(jax.nn.relu(_rmsnorm(x, norm_ffn[layer]) @ w_up[layer]))
        x = x + f @ w_down[layer]
    return _rmsnorm(x, norm_final)
```

```cpp
#include <hip/hip_runtime.h>
#include <hip/hip_cooperative_groups.h>
#include <cstdio>
#include <cstdint>
namespace cg = cooperative_groups;

#ifndef ONE_LAUNCH
#define ONE_LAUNCH 0
#endif

#ifndef PH_MASK
#define PH_MASK 0xFFFF
#endif
#define PHK(b) (((PH_MASK) >> (b)) & 1)
#define LAS __attribute__((address_space(3)))
typedef unsigned short bf16_t;
typedef short bf16x8 __attribute__((ext_vector_type(8)));
typedef float f32x4 __attribute__((ext_vector_type(4)));
typedef float f32x2 __attribute__((ext_vector_type(2)));
typedef float f32x16 __attribute__((ext_vector_type(16)));
typedef unsigned u32x4 __attribute__((ext_vector_type(4)));
typedef unsigned u32x2 __attribute__((ext_vector_type(2)));
typedef LAS float lfloat;

constexpr int BATCH = 4, SEQ = 8192, D = 1024, FF = 4096;
constexpr int M = BATCH * SEQ;
constexpr int NP = 2816;
constexpr float RMS_EPS = 1e-6f, LN_EPS = 1e-5f, GN_EPS = 64e-5f;
constexpr int EC_Q = 0, EC_K = 256, EC_V = 512, EC_G = 1024, EC_U = 1536, EC_SV = 2048, EC_ALR = 2560;
constexpr int OC_R = 0, OC_K = 512, OC_V = 1024, OC_CA = 1536, OC_CG = 2048, OC_XW = 2560, OC_XA = 2592, OC_XG = 2624;

constexpr size_t MiB = 1u << 20;
constexpr size_t WS_WIN0 = 2 * MiB, WS_WOUT0 = 8 * MiB, WS_WUP0 = 10 * MiB, WS_WDN0 = 18 * MiB;
constexpr size_t WS_WIN1 = 26 * MiB, WS_WOUT1 = 32 * MiB, WS_WUP1 = 34 * MiB, WS_WDN1 = 42 * MiB;
constexpr size_t WS_TAB = 1 * MiB;
constexpr size_t TAB_W2T = 0, TAB_A2T = 65536, TAB_G2T = 131072, TAB_CWT = 327680, TAB_GA2T = 393216;
constexpr size_t WS_SSP = 50 * MiB;
constexpr size_t WS_XN = 52 * MiB;
constexpr size_t WS_MIX = 116 * MiB;
constexpr size_t WS_P = 180 * MiB;
constexpr size_t WS_H = 180 * MiB;
constexpr size_t WS_FREE = 436 * MiB;
constexpr size_t WS_END = 512 * MiB;
constexpr size_t WS_GLA_ST = WS_XN;
constexpr size_t WS_GLA_DL = WS_FREE;
constexpr size_t WS_R_KP = WS_XN, WS_R_KK = WS_XN + 32 * MiB;
constexpr size_t WS_R_BB = 356 * MiB, WS_R_LD = 388 * MiB, WS_R_Y = 420 * MiB;
static_assert(WS_P + (size_t)M * NP * 2 <= WS_R_BB, "P vs rwkv scratch");
static_assert(WS_R_Y + (size_t)M * 512 * 2 <= WS_END, "ws map");

constexpr int NWAVES = 8, NTHREADS = 512;
constexpr int LDS_BYTES = 147456;

__device__ __forceinline__ float bf2f(unsigned v) { return __uint_as_float(v << 16); }
__device__ __forceinline__ unsigned f2bf(float f) { unsigned u = __float_as_uint(f); return (u + 0x7fffu + ((u >> 16) & 1u)) >> 16; }
__device__ __forceinline__ unsigned pk2(float lo, float hi) { return f2bf(lo) | (f2bf(hi) << 16); }
__device__ __forceinline__ float sigmoidf_(float x) { return 1.0f / (1.0f + __expf(-x)); }
__device__ __forceinline__ float siluf_(float x) { return x * sigmoidf_(x); }
__device__ __forceinline__ float geluf_(float x) { const float u = 1.5957691216057308f * (x + 0.044715f * x * x * x); return x * sigmoidf_(u); }
__device__ __forceinline__ float logsigmoidf_(float z) { return fminf(z, 0.f) - __logf(1.0f + __expf(-fabsf(z))); }
__device__ __forceinline__ float wave_sum(float v) {
#pragma unroll
    for (int o = 1; o < 64; o <<= 1) v += __shfl_xor(v, o);
    return v;
}
__device__ __forceinline__ void unpack8(const u32x4 w, float* f) {
    f[0] = bf2f(w.x & 0xffffu); f[1] = __uint_as_float(w.x & 0xffff0000u);
    f[2] = bf2f(w.y & 0xffffu); f[3] = __uint_as_float(w.y & 0xffff0000u);
    f[4] = bf2f(w.z & 0xffffu); f[5] = __uint_as_float(w.z & 0xffff0000u);
    f[6] = bf2f(w.w & 0xffffu); f[7] = __uint_as_float(w.w & 0xffff0000u);
}
__device__ __forceinline__ float ldbf(const bf16_t* p) { return bf2f((unsigned)*p); }

namespace pg8 {
#define PG8_LAS __attribute__((address_space(3)))
constexpr int BM = 256, BK = 64, HALF = 128, HTB = HALF * BK * 2, STAGE_BYTES = 8 * HTB, NXCD = 8, WGM = 8;
__host__ __device__ __forceinline__ int lds_byte(int r, int c) { const int st = (r >> 4) * 2 + (c >> 5), rr = r & 15, cc = c & 31, ob = rr * 64 + cc * 2; return st * 1024 + (ob ^ (((ob >> 9) & 1) << 5)); }
__host__ __device__ __forceinline__ void stage_rc(int b, int& R, int& C) { const int st = b / 1024, sb = b % 1024, swz = sb ^ (((sb >> 9) & 1) << 5); R = (st >> 1) * 16 + swz / 64; C = (st & 1) * 32 + (swz % 64) / 2; }
__host__ __device__ __forceinline__ int perm32(int rho) { const int n = rho >> 4, i = rho & 15; return 8 * (i >> 2) + 4 * n + (i & 3); }

struct Unit { int pm, pn; };
struct Gemm { const bf16_t* A; const bf16_t* Bt; int M, N, K; };
struct StaticOrder {
    int nM, nN, nwg, G, c;
    __host__ __device__ void init(int M_, int N_, int G_, int c_) { nM = M_ / BM; nN = N_ / BM; nwg = nM * nN; G = G_; c = c_; }
    __host__ __device__ bool next(int i, Unit& u) const {
        const long L = (long)i * G + c; if (L >= nwg) return false;
        int wgid = (int)L; { const int q = nwg / NXCD, r = nwg % NXCD, xcd = wgid % NXCD, off = wgid / NXCD; wgid = (xcd < r ? xcd * (q + 1) : r * (q + 1) + (xcd - r) * q) + off; }
        const int nig = WGM * nN, gid = wgid / nig, fm = gid * WGM, gsz = (nM - fm) < WGM ? (nM - fm) : WGM;
        u.pm = fm + ((wgid % nig) % gsz); u.pn = (wgid % nig) / gsz; return true;
    }
    __device__ __forceinline__ void a_ready(const Unit&) const {}
    __device__ __forceinline__ void done(const Unit&) const {}
};
__device__ __forceinline__ unsigned cvt_pk_bf16(float lo, float hi) { unsigned r; asm volatile("v_cvt_pk_bf16_f32 %0, %1, %2" : "=v"(r) : "v"(lo), "v"(hi)); return r; }

__device__ __forceinline__ float row_rstd(const float* ssp, int r) {
    const f32x4* p = (const f32x4*)(ssp + (size_t)r * 16);
    const f32x4 a = p[0], b = p[1], c = p[2], d = p[3];
    const float s = ((a[0] + a[1]) + (a[2] + a[3])) + ((b[0] + b[1]) + (b[2] + b[3])) + ((c[0] + c[1]) + (c[2] + c[3])) + ((d[0] + d[1]) + (d[2] + d[3]));
    return 1.0f / sqrtf(s * (1.0f / 1024.0f) + RMS_EPS);
}
template <int ACT> struct EpiProj {
    static constexpr bool PERM = true, AFTER_DRAIN = false;
    bf16_t* O; int ldc; const float* ssp;
    __device__ __forceinline__ void operator()(const f32x4 (&acc)[2][2][4][2], const Unit& u, int wr, int wc, int fr, int fq) const {
        const int row0 = u.pm * BM + wr * 64 + fr, col0 = u.pn * BM + wc * 32 + 8 * fq;
        float rs[2][4];
#pragma unroll
        for (int ai = 0; ai < 2; ++ai)
#pragma unroll
            for (int m = 0; m < 4; ++m) rs[ai][m] = row_rstd(ssp, row0 + ai * HALF + m * 16);
#pragma unroll
        for (int ai = 0; ai < 2; ++ai)
#pragma unroll
            for (int m = 0; m < 4; ++m) { bf16_t* rowp = O + (size_t)(row0 + ai * HALF + m * 16) * ldc + col0; const float sc = rs[ai][m];
#pragma unroll
                for (int bj = 0; bj < 2; ++bj) { f32x4 v0 = acc[ai][bj][m][0] * sc, v1 = acc[ai][bj][m][1] * sc;
                    if (ACT == 1) {
#pragma unroll
                        for (int e = 0; e < 4; ++e) { const float a = fmaxf(v0[e], 0.f), b = fmaxf(v1[e], 0.f); v0[e] = a * a; v1[e] = b * b; } }
                    u32x4 w; w.x = cvt_pk_bf16(v0[0], v0[1]); w.y = cvt_pk_bf16(v0[2], v0[3]); w.z = cvt_pk_bf16(v1[0], v1[1]); w.w = cvt_pk_bf16(v1[2], v1[3]);
                    *(u32x4*)(rowp + bj * HALF) = w; } }
    }
};
struct EpiRes {
    static constexpr bool PERM = false, AFTER_DRAIN = false;
    const float* base; float* out; bf16_t* xn; const float* gain; float* ssp;
    __device__ __forceinline__ void operator()(const f32x4 (&acc)[2][2][4][2], const Unit& u, int wr, int wc, int fr, int fq) const {
        const int row0 = u.pm * BM + wr * 64 + fr, col0 = u.pn * BM + wc * 32 + 4 * fq;
        f32x4 gv[2][2];
#pragma unroll
        for (int bj = 0; bj < 2; ++bj)
#pragma unroll
            for (int n = 0; n < 2; ++n) gv[bj][n] = xn ? *(const f32x4*)(gain + col0 + bj * HALF + n * 16) : (f32x4){0.f, 0.f, 0.f, 0.f};
#pragma unroll
        for (int ai = 0; ai < 2; ++ai)
#pragma unroll
            for (int m = 0; m < 4; ++m) { const int r = row0 + ai * HALF + m * 16; const size_t off = (size_t)r * D + col0; float ss = 0.f;
#pragma unroll
                for (int bj = 0; bj < 2; ++bj)
#pragma unroll
                    for (int n = 0; n < 2; ++n) { const f32x4 b = *(const f32x4*)(base + off + bj * HALF + n * 16); const f32x4 v = b + acc[ai][bj][m][n];
                        *(f32x4*)(out + off + bj * HALF + n * 16) = v; ss += (v[0] * v[0] + v[1] * v[1]) + (v[2] * v[2] + v[3] * v[3]);
                        if (xn) { const f32x4 g = v * gv[bj][n]; u32x2 w; w.x = cvt_pk_bf16(g[0], g[1]); w.y = cvt_pk_bf16(g[2], g[3]); *(u32x2*)(xn + off + bj * HALF + n * 16) = w; } }
                ss += __shfl_xor(ss, 16); ss += __shfl_xor(ss, 32);
                if (fq == 0) ssp[(size_t)r * 16 + u.pn * 4 + wc] = ss; }
    }
};

template <class Epi, class Sched, bool ALIGN_EPI = false, bool SP2 = false>
__device__ __forceinline__ void gemm_phase(PG8_LAS unsigned char* lds, const int tid, const Gemm g, const Sched& S, const Epi& E) {
    const int wid = __builtin_amdgcn_readfirstlane(tid >> 6), lane = tid & 63, wr = wid >> 2, wc = wid & 3, fr = lane & 15, fq = lane >> 4;
    const int K = g.K, nt = K / BK;
    unsigned voffA[2], voffB[2];
#pragma unroll
    for (int i = 0; i < 2; ++i) { int R, C; stage_rc(tid * 16 + i * 8192, R, C); const int Rb = Epi::PERM ? ((R & ~31) + perm32(R & 31)) : R;
        voffA[i] = (unsigned)(R * K + C) * 2u; voffB[i] = (unsigned)(Rb * K + C) * 2u; }
    const size_t kstep = (size_t)(BK * 2);
    const size_t hstep = (size_t)HALF * K * 2;
    const size_t tstep = 2 * hstep;
    const unsigned ldsw = (unsigned)wid * 1024u;
    const int aoff = lds_byte(wr * 64 + fr, fq * 8), boff = lds_byte(wc * 32 + fr, fq * 8);
#define PG8_SA(b, h) (((b) * 2 + (h)) * HTB)
#define PG8_SB(b, h) ((4 + (b) * 2 + (h)) * HTB)
#define PG8_STAGE(bufoff, gbase, voff) do { _Pragma("unroll") for (int _i = 0; _i < 2; ++_i) \
        __builtin_amdgcn_global_load_lds((const unsigned*)((const char*)(gbase) + (voff)[_i]), (PG8_LAS unsigned*)(lds + (bufoff) + ldsw + _i * 8192), 16, 0, 0); } while (0)
#define PG8_LDA(dst, b, h) do { _Pragma("unroll") for (int m = 0; m < 4; ++m) _Pragma("unroll") for (int k = 0; k < 2; ++k) dst[m][k] = *(const PG8_LAS bf16x8*)(lds + PG8_SA(b, h) + aoff + m * 2048 + k * 1024); } while (0)
#define PG8_LDB(dst, b, h) do { _Pragma("unroll") for (int n = 0; n < 2; ++n) _Pragma("unroll") for (int k = 0; k < 2; ++k) dst[n][k] = *(const PG8_LAS bf16x8*)(lds + PG8_SB(b, h) + boff + n * 2048 + k * 1024); } while (0)
#define PG8_MMA(ai, bj, At, Bt) do { __builtin_amdgcn_s_setprio(1); _Pragma("unroll") for (int m = 0; m < 4; ++m) _Pragma("unroll") for (int n = 0; n < 2; ++n) _Pragma("unroll") for (int k = 0; k < 2; ++k) \
        acc[ai][bj][m][n] = __builtin_amdgcn_mfma_f32_16x16x32_bf16(Bt[n][k], At[m][k], acc[ai][bj][m][n], 0, 0, 0); __builtin_amdgcn_s_setprio(0); } while (0)
#define PG8_WAIT_V(n) asm volatile("s_waitcnt vmcnt(" #n ")" ::: "memory")
#define PG8_WAIT_L(n) asm volatile("s_waitcnt lgkmcnt(" #n ")" ::: "memory")
#define PG8_BAR __builtin_amdgcn_s_barrier()
#define PG8_SCHED __builtin_amdgcn_sched_barrier(0)
    Unit cur, nxt; int ui = 0;
    if (!S.next(0, cur)) return;
    f32x4 acc[2][2][4][2];
#pragma unroll
    for (int a = 0; a < 2; ++a)
#pragma unroll
        for (int b = 0; b < 2; ++b)
#pragma unroll
            for (int m = 0; m < 4; ++m)
#pragma unroll
                for (int n = 0; n < 2; ++n) acc[a][b][m][n] = (f32x4){0.f, 0.f, 0.f, 0.f};
    bf16x8 At[4][2], B0[2][2], B1[2][2];
    const char* cA = (const char*)g.A + (size_t)cur.pm * tstep; const char* cB = (const char*)g.Bt + (size_t)cur.pn * tstep;
    S.a_ready(cur);
    if constexpr (SP2) {
        PG8_STAGE(PG8_SB(0, 0), cB, voffB); PG8_STAGE(PG8_SB(0, 1), cB + hstep, voffB); PG8_STAGE(PG8_SA(0, 0), cA, voffA); PG8_STAGE(PG8_SA(0, 1), cA + hstep, voffA);
        if (wr == 1) PG8_BAR;
        PG8_WAIT_V(2); PG8_BAR;
        PG8_STAGE(PG8_SB(1, 0), cB + kstep, voffB); PG8_STAGE(PG8_SA(1, 0), cA + kstep, voffA); PG8_STAGE(PG8_SB(1, 1), cB + hstep + kstep, voffB);
        PG8_WAIT_V(6); PG8_BAR;
    } else {
        PG8_STAGE(PG8_SB(0, 0), cB, voffB); PG8_STAGE(PG8_SA(0, 0), cA, voffA); PG8_STAGE(PG8_SB(0, 1), cB + hstep, voffB); PG8_STAGE(PG8_SA(0, 1), cA + hstep, voffA);
        if (wr == 1) PG8_BAR;
        PG8_WAIT_V(4); PG8_BAR;
        PG8_STAGE(PG8_SB(1, 0), cB + kstep, voffB); PG8_STAGE(PG8_SA(1, 0), cA + kstep, voffA); PG8_STAGE(PG8_SB(1, 1), cB + hstep + kstep, voffB);
        PG8_WAIT_V(6); PG8_BAR;
    }
    for (;;) {
        const bool has_next = S.next(ui + 1, nxt);
        const char* nA = has_next ? (const char*)g.A + (size_t)nxt.pm * tstep : cA; const char* nB = has_next ? (const char*)g.Bt + (size_t)nxt.pn * tstep : cB;
        for (int t = 0; t < nt; t += 2) {
            const bool last = (t == nt - 2);
            const char* a1 = cA + (size_t)(t + 1) * kstep;
            const char* a2 = last ? nA : cA + (size_t)(t + 2) * kstep; const char* b2 = last ? nB : cB + (size_t)(t + 2) * kstep;
            const char* a3 = a2 + kstep; const char* b3 = b2 + kstep;
            if (last && has_next) S.a_ready(nxt);
            if constexpr (SP2) {
            PG8_LDB(B0, 0, 0); PG8_LDB(B1, 0, 1); PG8_SCHED; PG8_LDA(At, 0, 0); PG8_STAGE(PG8_SA(1, 1), a1 + hstep, voffA);
            PG8_WAIT_V(8); PG8_WAIT_L(0); PG8_BAR; PG8_MMA(0, 0, At, B0); PG8_MMA(0, 1, At, B1); PG8_BAR; PG8_SCHED;
            PG8_LDA(At, 0, 1); PG8_STAGE(PG8_SB(0, 0), b2, voffB); PG8_STAGE(PG8_SB(0, 1), b2 + hstep, voffB); PG8_STAGE(PG8_SA(0, 0), a2, voffA);
            PG8_WAIT_V(8); PG8_WAIT_L(0); PG8_BAR; PG8_MMA(1, 0, At, B0); PG8_MMA(1, 1, At, B1); PG8_BAR; PG8_SCHED;
            PG8_LDB(B0, 1, 0); PG8_LDB(B1, 1, 1); PG8_SCHED; PG8_LDA(At, 1, 0); PG8_STAGE(PG8_SA(0, 1), a2 + hstep, voffA);
            PG8_WAIT_V(8); PG8_WAIT_L(0); PG8_BAR; PG8_MMA(0, 0, At, B0); PG8_MMA(0, 1, At, B1); PG8_BAR; PG8_SCHED;
            PG8_LDA(At, 1, 1); PG8_STAGE(PG8_SB(1, 0), b3, voffB); PG8_STAGE(PG8_SB(1, 1), b3 + hstep, voffB); PG8_STAGE(PG8_SA(1, 0), a3, voffA);
            PG8_WAIT_V(8); PG8_WAIT_L(0); PG8_BAR; PG8_MMA(1, 0, At, B0); PG8_MMA(1, 1, At, B1); PG8_BAR; PG8_SCHED;
            } else {
            PG8_LDB(B0, 0, 0); PG8_SCHED; PG8_LDA(At, 0, 0); PG8_STAGE(PG8_SA(1, 1), a1 + hstep, voffA);
            PG8_WAIT_L(8); PG8_BAR; PG8_WAIT_L(0); PG8_MMA(0, 0, At, B0); PG8_BAR; PG8_SCHED;
            PG8_LDB(B1, 0, 1); PG8_STAGE(PG8_SB(0, 0), b2, voffB);
            PG8_BAR; PG8_WAIT_L(0); PG8_MMA(0, 1, At, B1); PG8_BAR;
            PG8_LDA(At, 0, 1); PG8_STAGE(PG8_SA(0, 0), a2, voffA);
            PG8_BAR; PG8_WAIT_L(0); PG8_MMA(1, 0, At, B0); PG8_BAR; PG8_SCHED;
            PG8_STAGE(PG8_SB(0, 1), b2 + hstep, voffB);
            PG8_WAIT_V(6); PG8_BAR; PG8_MMA(1, 1, At, B1); PG8_BAR;
            PG8_LDB(B0, 1, 0); PG8_SCHED; PG8_LDA(At, 1, 0); PG8_STAGE(PG8_SA(0, 1), a2 + hstep, voffA);
            PG8_WAIT_L(8); PG8_BAR; PG8_WAIT_L(0); PG8_MMA(0, 0, At, B0); PG8_BAR; PG8_SCHED;
            PG8_LDB(B1, 1, 1); PG8_STAGE(PG8_SB(1, 0), b3, voffB);
            PG8_BAR; PG8_WAIT_L(0); PG8_MMA(0, 1, At, B1); PG8_BAR;
            PG8_LDA(At, 1, 1); PG8_STAGE(PG8_SA(1, 0), a3, voffA);
            PG8_BAR; PG8_WAIT_L(0); PG8_MMA(1, 0, At, B0); PG8_BAR; PG8_SCHED;
            PG8_STAGE(PG8_SB(1, 1), b3 + hstep, voffB);
            PG8_WAIT_V(6); PG8_BAR; PG8_MMA(1, 1, At, B1); PG8_BAR;
            }
        }
        if constexpr (ALIGN_EPI) { if (wr == 0) PG8_BAR; }
        if constexpr (!Epi::AFTER_DRAIN) { E(acc, cur, wr, wc, fr, fq); S.done(cur); }
        if (!has_next) break;
#pragma unroll
        for (int a = 0; a < 2; ++a)
#pragma unroll
            for (int b = 0; b < 2; ++b)
#pragma unroll
                for (int m = 0; m < 4; ++m)
#pragma unroll
                    for (int n = 0; n < 2; ++n) acc[a][b][m][n] = (f32x4){0.f, 0.f, 0.f, 0.f};
        cur = nxt; cA = nA; cB = nB; ++ui;
        if constexpr (ALIGN_EPI) { if (wr == 1) PG8_BAR; }
    }
    PG8_WAIT_V(0);
    if constexpr (!ALIGN_EPI) { if (wr == 0) PG8_BAR; }
    PG8_BAR;
#undef PG8_SA
#undef PG8_SB
#undef PG8_STAGE
#undef PG8_LDA
#undef PG8_LDB
#undef PG8_MMA
#undef PG8_WAIT_V
#undef PG8_WAIT_L
#undef PG8_BAR
#undef PG8_SCHED
}
}

struct Args { const float* in[32]; float* out; unsigned char* ws; int ph_lo, ph_hi; };
enum { I_X = 0, I_NORM_MIX, I_NORM_FFN, I_W_UP, I_W_DOWN, I_NORM_FINAL, I_EVEN_W_IN, I_EVEN_W_OUT, I_GLA_W_ALPHA2, I_GLA_B_ALPHA, I_GLA_NORM,
       I_SGU_LN_G, I_SGU_LN_B, I_SGU_W, I_SGU_B, I_ODD_W_IN, I_ODD_W_OUT, I_RWKV_MU, I_RWKV_W0, I_RWKV_W2, I_RWKV_A0, I_RWKV_A2, I_RWKV_G2,
       I_RWKV_K_K, I_RWKV_K_A, I_RWKV_R_K, I_RWKV_GN_G, I_RWKV_GN_B, I_CONV_W, I_CONV_B, I_CONV_LN_G, I_CONV_LN_B };

struct Ctx { LAS unsigned char* lds; int tid, lane, wave, bid, nblk; };
__device__ __forceinline__ Ctx mk_ctx(LAS unsigned char* lds) { Ctx C; C.lds = lds; int t = threadIdx.x, b = blockIdx.x, g = gridDim.x; asm volatile("" : "+v"(t), "+s"(b), "+s"(g));
    C.tid = t; C.lane = t & 63; C.wave = __builtin_amdgcn_readfirstlane(t >> 6); C.bid = b; C.nblk = g; return C; }
typedef __attribute__((address_space(4))) const Args CArgs;
__device__ __forceinline__ CArgs* get_args() { CArgs* p = (CArgs*)__builtin_amdgcn_kernarg_segment_ptr(); asm volatile("" : "+s"(p)); return p; }

template <int MODE> __device__ __forceinline__ int colmap(int n) {
    if (MODE == 0) return n;
    if (MODE == 1) return n < 1536 ? n : (n < 2560 ? n + 16 : (n < 2576 ? n - 1024 : -1));
    return n < 1536 ? n : (n < 2560 ? n + 160 : (n < 2720 ? n - 1024 : -1));
}
template <int MODE> __device__ __forceinline__ void p0_transpose_item(const float* W, int K, int Nsrc, int Ndst, bf16_t* WT, LAS float* scr, int item, int lane) {
    const int nblk = Ndst / 32, kb = item / nblk, nb = item % nblk, k0 = 64 * kb, n0 = 32 * nb;
    const int src = colmap<MODE>(n0 + (lane & 31));
#pragma unroll 8
    for (int i = 0; i < 32; ++i) { const int kk = 2 * i + (lane >> 5); scr[kk * 33 + (lane & 31)] = src >= 0 ? W[(size_t)(k0 + kk) * Nsrc + src] : 0.f; }
    asm volatile("s_waitcnt lgkmcnt(0)" ::: "memory");
    const int c = lane & 7;
#pragma unroll
    for (int j = 0; j < 4; ++j) { const int n = (lane >> 3) + 8 * j; const LAS float* s = scr + (8 * c) * 33 + n;
        u32x4 o; o.x = pk2(s[0 * 33], s[1 * 33]); o.y = pk2(s[2 * 33], s[3 * 33]); o.z = pk2(s[4 * 33], s[5 * 33]); o.w = pk2(s[6 * 33], s[7 * 33]);
        *(u32x4*)(WT + (size_t)(n0 + n) * K + k0 + 8 * c) = o; }
    asm volatile("s_waitcnt lgkmcnt(0)" ::: "memory");
}
__device__ __forceinline__ void p0_prologue(const Ctx& C, CArgs& a) {
    LAS float* scr = (LAS float*)(C.lds + C.wave * 16384);
    const int gw = C.bid * NWAVES + C.wave, NGW = C.nblk * NWAVES;
    unsigned char* ws = a.ws;
    constexpr int I_IN = (D / 64) * (NP / 32), I_OUT = (D / 64) * (D / 32), I_UP = (D / 64) * (FF / 32), I_DN = (FF / 64) * (D / 32);
    constexpr int PER_LAYER = I_IN + I_OUT + I_UP + I_DN;
    for (int it = gw; it < 2 * PER_LAYER; it += NGW) {
        const int layer = it / PER_LAYER; int r = it % PER_LAYER;
        if (r < I_IN) { if (layer == 0) p0_transpose_item<1>(a.in[I_EVEN_W_IN], D, 2576, NP, (bf16_t*)(ws + WS_WIN0), scr, r, C.lane);
                        else p0_transpose_item<2>(a.in[I_ODD_W_IN], D, 2720, NP, (bf16_t*)(ws + WS_WIN1), scr, r, C.lane); continue; } r -= I_IN;
        if (r < I_OUT) { p0_transpose_item<0>(layer == 0 ? a.in[I_EVEN_W_OUT] : a.in[I_ODD_W_OUT], D, D, D, (bf16_t*)(ws + (layer == 0 ? WS_WOUT0 : WS_WOUT1)), scr, r, C.lane); continue; } r -= I_OUT;
        if (r < I_UP) { p0_transpose_item<0>(a.in[I_W_UP] + (size_t)layer * D * FF, D, FF, FF, (bf16_t*)(ws + (layer == 0 ? WS_WUP0 : WS_WUP1)), scr, r, C.lane); continue; } r -= I_UP;
        p0_transpose_item<0>(a.in[I_W_DOWN] + (size_t)layer * FF * D, FF, D, D, (bf16_t*)(ws + (layer == 0 ? WS_WDN0 : WS_WDN1)), scr, r, C.lane);
    }
    { const int gt = C.bid * NTHREADS + C.tid, NGT = C.nblk * NTHREADS; float* tab = (float*)(ws + WS_TAB);
      for (int i = gt; i < 512 * 32; i += NGT) { const int c = i >> 5, j = i & 31; tab[TAB_W2T / 4 + i] = a.in[I_RWKV_W2][j * 512 + c]; tab[TAB_A2T / 4 + i] = a.in[I_RWKV_A2][j * 512 + c];
          tab[TAB_CWT / 4 + i] = j < 31 ? a.in[I_CONV_W][j * 512 + c] : 0.f; }
      for (int i = gt; i < 512 * 96; i += NGT) { const int c = i / 96, j = i % 96; tab[TAB_G2T / 4 + i] = a.in[I_RWKV_G2][j * 512 + c]; }
      for (int i = gt; i < 256 * 16; i += NGT) { const int c = i >> 4, j = i & 15; tab[TAB_GA2T / 4 + i] = a.in[I_GLA_W_ALPHA2][j * 256 + c]; } }
    const float* x = a.in[I_X]; const float* g = a.in[I_NORM_MIX]; bf16_t* XN = (bf16_t*)(ws + WS_XN); float* SSP = (float*)(ws + WS_SSP);
    f32x4 gv[4];
#pragma unroll
    for (int j = 0; j < 4; ++j) gv[j] = *((const f32x4*)g + C.lane + 64 * j);
    for (int m = gw; m < M; m += NGW) {
        const f32x4* xr = (const f32x4*)(x + (size_t)m * D) + C.lane; f32x4 v[4]; float s = 0.f;
#pragma unroll
        for (int j = 0; j < 4; ++j) { v[j] = xr[64 * j]; s += (v[j][0] * v[j][0] + v[j][1] * v[j][1]) + (v[j][2] * v[j][2] + v[j][3] * v[j][3]); }
        s = wave_sum(s);
        u32x2* o8 = (u32x2*)(XN + (size_t)m * D) + C.lane;
#pragma unroll
        for (int j = 0; j < 4; ++j) { const f32x4 t = v[j] * gv[j]; u32x2 w; w.x = pk2(t[0], t[1]); w.y = pk2(t[2], t[3]); o8[64 * j] = w; }
        if (C.lane < 16) SSP[(size_t)m * 16 + C.lane] = (C.lane == 0) ? s : 0.f;
    }
}

__device__ __forceinline__ void gla_decay(const Ctx& C, CArgs& a, const bf16_t* P, int tok0, int h, LAS float* ALR, LAS float* TOT, float (&bv)[8], float& total) {
    for (int i = C.tid; i < 1024; i += NTHREADS) { const int t = i >> 4, j = i & 15; ALR[i] = ldbf(P + (size_t)(tok0 + t) * NP + EC_ALR + j); }
    __syncthreads();
    const int col = h * 64 + C.lane; const float ba = a.in[I_GLA_B_ALPHA][col];
    float wc[16];
    { const f32x4* wp = (const f32x4*)((const float*)(a.ws + WS_TAB + TAB_GA2T) + col * 16);
#pragma unroll
      for (int j = 0; j < 4; ++j) { const f32x4 v = wp[j]; wc[4 * j] = v[0]; wc[4 * j + 1] = v[1]; wc[4 * j + 2] = v[2]; wc[4 * j + 3] = v[3]; } }
    float pre = 0.f;
#pragma unroll
    for (int i = 0; i < 8; ++i) { const int t = 8 * C.wave + i; float z = ba;
#pragma unroll
        for (int j = 0; j < 16; ++j) z += ALR[t * 16 + j] * wc[j];
        pre += logsigmoidf_(z) * (1.0f / 16.0f); bv[i] = pre; }
    TOT[C.wave * 64 + C.lane] = pre;
    __syncthreads();
    float off = 0.f, tot = 0.f;
#pragma unroll
    for (int w = 0; w < 8; ++w) { const float tv = TOT[w * 64 + C.lane]; tot += tv; if (w < C.wave) off += tv; }
#pragma unroll
    for (int i = 0; i < 8; ++i) bv[i] += off;
    total = tot;
}
__device__ __forceinline__ void load_vtile(const Ctx& C, const bf16_t* P, int tok0, int colbase, LAS float* VT) {
    for (int i = C.tid; i < 1024; i += NTHREADS) { const int t = i >> 4, c8 = i & 15; const u32x4 w = *(const u32x4*)(P + (size_t)(tok0 + t) * NP + colbase + 8 * c8); float f[8]; unpack8(w, f);
        LAS f32x4* d = (LAS f32x4*)(VT + t * 128 + 8 * c8); d[0] = (f32x4){f[0], f[1], f[2], f[3]}; d[1] = (f32x4){f[4], f[5], f[6], f[7]}; }
}
__device__ __forceinline__ void gla_a_unit(const Ctx& C, CArgs& a, int uid) {
    const int h = uid & 3, n = (uid >> 2) & 127, b = uid >> 9, tok0 = b * SEQ + n * 64;
    const bf16_t* P = (const bf16_t*)(a.ws + WS_P);
    LAS float* ALR = (LAS float*)C.lds; LAS float* TOT = ALR + 1024; LAS float* KS = TOT + 512; LAS float* VT = KS + 4096;
    float bv[8], total;
    load_vtile(C, P, tok0, EC_V + h * 128, VT);
    gla_decay(C, a, P, tok0, h, ALR, TOT, bv, total);
    const int col = h * 64 + C.lane;
#pragma unroll
    for (int i = 0; i < 8; ++i) { const int t = 8 * C.wave + i; const float kv = ldbf(P + (size_t)(tok0 + t) * NP + EC_K + col); KS[t * 64 + C.lane] = kv * __expf(total - bv[i]); }
    const int ug = (b * 4 + h) * 128 + n;
    if (C.wave == 0) ((float*)(a.ws + WS_GLA_DL))[ug * 64 + C.lane] = __expf(total);
    __syncthreads();
    const int di = C.wave >> 2, vj = C.wave & 3, l31 = C.lane & 31, lh = C.lane >> 5;
    f32x16 acc;
#pragma unroll
    for (int r = 0; r < 16; ++r) acc[r] = 0.f;
#pragma unroll 4
    for (int s = 0; s < 32; ++s) { const float av = KS[(2 * s + lh) * 64 + 32 * di + l31], bvv = VT[(2 * s + lh) * 128 + 32 * vj + l31]; acc = __builtin_amdgcn_mfma_f32_32x32x2f32(av, bvv, acc, 0, 0, 0); }
    float* ST = (float*)(a.ws + WS_GLA_ST) + (size_t)ug * 8192;
#pragma unroll
    for (int r = 0; r < 16; ++r) { const int d = 32 * di + (r & 3) + 8 * (r >> 2) + 4 * lh; ST[d * 128 + 32 * vj + l31] = acc[r]; }
    __syncthreads();
}
__device__ __forceinline__ void gla_scan(const Ctx& C, CArgs& a) {
    const int gid = C.bid * NTHREADS + C.tid;
    for (int e0 = gid; e0 < 16 * 8192; e0 += C.nblk * NTHREADS) {
        const int bh = e0 >> 13, e = e0 & 8191, d = e >> 7;
        float* base = (float*)(a.ws + WS_GLA_ST) + (size_t)bh * 128 * 8192 + e; const float* dl = (const float*)(a.ws + WS_GLA_DL) + (size_t)bh * 128 * 64 + d;
        float s = 0.f;
        for (int n0 = 0; n0 < 128; n0 += 8) { float kv[8], dv[8];
#pragma unroll
            for (int j = 0; j < 8; ++j) { kv[j] = base[(size_t)(n0 + j) * 8192]; dv[j] = dl[(n0 + j) * 64]; }
#pragma unroll
            for (int j = 0; j < 8; ++j) { base[(size_t)(n0 + j) * 8192] = s; s = s * dv[j] + kv[j]; } }
    }
}
__device__ __forceinline__ void gla_c_unit(const Ctx& C, CArgs& a, int uid) {
    const int h = uid & 3, n = (uid >> 2) & 127, b = uid >> 9, tok0 = b * SEQ + n * 64;
    const bf16_t* P = (const bf16_t*)(a.ws + WS_P);
    LAS float* ALR = (LAS float*)C.lds; LAS float* TOT = ALR + 1024; LAS float* QD = TOT + 512; LAS float* KD = QD + 64 * 65; LAS float* VT = KD + 64 * 65; LAS float* OT = VT + 8192;
    float bv[8], total;
    load_vtile(C, P, tok0, EC_V + h * 128, VT);
    gla_decay(C, a, P, tok0, h, ALR, TOT, bv, total);
    const int col = h * 64 + C.lane;
#pragma unroll
    for (int i = 0; i < 8; ++i) { const int t = 8 * C.wave + i; const float q = ldbf(P + (size_t)(tok0 + t) * NP + EC_Q + col), k = ldbf(P + (size_t)(tok0 + t) * NP + EC_K + col);
        QD[t * 65 + C.lane] = q * 0.125f * __expf(bv[i]); KD[t * 65 + C.lane] = k * __expf(-bv[i]); }
    __syncthreads();
    const int ci = C.wave >> 2, vj = C.wave & 3, l31 = C.lane & 31, lh = C.lane >> 5;
    f32x16 acc;
#pragma unroll
    for (int r = 0; r < 16; ++r) acc[r] = 0.f;
    for (int si = 0; si <= ci; ++si) {
        f32x16 at;
#pragma unroll
        for (int r = 0; r < 16; ++r) at[r] = 0.f;
#pragma unroll 4
        for (int s = 0; s < 32; ++s) { const float av = KD[(32 * si + l31) * 65 + 2 * s + lh], bq = QD[(32 * ci + l31) * 65 + 2 * s + lh]; at = __builtin_amdgcn_mfma_f32_32x32x2f32(av, bq, at, 0, 0, 0); }
#pragma unroll
        for (int j = 0; j < 16; ++j) { const int sl = 32 * si + (j & 3) + 8 * (j >> 2) + 4 * lh, c = 32 * ci + l31; const float av = (sl <= c) ? at[j] : 0.f;
            acc = __builtin_amdgcn_mfma_f32_32x32x2f32(av, VT[sl * 128 + 32 * vj + l31], acc, 0, 0, 0); }
    }
    const int ug = (b * 4 + h) * 128 + n; const float* ST = (const float*)(a.ws + WS_GLA_ST) + (size_t)ug * 8192;
#pragma unroll 4
    for (int s = 0; s < 32; ++s) { const float av = QD[(32 * ci + l31) * 65 + 2 * s + lh], sv = ST[(2 * s + lh) * 128 + 32 * vj + l31]; acc = __builtin_amdgcn_mfma_f32_32x32x2f32(av, sv, acc, 0, 0, 0); }
#pragma unroll
    for (int r = 0; r < 16; ++r) { const int c = 32 * ci + (r & 3) + 8 * (r >> 2) + 4 * lh; OT[c * 128 + 32 * vj + l31] = acc[r]; }
    __syncthreads();
    { const int c = C.tid >> 3, part = C.tid & 7; float o[16]; float ss = 0.f;
#pragma unroll
      for (int j = 0; j < 16; ++j) { o[j] = OT[c * 128 + part * 16 + j]; ss += o[j] * o[j]; }
      ss += __shfl_xor(ss, 1); ss += __shfl_xor(ss, 2); ss += __shfl_xor(ss, 4);
      const float rstd = 1.0f / sqrtf(ss * (1.0f / 128.0f) + RMS_EPS);
      const size_t m = (size_t)(tok0 + c); const bf16_t* gp = P + m * NP + EC_G + h * 128 + part * 16; const float* gn = a.in[I_GLA_NORM] + h * 128 + part * 16;
      const u32x4 g0 = *(const u32x4*)gp, g1 = *(const u32x4*)(gp + 8); float gf[16]; unpack8(g0, gf); unpack8(g1, gf + 8);
      unsigned w[8];
#pragma unroll
      for (int j = 0; j < 8; ++j) w[j] = pk2(o[2 * j] * rstd * gn[2 * j] * siluf_(gf[2 * j]), o[2 * j + 1] * rstd * gn[2 * j + 1] * siluf_(gf[2 * j + 1]));
      bf16_t* mp = (bf16_t*)(a.ws + WS_MIX) + m * D + h * 128 + part * 16;
      *(u32x4*)mp = (u32x4){w[0], w[1], w[2], w[3]}; *(u32x4*)(mp + 8) = (u32x4){w[4], w[5], w[6], w[7]}; }
    __syncthreads();
}
__device__ __forceinline__ void sgu_unit(const Ctx& C, CArgs& a, int uid) {
    const int tok0 = uid * 128;
    const bf16_t* P = (const bf16_t*)(a.ws + WS_P); bf16_t* MIX = (bf16_t*)(a.ws + WS_MIX);
    LAS float* WL = (LAS float*)C.lds; LAS float* VH = WL + 128 * 129; LAS float* STS = VH + 128 * 128;
    for (int i = 0; i < 16; ++i) { const int t = 16 * C.wave + i; const u32x4 w = *(const u32x4*)(P + (size_t)(tok0 + t) * NP + EC_SV + 8 * C.lane); float f[8]; unpack8(w, f); float s = 0.f;
#pragma unroll
        for (int j = 0; j < 8; ++j) { f[j] = geluf_(f[j]); s += f[j]; }
        const float mean = wave_sum(s) * (1.0f / 512.0f); float q = 0.f;
#pragma unroll
        for (int j = 0; j < 8; ++j) { const float d = f[j] - mean; q += d * d; }
        const float var = wave_sum(q) * (1.0f / 512.0f);
        if (C.lane == 0) { STS[2 * t] = mean; STS[2 * t + 1] = 1.0f / sqrtf(var + LN_EPS); } }
    __syncthreads();
    const int l31 = C.lane & 31, lh = C.lane >> 5, cj = C.wave & 3;
    for (int g = 0; g < 4; ++g) {
        const float* W = a.in[I_SGU_W] + g * 16384;
        for (int i = C.tid; i < 16384; i += NTHREADS) { const int t = i >> 7, s = i & 127; WL[t * 129 + s] = (s <= t) ? W[i] : 0.f; }
        for (int i = C.tid; i < 2048; i += NTHREADS) { const int s = i >> 4, c8 = i & 15; const u32x4 w = *(const u32x4*)(P + (size_t)(tok0 + s) * NP + EC_SV + g * 128 + 8 * c8); float f[8]; unpack8(w, f);
            const float mean = STS[2 * s], rstd = STS[2 * s + 1]; const float* lg = a.in[I_SGU_LN_G] + g * 128 + 8 * c8; const float* lb = a.in[I_SGU_LN_B] + g * 128 + 8 * c8;
#pragma unroll
            for (int j = 0; j < 8; ++j) VH[s * 128 + 8 * c8 + j] = (geluf_(f[j]) - mean) * rstd * lg[j] + lb[j]; }
        __syncthreads();
        for (int tt = 0; tt < 2; ++tt) { const int ti = tt == 0 ? (C.wave >> 2) : 3 - (C.wave >> 2);
            f32x16 acc;
#pragma unroll
            for (int r = 0; r < 16; ++r) acc[r] = 0.f;
            const int nsteps = 16 * (ti + 1);
#pragma unroll 4
            for (int s = 0; s < nsteps; ++s) { const float av = WL[(32 * ti + l31) * 129 + 2 * s + lh], bv = VH[(2 * s + lh) * 128 + 32 * cj + l31]; acc = __builtin_amdgcn_mfma_f32_32x32x2f32(av, bv, acc, 0, 0, 0); }
#pragma unroll
            for (int r = 0; r < 16; ++r) { const int t = 32 * ti + (r & 3) + 8 * (r >> 2) + 4 * lh, c = g * 128 + 32 * cj + l31; const size_t m = (size_t)(tok0 + t);
                const float uv = ldbf(P + m * NP + EC_U + c); const float o = (acc[r] + a.in[I_SGU_B][g * 128 + t]) * geluf_(uv);
                MIX[m * D + 512 + c] = (bf16_t)f2bf(o); } }
        __syncthreads();
    }
}

__device__ __forceinline__ float lerp_tok(const bf16_t* P, size_t m, int col, float mu) {
    const float cur = ldbf(P + m * NP + col); const float prev = ((m & (SEQ - 1)) != 0) ? ldbf(P + (m - 1) * NP + col) : 0.f;
    return cur + (prev - cur) * mu;
}
__device__ __forceinline__ void conv_unit(const Ctx& C, CArgs& a, int uid) {
    const int b = uid >> 7, i64 = uid & 127, t0 = i64 * 64; const size_t mb = (size_t)b * SEQ;
    const bf16_t* P = (const bf16_t*)(a.ws + WS_P); bf16_t* MIX = (bf16_t*)(a.ws + WS_MIX);
    LAS bf16_t* Z = (LAS bf16_t*)C.lds; LAS float* YG = (LAS float*)(C.lds + 94 * 512 * 2);
    for (int i = C.tid; i < 94 * 64; i += NTHREADS) { const int j = i >> 6, c8 = i & 63; const int t = t0 - 30 + j; u32x4 o = (u32x4){0u, 0u, 0u, 0u};
        if (t >= 0) { const bf16_t* pr = P + (mb + t) * NP; const u32x4 wa = *(const u32x4*)(pr + OC_CA + 8 * c8), wg = *(const u32x4*)(pr + OC_CG + 8 * c8); float fa[8], fg[8]; unpack8(wa, fa); unpack8(wg, fg);
            o.x = pk2(fa[0] * sigmoidf_(fg[0]), fa[1] * sigmoidf_(fg[1])); o.y = pk2(fa[2] * sigmoidf_(fg[2]), fa[3] * sigmoidf_(fg[3]));
            o.z = pk2(fa[4] * sigmoidf_(fg[4]), fa[5] * sigmoidf_(fg[5])); o.w = pk2(fa[6] * sigmoidf_(fg[6]), fa[7] * sigmoidf_(fg[7])); }
        *(LAS u32x4*)(Z + j * 512 + 8 * c8) = o; }
    __syncthreads();
    const int c = C.tid; float w[31];
    { const f32x4* wp = (const f32x4*)((const float*)(a.ws + WS_TAB + TAB_CWT) + c * 32);
#pragma unroll
      for (int j = 0; j < 8; ++j) { const f32x4 v = wp[j]; w[4 * j] = v[0]; w[4 * j + 1] = v[1]; w[4 * j + 2] = v[2]; if (j < 7) w[4 * j + 3] = v[3]; } }
    const float cb = a.in[I_CONV_B][c];
    float lg[8], lb[8];
#pragma unroll
    for (int k = 0; k < 8; ++k) { lg[k] = a.in[I_CONV_LN_G][C.lane + 64 * k]; lb[k] = a.in[I_CONV_LN_B][C.lane + 64 * k]; }
#pragma unroll 1
    for (int grp = 0; grp < 8; ++grp) {
        float zw[38];
#pragma unroll
        for (int j = 0; j < 38; ++j) zw[j] = bf2f((unsigned)Z[(8 * grp + j) * 512 + c]);
#pragma unroll
        for (int q = 0; q < 8; ++q) { float y = cb;
#pragma unroll
            for (int j = 0; j < 31; ++j) y += w[j] * zw[q + j];
            YG[q * 512 + c] = y; }
        __syncthreads();
        { float v[8]; float s = 0.f;
#pragma unroll
          for (int k = 0; k < 8; ++k) { v[k] = YG[C.wave * 512 + C.lane + 64 * k]; s += v[k]; }
          const float mean = wave_sum(s) * (1.0f / 512.0f); float q2 = 0.f;
#pragma unroll
          for (int k = 0; k < 8; ++k) { v[k] -= mean; q2 += v[k] * v[k]; }
          const float rstd = 1.0f / sqrtf(wave_sum(q2) * (1.0f / 512.0f) + LN_EPS);
          const size_t m = mb + t0 + 8 * grp + C.wave;
#pragma unroll
          for (int k = 0; k < 8; ++k) MIX[m * D + 512 + C.lane + 64 * k] = (bf16_t)f2bf(siluf_(v[k] * rstd * lg[k] + lb[k])); }
        __syncthreads();
    }
}
__device__ __forceinline__ void rwkv_pre_unit(const Ctx& C, CArgs& a, int uid) {
    const size_t m0 = (size_t)uid * 64;
    const bf16_t* P = (const bf16_t*)(a.ws + WS_P); const float* mu = a.in[I_RWKV_MU];
    LAS float* XW = (LAS float*)C.lds; LAS float* XA = XW + 64 * 32;
    for (int i = C.tid; i < 4096; i += NTHREADS) { const int t = i >> 6, j = i & 63; const float v = lerp_tok(P, m0 + t, OC_XW + j, mu[1536 + j]);
        if (j < 32) XW[t * 32 + j] = tanhf(v); else XA[t * 32 + j - 32] = v; }
    __syncthreads();
    const int col = C.wave * 64 + C.lane;
    float w2c[32], a2c[32];
    { const f32x4* wp = (const f32x4*)((const float*)(a.ws + WS_TAB + TAB_W2T) + col * 32); const f32x4* ap = (const f32x4*)((const float*)(a.ws + WS_TAB + TAB_A2T) + col * 32);
#pragma unroll
      for (int j = 0; j < 8; ++j) { const f32x4 v = wp[j], u = ap[j];
#pragma unroll
          for (int e = 0; e < 4; ++e) { w2c[4 * j + e] = v[e]; a2c[4 * j + e] = u[e]; } } }
    const float w0 = a.in[I_RWKV_W0][col], a0 = a.in[I_RWKV_A0][col], kks = a.in[I_RWKV_K_K][col], ka = a.in[I_RWKV_K_A][col], muk = mu[512 + col];
    bf16_t* KP = (bf16_t*)(a.ws + WS_R_KP); bf16_t* KK = (bf16_t*)(a.ws + WS_R_KK); bf16_t* BB = (bf16_t*)(a.ws + WS_R_BB); bf16_t* LD = (bf16_t*)(a.ws + WS_R_LD);
#pragma unroll 1
    for (int t = 0; t < 64; ++t) { float xw = w0, xa = a0;
#pragma unroll
        for (int j4 = 0; j4 < 8; ++j4) { const f32x4 u = *(LAS f32x4*)(XW + t * 32 + 4 * j4), v = *(LAS f32x4*)(XA + t * 32 + 4 * j4);
#pragma unroll
            for (int e = 0; e < 4; ++e) { xw += u[e] * w2c[4 * j4 + e]; xa += v[e] * a2c[4 * j4 + e]; } }
        const float ld = -0.6065306597126334f * sigmoidf_(xw), av = sigmoidf_(xa);
        const size_t m = m0 + t; const float k = lerp_tok(P, m, OC_K + col, muk);
        const float kkv = k * kks; const float n2 = wave_sum(kkv * kkv); const float kkn = kkv / fmaxf(sqrtf(n2), 1e-12f);
        const float kp = k * (1.0f + (av - 1.0f) * ka);
        KP[m * 512 + col] = (bf16_t)f2bf(kp); KK[m * 512 + col] = (bf16_t)f2bf(kkn); BB[m * 512 + col] = (bf16_t)f2bf(kkn * av); LD[m * 512 + col] = (bf16_t)f2bf(ld); }
    __syncthreads();
}
__device__ __forceinline__ float dpp_f(float v, int ctrl_dummy);
#define DPP_ADD(v, ctrl) (v) += __int_as_float(__builtin_amdgcn_mov_dpp(__float_as_int(v), (ctrl), 0xF, 0xF, true))
__device__ __forceinline__ float reduce16(float v) { DPP_ADD(v, 0xB1); DPP_ADD(v, 0x4E); DPP_ADD(v, 0x141); DPP_ADD(v, 0x140); return v; }
__device__ __forceinline__ void rwkv_scan(const Ctx& C, CArgs& a) {
    const int blk = C.bid; if (blk >= 128) return;
    const int bh = blk >> 2, b = bh >> 3, h = bh & 7, rowbase = 16 * (blk & 3);
    const bf16_t* P = (const bf16_t*)(a.ws + WS_P); const float* mu = a.in[I_RWKV_MU];
    const bf16_t* ARR[4] = { (const bf16_t*)(a.ws + WS_R_KK), (const bf16_t*)(a.ws + WS_R_LD), (const bf16_t*)(a.ws + WS_R_BB), (const bf16_t*)(a.ws + WS_R_KP) };
    bf16_t* Y = (bf16_t*)(a.ws + WS_R_Y);
    LAS float* VEC = (LAS float*)C.lds;
    LAS float* VV = VEC + 64 * 320;
    LAS float* YS = VV + 1024;
    const int st = C.tid >> 3, sk8 = C.tid & 7;
    float mur[8];
#pragma unroll
    for (int j = 0; j < 8; ++j) mur[j] = mu[h * 64 + 8 * sk8 + j];
    const int vrow = rowbase + 2 * sk8; const float muv0 = mu[1024 + h * 64 + vrow], muv1 = mu[1024 + h * 64 + vrow + 1];
    float s0 = 0.f, s1 = 0.f, s2 = 0.f, s3 = 0.f;
    const int k4 = C.lane & 15, rw = C.lane >> 4;
    u32x4 pre[4], prc, prp; unsigned pvc, pvp;
    auto issue = [&](int chunk) {
        const size_t m = (size_t)b * SEQ + chunk * 64 + st;
#pragma unroll
        for (int q = 0; q < 4; ++q) pre[q] = *(const u32x4*)(ARR[q] + m * 512 + h * 64 + 8 * sk8);
        prc = *(const u32x4*)(P + m * NP + OC_R + h * 64 + 8 * sk8);
        pvc = *(const unsigned*)(P + m * NP + OC_V + h * 64 + vrow);
        if ((m & (SEQ - 1)) != 0) { prp = *(const u32x4*)(P + (m - 1) * NP + OC_R + h * 64 + 8 * sk8); pvp = *(const unsigned*)(P + (m - 1) * NP + OC_V + h * 64 + vrow); }
        else { prp = (u32x4){0u, 0u, 0u, 0u}; pvp = 0u; }
    };
    issue(0);
#pragma unroll 1
    for (int chunk = 0; chunk < 128; ++chunk) {
        { float f[8], g[8];
#pragma unroll
          for (int q = 0; q < 4; ++q) { unpack8(pre[q], f);
              if (q == 1) {
#pragma unroll
                  for (int j = 0; j < 8; ++j) f[j] = __expf(f[j]); }
              LAS f32x4* d = (LAS f32x4*)(VEC + (st * 5 + q) * 64 + 8 * sk8); d[0] = (f32x4){f[0], f[1], f[2], f[3]}; d[1] = (f32x4){f[4], f[5], f[6], f[7]}; }
          unpack8(prc, f); unpack8(prp, g);
#pragma unroll
          for (int j = 0; j < 8; ++j) f[j] = f[j] + (g[j] - f[j]) * mur[j];
          LAS f32x4* d = (LAS f32x4*)(VEC + (st * 5 + 4) * 64 + 8 * sk8); d[0] = (f32x4){f[0], f[1], f[2], f[3]}; d[1] = (f32x4){f[4], f[5], f[6], f[7]};
          const float vc0 = bf2f(pvc & 0xffffu), vc1 = __uint_as_float(pvc & 0xffff0000u), vp0 = bf2f(pvp & 0xffffu), vp1 = __uint_as_float(pvp & 0xffff0000u);
          VV[st * 16 + 2 * sk8] = vc0 + (vp0 - vc0) * muv0; VV[st * 16 + 2 * sk8 + 1] = vc1 + (vp1 - vc1) * muv1; }
        __syncthreads();
        if (chunk + 1 < 128) issue(chunk + 1);
        if (C.wave < 4) {
            float ybuf = 0.f;
#pragma unroll 1
            for (int t = 0; t < 64; ++t) {
                const LAS f32x4* vp = (const LAS f32x4*)(VEC + t * 320 + 4 * k4);
                const f32x4 kk = vp[0], w = vp[16], bb = vp[32], kp = vp[48], r = vp[64];
                const float vt = VV[t * 16 + 4 * C.wave + rw];
                float p = (s0 * kk[0] + s1 * kk[1]) + (s2 * kk[2] + s3 * kk[3]);
                p = reduce16(p);
                s0 = s0 * w[0] - p * bb[0] + vt * kp[0]; s1 = s1 * w[1] - p * bb[1] + vt * kp[1];
                s2 = s2 * w[2] - p * bb[2] + vt * kp[2]; s3 = s3 * w[3] - p * bb[3] + vt * kp[3];
                float y = (s0 * r[0] + s1 * r[1]) + (s2 * r[2] + s3 * r[3]);
                y = reduce16(y);
                if (k4 == (t & 15)) ybuf = y;
                if ((t & 15) == 15) YS[(t - 15 + k4) * 16 + 4 * C.wave + rw] = ybuf;
            }
        }
        __syncthreads();
        { const size_t m = (size_t)b * SEQ + chunk * 64 + st; const unsigned w = pk2(YS[st * 16 + 2 * sk8], YS[st * 16 + 2 * sk8 + 1]); *(unsigned*)(Y + m * 512 + h * 64 + vrow) = w; }
    }
}
__device__ __forceinline__ void rwkv_post_unit(const Ctx& C, CArgs& a, int uid) {
    const size_t m0 = (size_t)uid * 64;
    const bf16_t* P = (const bf16_t*)(a.ws + WS_P); const float* mu = a.in[I_RWKV_MU];
    LAS float* XG = (LAS float*)C.lds;
    for (int i = C.tid; i < 64 * 96; i += NTHREADS) { const int t = i / 96, j = i % 96; XG[i] = sigmoidf_(lerp_tok(P, m0 + t, OC_XG + j, mu[1600 + j])); }
    __syncthreads();
    const int col = C.wave * 64 + C.lane;
    float g2c[96];
    { const f32x4* gp = (const f32x4*)((const float*)(a.ws + WS_TAB + TAB_G2T) + col * 96);
#pragma unroll
      for (int j = 0; j < 24; ++j) { const f32x4 v = gp[j];
#pragma unroll
          for (int e = 0; e < 4; ++e) g2c[4 * j + e] = v[e]; } }
    const float gg = a.in[I_RWKV_GN_G][col], gb = a.in[I_RWKV_GN_B][col], rk = a.in[I_RWKV_R_K][col], mur = mu[col], muv = mu[1024 + col];
    const bf16_t* KP = (const bf16_t*)(a.ws + WS_R_KP); const bf16_t* Y = (const bf16_t*)(a.ws + WS_R_Y); bf16_t* MIX = (bf16_t*)(a.ws + WS_MIX);
#pragma unroll 1
    for (int t = 0; t < 64; ++t) { const size_t m = m0 + t; float g = 0.f;
#pragma unroll
        for (int j4 = 0; j4 < 24; ++j4) { const f32x4 u = *(LAS f32x4*)(XG + t * 96 + 4 * j4);
#pragma unroll
            for (int e = 0; e < 4; ++e) g += u[e] * g2c[4 * j4 + e]; }
        const float y = ldbf(Y + m * 512 + col); const float mean = wave_sum(y) * (1.0f / 64.0f); const float d = y - mean; const float var = wave_sum(d * d) * (1.0f / 64.0f);
        const float yn = d * (1.0f / sqrtf(var + GN_EPS)) * gg + gb;
        const float r = lerp_tok(P, m, OC_R + col, mur), v = lerp_tok(P, m, OC_V + col, muv), kp = ldbf(KP + m * 512 + col);
        const float bonus = wave_sum(r * kp * rk) * v;
        MIX[m * D + col] = (bf16_t)f2bf((yn + bonus) * g); }
    __syncthreads();
}
__device__ __forceinline__ void final_norm(const Ctx& C, CArgs& a) {
    const int gw = C.bid * NWAVES + C.wave, NGW = C.nblk * NWAVES; const float* ssp = (const float*)(a.ws + WS_SSP);
    f32x4 gv[4];
#pragma unroll
    for (int j = 0; j < 4; ++j) gv[j] = *((const f32x4*)a.in[I_NORM_FINAL] + C.lane + 64 * j);
    for (int m = gw; m < M; m += NGW) { const float rs = pg8::row_rstd(ssp, m); f32x4* xr = (f32x4*)(a.out + (size_t)m * D) + C.lane;
#pragma unroll
        for (int j = 0; j < 4; ++j) xr[64 * j] = xr[64 * j] * gv[j] * rs; }
}

constexpr int N_PHASES = 16;
__global__ void __launch_bounds__(NTHREADS, 2) fwd_kernel(Args args) {
    extern __shared__ __attribute__((aligned(16))) unsigned char lds_raw[];
    LAS unsigned char* const lds = (LAS unsigned char*)lds_raw;
    const int lo = get_args()->ph_lo, hi = get_args()->ph_hi;
#if ONE_LAUNCH
    cg::grid_group grid = cg::this_grid();
#define SEAM(k) do { if ((k) + 1 < hi) grid.sync(); } while (0)
#else
#define SEAM(k) do { } while (0)
#endif
#define IN(k) (lo <= (k) && (k) < hi)
    if (PHK(0) && IN(0)) { const Ctx C = mk_ctx(lds); p0_prologue(C, *get_args()); SEAM(0); }
    for (int layer = 0; layer < 2; ++layer) {
        const int pb = 1 + 7 * layer;
        if (PHK(1) && IN(pb)) {
            CArgs& A = *get_args(); unsigned char* ws = A.ws; const Ctx C = mk_ctx(lds);
            pg8::Gemm g{(const bf16_t*)(ws + WS_XN), (const bf16_t*)(ws + (layer == 0 ? WS_WIN0 : WS_WIN1)), M, NP, D}; pg8::StaticOrder S; S.init(M, NP, C.nblk, C.bid);
            pg8::EpiProj<0> E{(bf16_t*)(ws + WS_P), NP, (const float*)(ws + WS_SSP)};
            pg8::gemm_phase<pg8::EpiProj<0>, pg8::StaticOrder, true, true>(C.lds, C.tid, g, S, E);
            SEAM(pb);
        }
        if (IN(pb + 1)) {
            CArgs& A = *get_args(); const Ctx C = mk_ctx(lds);
            if (layer == 0) { if (PHK(2)) for (int u = C.bid; u < 256 + 2048; u += C.nblk) { if (u < 256) { if (PHK(12)) sgu_unit(C, A, u); } else gla_a_unit(C, A, u - 256); } }
            else { if (PHK(3)) for (int u = C.bid; u < 1024; u += C.nblk) { if (u < 512) { if (PHK(13)) conv_unit(C, A, u); } else rwkv_pre_unit(C, A, u - 512); } }
            SEAM(pb + 1);
        }
        if (IN(pb + 2)) {
            CArgs& A = *get_args(); const Ctx C = mk_ctx(lds);
            if (layer == 0) { if (PHK(4)) gla_scan(C, A); } else { if (PHK(5)) rwkv_scan(C, A); }
            SEAM(pb + 2);
        }
        if (IN(pb + 3)) {
            CArgs& A = *get_args(); const Ctx C = mk_ctx(lds);
            if (layer == 0) { if (PHK(6)) for (int u = C.bid; u < 2048; u += C.nblk) gla_c_unit(C, A, u); }
            else { if (PHK(7)) for (int u = C.bid; u < 512; u += C.nblk) rwkv_post_unit(C, A, u); }
            SEAM(pb + 3);
        }
        if (PHK(8) && IN(pb + 4)) {
            CArgs& A = *get_args(); unsigned char* ws = A.ws; const Ctx C = mk_ctx(lds);
            pg8::Gemm g{(const bf16_t*)(ws + WS_MIX), (const bf16_t*)(ws + (layer == 0 ? WS_WOUT0 : WS_WOUT1)), M, D, D}; pg8::StaticOrder S; S.init(M, D, C.nblk, C.bid);
            pg8::EpiRes E{layer == 0 ? A.in[I_X] : A.out, A.out, (bf16_t*)(ws + WS_XN), A.in[I_NORM_FFN] + layer * D, (float*)(ws + WS_SSP)};
            pg8::gemm_phase<pg8::EpiRes, pg8::StaticOrder, true, true>(C.lds, C.tid, g, S, E);
            SEAM(pb + 4);
        }
        if (PHK(9) && IN(pb + 5)) {
            CArgs& A = *get_args(); unsigned char* ws = A.ws; const Ctx C = mk_ctx(lds);
            pg8::Gemm g{(const bf16_t*)(ws + WS_XN), (const bf16_t*)(ws + (layer == 0 ? WS_WUP0 : WS_WUP1)), M, FF, D}; pg8::StaticOrder S; S.init(M, FF, C.nblk, C.bid);
            pg8::EpiProj<1> E{(bf16_t*)(ws + WS_H), FF, (const float*)(ws + WS_SSP)};
            pg8::gemm_phase<pg8::EpiProj<1>, pg8::StaticOrder, true, true>(C.lds, C.tid, g, S, E);
            SEAM(pb + 5);
        }
        if (PHK(10) && IN(pb + 6)) {
            CArgs& A = *get_args(); unsigned char* ws = A.ws; const Ctx C = mk_ctx(lds);
            pg8::Gemm g{(const bf16_t*)(ws + WS_H), (const bf16_t*)(ws + (layer == 0 ? WS_WDN0 : WS_WDN1)), M, D, FF}; pg8::StaticOrder S; S.init(M, D, C.nblk, C.bid);
            pg8::EpiRes E{A.out, A.out, layer == 0 ? (bf16_t*)(ws + WS_XN) : nullptr, A.in[I_NORM_MIX] + D, (float*)(ws + WS_SSP)};
            pg8::gemm_phase<pg8::EpiRes, pg8::StaticOrder, true, true>(C.lds, C.tid, g, S, E);
            SEAM(pb + 6);
        }
    }
    if (PHK(11) && IN(15)) { const Ctx C = mk_ctx(lds); final_norm(C, *get_args()); }
#undef IN
#undef SEAM
}

extern "C" void kernel_launch(void* const* d_in, const int* in_sizes, int n_in, void* d_out, int out_size, void* d_ws, size_t ws_size, hipStream_t stream) {
    static int grid = 0;
    if (grid == 0) {
        if (n_in != 32 || in_sizes[0] != M * D || out_size != M * D || ws_size < WS_END) { fprintf(stderr, "kernel_launch: unexpected shapes (n_in %d, in0 %d, out %d, ws %zu); nothing launched\n", n_in, n_in > 0 ? in_sizes[0] : -1, out_size, ws_size); grid = -1; return; }
        int dev = 0, cus = 0, per_cu = 0;
        if (hipGetDevice(&dev) != hipSuccess || hipDeviceGetAttribute(&cus, hipDeviceAttributeMultiprocessorCount, dev) != hipSuccess) { grid = -1; return; }
        if (hipFuncSetAttribute((const void*)fwd_kernel, hipFuncAttributeMaxDynamicSharedMemorySize, LDS_BYTES) != hipSuccess) { fprintf(stderr, "kernel_launch: hipFuncSetAttribute failed\n"); grid = -1; return; }
        if (hipOccupancyMaxActiveBlocksPerMultiprocessor(&per_cu, (const void*)fwd_kernel, NTHREADS, LDS_BYTES) != hipSuccess || per_cu < 1) { fprintf(stderr, "kernel_launch: occupancy query says %d blocks per CU\n", per_cu); per_cu = 1; }
        (void)hipGetLastError();
        grid = cus;
    }
    if (grid < 0) return;
    Args a{};
    for (int i = 0; i < 32; ++i) a.in[i] = (const float*)d_in[i];
    a.out = (float*)d_out; a.ws = (unsigned char*)d_ws;
#if ONE_LAUNCH
    a.ph_lo = 0; a.ph_hi = N_PHASES;
    void* kargs[] = { &a };
    hipError_t e = hipLaunchCooperativeKernel((const void*)fwd_kernel, dim3(grid), dim3(NTHREADS), kargs, LDS_BYTES, stream);
    if (e != hipSuccess) fprintf(stderr, "kernel_launch: cooperative launch failed: %s (grid %d)\n", hipGetErrorString(e), grid);
#else
    for (int ph = 0; ph < N_PHASES; ++ph) {
        a.ph_lo = ph; a.ph_hi = ph + 1;
        hipLaunchKernelGGL(fwd_kernel, dim3(grid), dim3(NTHREADS), LDS_BYTES, stream, a);
    }
#endif
}
```

```cpp
#include <hip/hip_runtime.h>
#include <hip/hip_cooperative_groups.h>
#include <cstdio>
#include <cstdint>
#include <type_traits>
namespace cg = cooperative_groups;

#ifndef ONE_LAUNCH
#define ONE_LAUNCH 1
#endif
#ifndef REP_STAGE
#define REP_STAGE 0
#endif
#ifndef REP_SGU
#define REP_SGU 1
#endif
#ifndef REP_GLAA
#define REP_GLAA 1
#endif
#ifndef REP_CONV
#define REP_CONV 1
#endif
#ifndef REP_PREP
#define REP_PREP 1
#endif
#ifndef REPEAT_PH
#define REPEAT_PH 0
#endif

#ifndef PH_MASK
#define PH_MASK 0xFFFF
#endif
#define PHK(b) (((PH_MASK) >> (b)) & 1)
#define LAS __attribute__((address_space(3)))
typedef unsigned short bf16_t;
typedef short bf16x8 __attribute__((ext_vector_type(8)));
typedef float f32x4 __attribute__((ext_vector_type(4)));
typedef float f32x2 __attribute__((ext_vector_type(2)));
typedef float f32x16 __attribute__((ext_vector_type(16)));
typedef unsigned u32x4 __attribute__((ext_vector_type(4)));
typedef unsigned u32x2 __attribute__((ext_vector_type(2)));
typedef LAS float lfloat;

constexpr int BATCH = 4, SEQ = 8192, D = 1024, FF = 4096;
constexpr int M = BATCH * SEQ;
constexpr int NP = 2816;
constexpr float RMS_EPS = 1e-6f, LN_EPS = 1e-5f, GN_EPS = 64e-5f;
constexpr int EC_Q = 0, EC_K = 256, EC_V = 512, EC_G = 1024, EC_U = 1536, EC_SV = 2048, EC_Z = 2560;
constexpr int OC_R = 0, OC_K = 512, OC_V = 1024, OC_CA = 1536, OC_CG = 2048, OC_XW = 2560, OC_XA = 2592, OC_XG = 2624;

constexpr size_t MiB = 1u << 20;
constexpr size_t WS_WIN0 = 2 * MiB, WS_WOUT0 = 8 * MiB, WS_WUP0 = 10 * MiB, WS_WDN0 = 18 * MiB;
constexpr size_t WS_WIN1 = 26 * MiB, WS_WOUT1 = 32 * MiB, WS_WUP1 = 34 * MiB, WS_WDN1 = 42 * MiB;
constexpr size_t WS_CTL = 0;
constexpr size_t WS_TAB = 1 * MiB;
constexpr size_t TAB_W2T = 0, TAB_A2T = 65536, TAB_G2T = 131072, TAB_CWT = 327680, TAB_GA2T = 393216, TAB_W2TB = 409600, TAB_A2TB = 442368, TAB_G2TB = 475136, TAB_SGUW = 589824;
constexpr size_t WS_SSP = 50 * MiB;
constexpr size_t WS_XN = 52 * MiB;
constexpr size_t WS_X = 436 * MiB;
constexpr size_t WS_MIX = 116 * MiB;
constexpr size_t WS_P = 180 * MiB;
constexpr size_t WS_H = 180 * MiB;
constexpr size_t WS_FREE = 436 * MiB;
constexpr size_t WS_END = 512 * MiB;
constexpr size_t WS_GLA_ST = WS_XN;
constexpr size_t WS_GLA_DL = 500 * MiB;
constexpr size_t WS_GLA_GD = WS_GLA_DL + 512 * 1024;
constexpr size_t WS_GLA_GL = WS_XN + 32 * MiB;
constexpr size_t WS_R_GP = WS_XN, WS_R_RP = WS_XN + 32 * MiB;
constexpr size_t WS_R_HADD = 356 * MiB, WS_R_Y0 = 388 * MiB;
constexpr size_t OUT_R_Y = 0, OUT_R_GC = 32 * MiB, OUT_R_BVF = 34 * MiB;
static_assert(WS_P + (size_t)M * NP * 2 <= WS_R_HADD, "P vs rwkv scratch");
static_assert(WS_R_Y0 + 32 * MiB <= WS_X && WS_X + 64 * MiB <= WS_GLA_DL && WS_GLA_DL + MiB <= WS_END, "ws map");

constexpr int NWAVES = 8, NTHREADS = 512;
constexpr int LDS_BYTES = 147456;

__device__ __forceinline__ float bf2f(unsigned v) { return __uint_as_float(v << 16); }
__device__ __forceinline__ unsigned f2bf(float f) { unsigned u = __float_as_uint(f); return (u + 0x7fffu + ((u >> 16) & 1u)) >> 16; }
__device__ __forceinline__ unsigned pk2(float lo, float hi) { return f2bf(lo) | (f2bf(hi) << 16); }
__device__ __forceinline__ float sigmoidf_(float x) { return 1.0f / (1.0f + __expf(-x)); }
__device__ __forceinline__ float fsigmoid(float x) { return __builtin_amdgcn_rcpf(1.0f + __expf(-x)); }
__device__ __forceinline__ float ftanh(float x) { return 1.0f - 2.0f * __builtin_amdgcn_rcpf(1.0f + __expf(2.0f * x)); }
__device__ __forceinline__ float silu_fast(float x) { return x * fsigmoid(x); }
__device__ __forceinline__ float siluf_(float x) { return x * sigmoidf_(x); }
__device__ __forceinline__ float geluf_(float x) { const float u = 1.5957691216057308f * (x + 0.044715f * x * x * x); return x * sigmoidf_(u); }
__device__ __forceinline__ float logsigmoidf_(float z) { return fminf(z, 0.f) - __logf(1.0f + __expf(-fabsf(z))); }
__device__ __forceinline__ float wave_sum(float v) {
#pragma unroll
    for (int o = 1; o < 64; o <<= 1) v += __shfl_xor(v, o);
    return v;
}
__device__ __forceinline__ void unpack8(const u32x4 w, float* f) {
    f[0] = bf2f(w.x & 0xffffu); f[1] = __uint_as_float(w.x & 0xffff0000u);
    f[2] = bf2f(w.y & 0xffffu); f[3] = __uint_as_float(w.y & 0xffff0000u);
    f[4] = bf2f(w.z & 0xffffu); f[5] = __uint_as_float(w.z & 0xffff0000u);
    f[6] = bf2f(w.w & 0xffffu); f[7] = __uint_as_float(w.w & 0xffff0000u);
}
__device__ __forceinline__ float ldbf(const bf16_t* p) { return bf2f((unsigned)*p); }

namespace pg8 {
#define PG8_LAS __attribute__((address_space(3)))
constexpr int BM = 256, BK = 64, HALF = 128, HTB = HALF * BK * 2, STAGE_BYTES = 8 * HTB, NXCD = 8, WGM = 8;
__host__ __device__ __forceinline__ int lds_byte(int r, int c) { const int st = (r >> 4) * 2 + (c >> 5), rr = r & 15, cc = c & 31, ob = rr * 64 + cc * 2; return st * 1024 + (ob ^ (((ob >> 9) & 1) << 5)); }
__host__ __device__ __forceinline__ void stage_rc(int b, int& R, int& C) { const int st = b / 1024, sb = b % 1024, swz = sb ^ (((sb >> 9) & 1) << 5); R = (st >> 1) * 16 + swz / 64; C = (st & 1) * 32 + (swz % 64) / 2; }
__host__ __device__ __forceinline__ int perm32(int rho) { const int n = rho >> 4, i = rho & 15; return 8 * (i >> 2) + 4 * n + (i & 3); }

struct Unit { int pm, pn; };
struct Gemm { const bf16_t* A; const bf16_t* Bt; int M, N, K; };
struct StaticOrder {
    int nM, nN, nwg, G, c;
    __host__ __device__ void init(int M_, int N_, int G_, int c_) { nM = M_ / BM; nN = N_ / BM; nwg = nM * nN; G = G_; c = c_; }
    __host__ __device__ bool next(int i, Unit& u) const {
        const long L = (long)i * G + c; if (L >= nwg) return false;
        int wgid = (int)L; { const int q = nwg / NXCD, r = nwg % NXCD, xcd = wgid % NXCD, off = wgid / NXCD; wgid = (xcd < r ? xcd * (q + 1) : r * (q + 1) + (xcd - r) * q) + off; }
        const int nig = WGM * nN, gid = wgid / nig, fm = gid * WGM, gsz = (nM - fm) < WGM ? (nM - fm) : WGM;
        u.pm = fm + ((wgid % nig) % gsz); u.pn = (wgid % nig) / gsz; return true;
    }
    __device__ __forceinline__ void a_ready(const Unit&) const {}
    __device__ __forceinline__ void done(const Unit&) const {}
};
typedef float f32x2_t_ __attribute__((ext_vector_type(2))); typedef __bf16 bf16x2_t_ __attribute__((ext_vector_type(2)));
__device__ __forceinline__ unsigned cvt_pk_bf16(float lo, float hi) { const f32x2_t_ v = {lo, hi}; const bf16x2_t_ b = __builtin_convertvector(v, bf16x2_t_); return __builtin_bit_cast(unsigned, b); }

__device__ __forceinline__ float row_rstd(const float* ssp, int r) {
    const f32x4* p = (const f32x4*)(ssp + (size_t)r * 16);
    const f32x4 a = p[0], b = p[1], c = p[2], d = p[3];
    const float s = ((a[0] + a[1]) + (a[2] + a[3])) + ((b[0] + b[1]) + (b[2] + b[3])) + ((c[0] + c[1]) + (c[2] + c[3])) + ((d[0] + d[1]) + (d[2] + d[3]));
    return 1.0f / sqrtf(s * (1.0f / 1024.0f) + RMS_EPS);
}
struct RstdState { float rs[2][4]; };
__device__ __forceinline__ void rstd_issue(const float* ssp, int row0, int fq, f32x4 (&raw)[2][4]) {
#pragma unroll
    for (int ai = 0; ai < 2; ++ai)
#pragma unroll
        for (int m = 0; m < 4; ++m) raw[ai][m] = *(const f32x4*)(ssp + (size_t)(row0 + ai * HALF + m * 16) * 16 + fq * 4);
}
__device__ __forceinline__ void rstd_finish(const f32x4 (&raw)[2][4], RstdState& st) {
#pragma unroll
    for (int ai = 0; ai < 2; ++ai)
#pragma unroll
        for (int m = 0; m < 4; ++m) { float s = (raw[ai][m][0] + raw[ai][m][1]) + (raw[ai][m][2] + raw[ai][m][3]);
            s += __shfl_xor(s, 16); s += __shfl_xor(s, 32);
            st.rs[ai][m] = __builtin_amdgcn_rsqf(s * (1.0f / 1024.0f) + RMS_EPS); }
}
template <int ACT> struct EpiProj {
    static constexpr bool PERM = true, AFTER_DRAIN = false;
    typedef RstdState State;
    bf16_t* O; int ldc; const float* ssp;
    __device__ __forceinline__ void init(State& st, const Unit& u, int wr, int fr, int fq) const {
        f32x4 raw[2][4]; rstd_issue(ssp, u.pm * BM + wr * 64 + fr, fq, raw); rstd_finish(raw, st);
    }
    __device__ __forceinline__ void operator()(const f32x4 (&acc)[2][2][4][2], State& st, const Unit& u, const Unit& un, bool has_next, int wr, int wc, int fr, int fq) const {
        const int row0 = u.pm * BM + wr * 64 + fr, col0 = u.pn * BM + wc * 32 + 8 * fq;
        f32x4 raw[2][4];
        if (has_next) rstd_issue(ssp, un.pm * BM + wr * 64 + fr, fq, raw);
#pragma unroll
        for (int ai = 0; ai < 2; ++ai)
#pragma unroll
            for (int m = 0; m < 4; ++m) { bf16_t* rowp = O + (size_t)(row0 + ai * HALF + m * 16) * ldc + col0; const float sc = st.rs[ai][m];
#pragma unroll
                for (int bj = 0; bj < 2; ++bj) { f32x4 v0 = acc[ai][bj][m][0] * sc, v1 = acc[ai][bj][m][1] * sc;
                    if (ACT == 1) {
#pragma unroll
                        for (int e = 0; e < 4; ++e) { const float a = fmaxf(v0[e], 0.f), b = fmaxf(v1[e], 0.f); v0[e] = a * a; v1[e] = b * b; } }
                    u32x4 w; w.x = cvt_pk_bf16(v0[0], v0[1]); w.y = cvt_pk_bf16(v0[2], v0[3]); w.z = cvt_pk_bf16(v1[0], v1[1]); w.w = cvt_pk_bf16(v1[2], v1[3]);
                    *(u32x4*)(rowp + bj * HALF) = w; } }
        if (has_next) rstd_finish(raw, st);
    }
};
template <bool BASE_F32> struct EpiRes {
    static constexpr bool PERM = true, AFTER_DRAIN = false;
    struct State {};
    const float* basef; bf16_t* X; float* ssp;
    __device__ __forceinline__ void init(State&, const Unit&, int, int, int) const {}
    __device__ __forceinline__ void operator()(const f32x4 (&acc)[2][2][4][2], State&, const Unit& u, const Unit&, bool, int wr, int wc, int fr, int fq) const {
        const int row0 = u.pm * BM + wr * 64 + fr, col0 = u.pn * BM + wc * 32 + 8 * fq;
#pragma unroll
        for (int ai = 0; ai < 2; ++ai) {
            f32x4 bf_[4][2][2]; u32x4 bb_[4][2];
#pragma unroll
            for (int m = 0; m < 4; ++m) { const size_t off = (size_t)(row0 + ai * HALF + m * 16) * D + col0;
#pragma unroll
                for (int bj = 0; bj < 2; ++bj) { if (BASE_F32) { bf_[m][bj][0] = *(const f32x4*)(basef + off + bj * HALF); bf_[m][bj][1] = *(const f32x4*)(basef + off + bj * HALF + 4); } else bb_[m][bj] = *(const u32x4*)(X + off + bj * HALF); } }
            float ssm[4];
#pragma unroll
            for (int m = 0; m < 4; ++m) { const int r = row0 + ai * HALF + m * 16; const size_t off = (size_t)r * D + col0; float ss = 0.f;
#pragma unroll
                for (int bj = 0; bj < 2; ++bj) { f32x4 b0, b1;
                    if (BASE_F32) { b0 = bf_[m][bj][0]; b1 = bf_[m][bj][1]; }
                    else { const u32x4 bw = bb_[m][bj];
                        b0 = (f32x4){bf2f(bw.x & 0xffffu), __uint_as_float(bw.x & 0xffff0000u), bf2f(bw.y & 0xffffu), __uint_as_float(bw.y & 0xffff0000u)};
                        b1 = (f32x4){bf2f(bw.z & 0xffffu), __uint_as_float(bw.z & 0xffff0000u), bf2f(bw.w & 0xffffu), __uint_as_float(bw.w & 0xffff0000u)}; }
                    const f32x4 v0 = b0 + acc[ai][bj][m][0], v1 = b1 + acc[ai][bj][m][1];
                    ss += ((v0[0] * v0[0] + v0[1] * v0[1]) + (v0[2] * v0[2] + v0[3] * v0[3])) + ((v1[0] * v1[0] + v1[1] * v1[1]) + (v1[2] * v1[2] + v1[3] * v1[3]));
                    u32x4 w; w.x = cvt_pk_bf16(v0[0], v0[1]); w.y = cvt_pk_bf16(v0[2], v0[3]); w.z = cvt_pk_bf16(v1[0], v1[1]); w.w = cvt_pk_bf16(v1[2], v1[3]);
                    *(u32x4*)(X + off + bj * HALF) = w; }
                ss += __shfl_xor(ss, 16); ss += __shfl_xor(ss, 32);
                ssm[m] = ss; }
            { const float sv = fq == 0 ? ssm[0] : fq == 1 ? ssm[1] : fq == 2 ? ssm[2] : ssm[3];
              ssp[(size_t)(row0 + ai * HALF + fq * 16) * 16 + u.pn * 4 + wc] = sv; }
        }
    }
};

template <class Epi, class Sched, bool ALIGN_EPI = false, bool SP2 = false>
__device__ __forceinline__ void gemm_phase(PG8_LAS unsigned char* lds, const int tid, const Gemm g, const Sched& S, const Epi& E) {
    const int wid = __builtin_amdgcn_readfirstlane(tid >> 6), lane = tid & 63, wr = wid >> 2, wc = wid & 3, fr = lane & 15, fq = lane >> 4;
    const int K = g.K, nt = K / BK;
    unsigned voffA[2], voffB[2];
#pragma unroll
    for (int i = 0; i < 2; ++i) { int R, C; stage_rc(tid * 16 + i * 8192, R, C); const int Rb = Epi::PERM ? ((R & ~31) + perm32(R & 31)) : R;
        voffA[i] = (unsigned)(R * K + C) * 2u; voffB[i] = (unsigned)(Rb * K + C) * 2u; }
    const size_t kstep = (size_t)(BK * 2);
    const size_t hstep = (size_t)HALF * K * 2;
    const size_t tstep = 2 * hstep;
    const unsigned ldsw = (unsigned)wid * 1024u;
    const int aoff = lds_byte(wr * 64 + fr, fq * 8), boff = lds_byte(wc * 32 + fr, fq * 8);
#define PG8_SA(b, h) (((b) * 2 + (h)) * HTB)
#define PG8_SB(b, h) ((4 + (b) * 2 + (h)) * HTB)
#define PG8_STAGE(bufoff, gbase, voff) do { _Pragma("unroll") for (int _i = 0; _i < 2; ++_i) \
        __builtin_amdgcn_global_load_lds((const unsigned*)((const char*)(gbase) + (voff)[_i]), (PG8_LAS unsigned*)(lds + (bufoff) + ldsw + _i * 8192), 16, 0, 0); } while (0)
#define PG8_LDA(dst, b, h) do { _Pragma("unroll") for (int m = 0; m < 4; ++m) _Pragma("unroll") for (int k = 0; k < 2; ++k) dst[m][k] = *(const PG8_LAS bf16x8*)(lds + PG8_SA(b, h) + aoff + m * 2048 + k * 1024); } while (0)
#define PG8_LDB(dst, b, h) do { _Pragma("unroll") for (int n = 0; n < 2; ++n) _Pragma("unroll") for (int k = 0; k < 2; ++k) dst[n][k] = *(const PG8_LAS bf16x8*)(lds + PG8_SB(b, h) + boff + n * 2048 + k * 1024); } while (0)
#define PG8_MMA(ai, bj, At, Bt) do { __builtin_amdgcn_s_setprio(1); _Pragma("unroll") for (int m = 0; m < 4; ++m) _Pragma("unroll") for (int n = 0; n < 2; ++n) _Pragma("unroll") for (int k = 0; k < 2; ++k) \
        acc[ai][bj][m][n] = __builtin_amdgcn_mfma_f32_16x16x32_bf16(Bt[n][k], At[m][k], acc[ai][bj][m][n], 0, 0, 0); __builtin_amdgcn_s_setprio(0); } while (0)
#define PG8_WAIT_V(n) asm volatile("s_waitcnt vmcnt(" #n ")" ::: "memory")
#define PG8_WAIT_L(n) asm volatile("s_waitcnt lgkmcnt(" #n ")" ::: "memory")
#define PG8_BAR __builtin_amdgcn_s_barrier()
#define PG8_SCHED __builtin_amdgcn_sched_barrier(0)
    Unit cur, nxt; int ui = 0;
    if (!S.next(0, cur)) return;
    f32x4 acc[2][2][4][2];
#pragma unroll
    for (int a = 0; a < 2; ++a)
#pragma unroll
        for (int b = 0; b < 2; ++b)
#pragma unroll
            for (int m = 0; m < 4; ++m)
#pragma unroll
                for (int n = 0; n < 2; ++n) acc[a][b][m][n] = (f32x4){0.f, 0.f, 0.f, 0.f};
    bf16x8 At[4][2], B0[2][2], B1[2][2];
    const char* cA = (const char*)g.A + (size_t)cur.pm * tstep; const char* cB = (const char*)g.Bt + (size_t)cur.pn * tstep;
    S.a_ready(cur);
    typename Epi::State est; E.init(est, cur, wr, fr, fq);
    if constexpr (SP2) {
        PG8_STAGE(PG8_SB(0, 0), cB, voffB); PG8_STAGE(PG8_SB(0, 1), cB + hstep, voffB); PG8_STAGE(PG8_SA(0, 0), cA, voffA); PG8_STAGE(PG8_SA(0, 1), cA + hstep, voffA);
        if (wr == 1) PG8_BAR;
        PG8_WAIT_V(2); PG8_BAR;
        PG8_STAGE(PG8_SB(1, 0), cB + kstep, voffB); PG8_STAGE(PG8_SA(1, 0), cA + kstep, voffA); PG8_STAGE(PG8_SB(1, 1), cB + hstep + kstep, voffB);
        PG8_WAIT_V(6); PG8_BAR;
    } else {
        PG8_STAGE(PG8_SB(0, 0), cB, voffB); PG8_STAGE(PG8_SA(0, 0), cA, voffA); PG8_STAGE(PG8_SB(0, 1), cB + hstep, voffB); PG8_STAGE(PG8_SA(0, 1), cA + hstep, voffA);
        if (wr == 1) PG8_BAR;
        PG8_WAIT_V(4); PG8_BAR;
        PG8_STAGE(PG8_SB(1, 0), cB + kstep, voffB); PG8_STAGE(PG8_SA(1, 0), cA + kstep, voffA); PG8_STAGE(PG8_SB(1, 1), cB + hstep + kstep, voffB);
        PG8_WAIT_V(6); PG8_BAR;
    }
    for (;;) {
        const bool has_next = S.next(ui + 1, nxt);
        const char* nA = has_next ? (const char*)g.A + (size_t)nxt.pm * tstep : cA; const char* nB = has_next ? (const char*)g.Bt + (size_t)nxt.pn * tstep : cB;
        for (int t = 0; t < nt; t += 2) {
            const bool last = (t == nt - 2);
            const char* a1 = cA + (size_t)(t + 1) * kstep;
            const char* a2 = last ? nA : cA + (size_t)(t + 2) * kstep; const char* b2 = last ? nB : cB + (size_t)(t + 2) * kstep;
            const char* a3 = a2 + kstep; const char* b3 = b2 + kstep;
            if (last && has_next) S.a_ready(nxt);
            if constexpr (SP2) {
            PG8_LDB(B0, 0, 0); PG8_LDB(B1, 0, 1); PG8_SCHED; PG8_LDA(At, 0, 0); PG8_STAGE(PG8_SA(1, 1), a1 + hstep, voffA);
            PG8_WAIT_V(8); PG8_WAIT_L(0); PG8_BAR; PG8_MMA(0, 0, At, B0); PG8_MMA(0, 1, At, B1); PG8_BAR; PG8_SCHED;
            PG8_LDA(At, 0, 1); PG8_STAGE(PG8_SB(0, 0), b2, voffB); PG8_STAGE(PG8_SB(0, 1), b2 + hstep, voffB); PG8_STAGE(PG8_SA(0, 0), a2, voffA);
            PG8_WAIT_V(8); PG8_WAIT_L(0); PG8_BAR; PG8_MMA(1, 0, At, B0); PG8_MMA(1, 1, At, B1); PG8_BAR; PG8_SCHED;
            PG8_LDB(B0, 1, 0); PG8_LDB(B1, 1, 1); PG8_SCHED; PG8_LDA(At, 1, 0); PG8_STAGE(PG8_SA(0, 1), a2 + hstep, voffA);
            PG8_WAIT_V(8); PG8_WAIT_L(0); PG8_BAR; PG8_MMA(0, 0, At, B0); PG8_MMA(0, 1, At, B1); PG8_BAR; PG8_SCHED;
            PG8_LDA(At, 1, 1); PG8_STAGE(PG8_SB(1, 0), b3, voffB); PG8_STAGE(PG8_SB(1, 1), b3 + hstep, voffB); PG8_STAGE(PG8_SA(1, 0), a3, voffA);
            PG8_WAIT_V(8); PG8_WAIT_L(0); PG8_BAR; PG8_MMA(1, 0, At, B0); PG8_MMA(1, 1, At, B1); PG8_BAR; PG8_SCHED;
            } else {
            PG8_LDB(B0, 0, 0); PG8_SCHED; PG8_LDA(At, 0, 0); PG8_STAGE(PG8_SA(1, 1), a1 + hstep, voffA);
            PG8_WAIT_L(8); PG8_BAR; PG8_WAIT_L(0); PG8_MMA(0, 0, At, B0); PG8_BAR; PG8_SCHED;
            PG8_LDB(B1, 0, 1); PG8_STAGE(PG8_SB(0, 0), b2, voffB);
            PG8_BAR; PG8_WAIT_L(0); PG8_MMA(0, 1, At, B1); PG8_BAR;
            PG8_LDA(At, 0, 1); PG8_STAGE(PG8_SA(0, 0), a2, voffA);
            PG8_BAR; PG8_WAIT_L(0); PG8_MMA(1, 0, At, B0); PG8_BAR; PG8_SCHED;
            PG8_STAGE(PG8_SB(0, 1), b2 + hstep, voffB);
            PG8_WAIT_V(6); PG8_BAR; PG8_MMA(1, 1, At, B1); PG8_BAR;
            PG8_LDB(B0, 1, 0); PG8_SCHED; PG8_LDA(At, 1, 0); PG8_STAGE(PG8_SA(0, 1), a2 + hstep, voffA);
            PG8_WAIT_L(8); PG8_BAR; PG8_WAIT_L(0); PG8_MMA(0, 0, At, B0); PG8_BAR; PG8_SCHED;
            PG8_LDB(B1, 1, 1); PG8_STAGE(PG8_SB(1, 0), b3, voffB);
            PG8_BAR; PG8_WAIT_L(0); PG8_MMA(0, 1, At, B1); PG8_BAR;
            PG8_LDA(At, 1, 1); PG8_STAGE(PG8_SA(1, 0), a3, voffA);
            PG8_BAR; PG8_WAIT_L(0); PG8_MMA(1, 0, At, B0); PG8_BAR; PG8_SCHED;
            PG8_STAGE(PG8_SB(1, 1), b3 + hstep, voffB);
            PG8_WAIT_V(6); PG8_BAR; PG8_MMA(1, 1, At, B1); PG8_BAR;
            }
        }
        if constexpr (ALIGN_EPI) { if (wr == 0) PG8_BAR; }
        if constexpr (!Epi::AFTER_DRAIN) { E(acc, est, cur, nxt, has_next, wr, wc, fr, fq); S.done(cur); }
        if (!has_next) break;
#pragma unroll
        for (int a = 0; a < 2; ++a)
#pragma unroll
            for (int b = 0; b < 2; ++b)
#pragma unroll
                for (int m = 0; m < 4; ++m)
#pragma unroll
                    for (int n = 0; n < 2; ++n) acc[a][b][m][n] = (f32x4){0.f, 0.f, 0.f, 0.f};
        cur = nxt; cA = nA; cB = nB; ++ui;
        if constexpr (ALIGN_EPI) { if (wr == 1) PG8_BAR; }
    }
    PG8_WAIT_V(0);
    if constexpr (!ALIGN_EPI) { if (wr == 0) PG8_BAR; }
    PG8_BAR;
#undef PG8_SA
#undef PG8_SB
#undef PG8_STAGE
#undef PG8_LDA
#undef PG8_LDB
#undef PG8_MMA
#undef PG8_WAIT_V
#undef PG8_WAIT_L
#undef PG8_BAR
#undef PG8_SCHED
}
}


#define XB_TMO      128
#define XB_XCNT(j)  (256  + 64 * (j))
#define XB_XSUB(j)  (1280 + 64 * (j))
#define XB_XGEN(j)  (2304 + 64 * (j))
#define XB_TOP      3328
#define XB_TOPGEN   3392
#define XCD_BAR_WORDS 3456
#define XB_SPIN_CAP (1u << 18)
__device__ __forceinline__ unsigned xb_ld(unsigned* p)              { return __hip_atomic_load(p, __ATOMIC_RELAXED, __HIP_MEMORY_SCOPE_AGENT); }
__device__ __forceinline__ unsigned xb_add(unsigned* p, unsigned v) { return __hip_atomic_fetch_add(p, v, __ATOMIC_RELAXED, __HIP_MEMORY_SCOPE_AGENT); }
__device__ __forceinline__ unsigned xb_xcc_id() { return (unsigned)__builtin_amdgcn_s_getreg((3 << 11) | 20) & 0xFu; }
#define XB_SPIN(cond, bar) do { unsigned _sp = 0; while (cond) { __builtin_amdgcn_s_sleep(1); \
    if ((++_sp & 255u) == 0u) { if (xb_ld(&(bar)[XB_TMO])) break; if (_sp > XB_SPIN_CAP) { atomicAdd(&(bar)[XB_TMO], 1u); break; } } } } while (0)
struct XcdBarrier { unsigned* bar; unsigned x; volatile LAS unsigned* st; };
__device__ __forceinline__ XcdBarrier xcd_barrier_post(unsigned* bar, volatile LAS unsigned* st) {
    XcdBarrier b; b.bar = bar; b.x = xb_xcc_id(); b.st = st;
    if (threadIdx.x == 0) (void)xb_add(&bar[XB_XCNT(b.x)], 1u);
    return b;
}
__device__ __forceinline__ void xcd_barrier_complete(unsigned* bar, unsigned x, unsigned& nloc, unsigned& nx) {
    const unsigned G = gridDim.x * gridDim.y * gridDim.z;
    unsigned sum, cnt, mine, sp = 0u;
    for (;;) {
        sum = 0u; cnt = 0u; mine = 0u;
#pragma unroll
        for (unsigned j = 0; j < 16; ++j) { const unsigned c = xb_ld(&bar[XB_XCNT(j)]); sum += c; cnt += (c > 0u) ? 1u : 0u; mine = (j == x) ? c : mine; }
        if (sum == G) break;
        __builtin_amdgcn_s_sleep(1);
        if ((++sp & 255u) == 0u) { if (xb_ld(&bar[XB_TMO])) break; if (sp > XB_SPIN_CAP) { atomicAdd(&bar[XB_TMO], 1u); break; } }
    }
    nloc = mine > 0u ? mine : 1u; nx = cnt > 0u ? cnt : 1u;
}
__device__ __forceinline__ void xcd_barrier(const XcdBarrier& b) {
    asm volatile("s_waitcnt vmcnt(0)" ::: "memory");
    __syncthreads();
    if (threadIdx.x == 0) {
        unsigned* bar = b.bar;
        __builtin_amdgcn_s_waitcnt(0);
        asm volatile("buffer_inv sc1" ::: "memory");
        unsigned nloc = b.st[0], nx = b.st[1];
        if (nloc == 0u) { xcd_barrier_complete(bar, b.x, nloc, nx); b.st[0] = nloc; b.st[1] = nx; }
        const unsigned old = xb_add(&bar[XB_XSUB(b.x)], 1u);
        const unsigned gen = old / nloc;
        if (old + 1u == (gen + 1u) * nloc) {
            __builtin_amdgcn_fence(__ATOMIC_RELEASE, "agent");
            asm volatile("s_waitcnt vmcnt(0)" ::: "memory");
            const unsigned og = xb_add(&bar[XB_TOP], 1u);
            const unsigned tg = og / nx;
            if (og + 1u == (tg + 1u) * nx) xb_add(&bar[XB_TOPGEN], 1u);
            else XB_SPIN(xb_ld(&bar[XB_TOPGEN]) == tg, bar);
            xb_add(&bar[XB_XGEN(b.x)], 1u);
            asm volatile("s_waitcnt vmcnt(0)" ::: "memory");
        } else {
            XB_SPIN(xb_ld(&bar[XB_XGEN(b.x)]) == gen, bar);
            asm volatile("s_waitcnt vmcnt(0)" ::: "memory");
        }
    }
    __syncthreads();
}

struct Args { const float* in[32]; float* out; unsigned char* ws; int ph_lo, ph_hi; };
enum { I_X = 0, I_NORM_MIX, I_NORM_FFN, I_W_UP, I_W_DOWN, I_NORM_FINAL, I_EVEN_W_IN, I_EVEN_W_OUT, I_GLA_W_ALPHA2, I_GLA_B_ALPHA, I_GLA_NORM,
       I_SGU_LN_G, I_SGU_LN_B, I_SGU_W, I_SGU_B, I_ODD_W_IN, I_ODD_W_OUT, I_RWKV_MU, I_RWKV_W0, I_RWKV_W2, I_RWKV_A0, I_RWKV_A2, I_RWKV_G2,
       I_RWKV_K_K, I_RWKV_K_A, I_RWKV_R_K, I_RWKV_GN_G, I_RWKV_GN_B, I_CONV_W, I_CONV_B, I_CONV_LN_G, I_CONV_LN_B };

struct Ctx { LAS unsigned char* lds; int tid, lane, wave, bid, nblk; };
__device__ __forceinline__ Ctx mk_ctx(LAS unsigned char* lds) { Ctx C; C.lds = lds; int t = threadIdx.x, b = blockIdx.x, g = gridDim.x; asm volatile("" : "+v"(t), "+s"(b), "+s"(g));
    C.tid = t; C.lane = t & 63; C.wave = __builtin_amdgcn_readfirstlane(t >> 6); C.bid = b; C.nblk = g; return C; }
typedef __attribute__((address_space(4))) const Args CArgs;
__device__ __forceinline__ CArgs* get_args() { CArgs* p = (CArgs*)__builtin_amdgcn_kernarg_segment_ptr(); asm volatile("" : "+s"(p)); return p; }

template <int MODE> __device__ __forceinline__ int colmap(int n) {
    if (MODE == 0) return n;
    if (MODE == 1) return n < 1536 ? n : (n < 2560 ? n + 16 : -2);
    return n < 1536 ? n : (n < 2560 ? n + 160 : (n < 2720 ? n - 1024 : -1));
}
template <int MODE> __device__ __forceinline__ void p0_transpose_item(const float* W, const float* gain, int K, int Nsrc, int Ndst, bf16_t* WT, LAS float* scr, int item, int lane) {
    const int nblk = Ndst / 32, kb = item / nblk, nb = item % nblk, k0 = 64 * kb, n0 = 32 * nb;
    const int src = colmap<MODE>(n0 + (lane & 31));
    if (MODE == 1 && n0 >= 2560) return;
    float wv_[32];
#pragma unroll
    for (int i = 0; i < 32; ++i) { const int kk = 2 * i + (lane >> 5); wv_[i] = src >= 0 ? W[(size_t)(k0 + kk) * Nsrc + src] : 0.f; }
    if (gain) {
#pragma unroll
        for (int i = 0; i < 32; ++i) wv_[i] *= gain[k0 + 2 * i + (lane >> 5)]; }
#pragma unroll
    for (int i = 0; i < 32; ++i) scr[(2 * i + (lane >> 5)) * 33 + (lane & 31)] = wv_[i];
    asm volatile("s_waitcnt lgkmcnt(0)" ::: "memory");
    const int c = lane & 7;
#pragma unroll
    for (int j = 0; j < 4; ++j) { const int n = (lane >> 3) + 8 * j; const LAS float* s = scr + (8 * c) * 33 + n;
        u32x4 o; o.x = pk2(s[0 * 33], s[1 * 33]); o.y = pk2(s[2 * 33], s[3 * 33]); o.z = pk2(s[4 * 33], s[5 * 33]); o.w = pk2(s[6 * 33], s[7 * 33]);
        *(u32x4*)(WT + (size_t)(n0 + n) * K + k0 + 8 * c) = o; }
    asm volatile("s_waitcnt lgkmcnt(0)" ::: "memory");
}
constexpr int I_IN = (D / 64) * (NP / 32), I_OUT = (D / 64) * (D / 32), I_UP = (D / 64) * (FF / 32), I_DN = (FF / 64) * (D / 32);
constexpr int PER_LAYER = I_IN + I_OUT + I_UP + I_DN;
__device__ __forceinline__ void p0_weights(const Ctx& C, CArgs& a, int lo, int hi, int gw, int NGW) {
    LAS float* scr = (LAS float*)(C.lds + C.wave * 16384);
    unsigned char* ws = a.ws;
    for (int it = lo + gw; it < hi; it += NGW) {
        const int layer = it / PER_LAYER; int r = it % PER_LAYER;
        if (r < I_IN) { if (layer == 0) p0_transpose_item<1>(a.in[I_EVEN_W_IN], a.in[I_NORM_MIX], D, 2576, NP, (bf16_t*)(ws + WS_WIN0), scr, r, C.lane);
                        else p0_transpose_item<2>(a.in[I_ODD_W_IN], a.in[I_NORM_MIX] + D, D, 2720, NP, (bf16_t*)(ws + WS_WIN1), scr, r, C.lane); continue; } r -= I_IN;
        if (r < I_OUT) { p0_transpose_item<0>(layer == 0 ? a.in[I_EVEN_W_OUT] : a.in[I_ODD_W_OUT], nullptr, D, D, D, (bf16_t*)(ws + (layer == 0 ? WS_WOUT0 : WS_WOUT1)), scr, r, C.lane); continue; } r -= I_OUT;
        if (r < I_UP) { p0_transpose_item<0>(a.in[I_W_UP] + (size_t)layer * D * FF, a.in[I_NORM_FFN] + layer * D, D, FF, FF, (bf16_t*)(ws + (layer == 0 ? WS_WUP0 : WS_WUP1)), scr, r, C.lane); continue; } r -= I_UP;
        p0_transpose_item<0>(a.in[I_W_DOWN] + (size_t)layer * FF * D, nullptr, FF, D, D, (bf16_t*)(ws + (layer == 0 ? WS_WDN0 : WS_WDN1)), scr, r, C.lane);
    }
}
__device__ __forceinline__ void p0_prologue(const Ctx& C, CArgs& a) {
    const int gw = C.bid * NWAVES + C.wave, NGW = C.nblk * NWAVES;
    unsigned char* ws = a.ws;
    p0_weights(C, a, 0, I_IN, gw, NGW);
    { const int gt = C.bid * NTHREADS + C.tid, NGT = C.nblk * NTHREADS; float* tab = (float*)(ws + WS_TAB);
      for (int i = gt; i < 512 * 32; i += NGT) { const int c = i >> 5, j = i & 31; tab[TAB_W2T / 4 + i] = a.in[I_RWKV_W2][j * 512 + c]; tab[TAB_A2T / 4 + i] = a.in[I_RWKV_A2][j * 512 + c];
          ((bf16_t*)(ws + WS_TAB + TAB_W2TB))[i] = (bf16_t)f2bf(a.in[I_RWKV_W2][j * 512 + c]); ((bf16_t*)(ws + WS_TAB + TAB_A2TB))[i] = (bf16_t)f2bf(a.in[I_RWKV_A2][j * 512 + c]);
          tab[TAB_CWT / 4 + i] = j < 31 ? a.in[I_CONV_W][j * 512 + c] : 0.f; }
      for (int i = gt; i < 512 * 96; i += NGT) { const int c = i / 96, j = i % 96; tab[TAB_G2T / 4 + i] = a.in[I_RWKV_G2][j * 512 + c]; ((bf16_t*)(ws + WS_TAB + TAB_G2TB))[i] = (bf16_t)f2bf(a.in[I_RWKV_G2][j * 512 + c]); }
      for (int i = gt; i < 256 * 128; i += NGT) { const int n = i >> 7, k8 = i & 127; float wa[16];
#pragma unroll
          for (int j = 0; j < 16; ++j) wa[j] = a.in[I_GLA_W_ALPHA2][j * 256 + n];
          unsigned o[4];
#pragma unroll
          for (int e = 0; e < 8; ++e) { const int k = 8 * k8 + e; const f32x4* wr = (const f32x4*)(a.in[I_EVEN_W_IN] + (size_t)k * 2576 + 1536); float acc = 0.f;
#pragma unroll
              for (int j4 = 0; j4 < 4; ++j4) { const f32x4 v = wr[j4]; acc += v[0] * wa[4 * j4] + v[1] * wa[4 * j4 + 1] + v[2] * wa[4 * j4 + 2] + v[3] * wa[4 * j4 + 3]; }
              acc *= a.in[I_NORM_MIX][k];
              if (e & 1) o[e >> 1] |= f2bf(acc) << 16; else o[e >> 1] = f2bf(acc); }
          *(u32x4*)((bf16_t*)(ws + WS_WIN0) + (size_t)(2560 + n) * D + 8 * k8) = (u32x4){o[0], o[1], o[2], o[3]}; }
      for (int i = gt; i < 4 * 128 * 128; i += NGT) { const int t = (i >> 7) & 127, sx = i & 127; ((bf16_t*)(ws + WS_TAB + TAB_SGUW))[i] = (bf16_t)f2bf(sx <= t ? a.in[I_SGU_W][i] : 0.f); } }
    const float* x = a.in[I_X]; bf16_t* X = (bf16_t*)(ws + WS_X); float* SSP = (float*)(ws + WS_SSP);
    for (int m = gw; m < M; m += 2 * NGW) {
        const int m2 = m + NGW; const bool has2 = m2 < M;
        const f32x4* xr = (const f32x4*)(x + (size_t)m * D) + 2 * C.lane; const f32x4* xr2 = (const f32x4*)(x + (size_t)(has2 ? m2 : m) * D) + 2 * C.lane; f32x4 v[4], v2[4]; float s = 0.f, s2 = 0.f;
#pragma unroll
        for (int j = 0; j < 4; ++j) { v[j] = xr[128 * (j >> 1) + (j & 1)]; v2[j] = xr2[128 * (j >> 1) + (j & 1)]; }
#pragma unroll
        for (int j = 0; j < 4; ++j) { s += (v[j][0] * v[j][0] + v[j][1] * v[j][1]) + (v[j][2] * v[j][2] + v[j][3] * v[j][3]); s2 += (v2[j][0] * v2[j][0] + v2[j][1] * v2[j][1]) + (v2[j][2] * v2[j][2] + v2[j][3] * v2[j][3]); }
        s = wave_sum(s); s2 = wave_sum(s2);
        u32x4* o8 = (u32x4*)(X + (size_t)m * D) + C.lane;
#pragma unroll
        for (int j = 0; j < 2; ++j) { u32x4 w; w.x = pk2(v[2 * j][0], v[2 * j][1]); w.y = pk2(v[2 * j][2], v[2 * j][3]); w.z = pk2(v[2 * j + 1][0], v[2 * j + 1][1]); w.w = pk2(v[2 * j + 1][2], v[2 * j + 1][3]); o8[64 * j] = w; }
        if (C.lane < 16) SSP[(size_t)m * 16 + C.lane] = (C.lane == 0) ? s : 0.f;
        if (has2) { u32x4* o82 = (u32x4*)(X + (size_t)m2 * D) + C.lane;
#pragma unroll
            for (int j = 0; j < 2; ++j) { u32x4 w; w.x = pk2(v2[2 * j][0], v2[2 * j][1]); w.y = pk2(v2[2 * j][2], v2[2 * j][3]); w.z = pk2(v2[2 * j + 1][0], v2[2 * j + 1][1]); w.w = pk2(v2[2 * j + 1][2], v2[2 * j + 1][3]); o82[64 * j] = w; }
            if (C.lane < 16) SSP[(size_t)m2 * 16 + C.lane] = (C.lane == 0) ? s2 : 0.f; }
    }
}

constexpr int RP = 72;
__device__ __forceinline__ bf16x8 ldfrag(LAS unsigned char* lds, int base, int row, int col) { return *(const LAS bf16x8*)(lds + base + (row * RP + col) * 2); }
__device__ __forceinline__ bf16x8 ldfrag2(LAS unsigned char* lds, int base, int pitch, int row, int c0, int c1) {
    const u32x2 lo = *(const LAS u32x2*)(lds + base + (row * pitch + c0) * 2), hi = *(const LAS u32x2*)(lds + base + (row * pitch + c1) * 2);
    const u32x4 w = (u32x4){lo.x, lo.y, hi.x, hi.y}; return __builtin_bit_cast(bf16x8, w);
}
__device__ __forceinline__ bf16x8 ldfrag_lo(LAS unsigned char* lds, int base, int pitch, int row, int c0) {
    const u32x2 lo = *(const LAS u32x2*)(lds + base + (row * pitch + c0) * 2); const u32x4 w = (u32x4){lo.x, lo.y, 0u, 0u}; return __builtin_bit_cast(bf16x8, w);
}
__device__ __forceinline__ bf16x8 mkfrag(const f32x4 lo, const f32x4 hi) { const u32x4 w = (u32x4){pg8::cvt_pk_bf16(lo[0], lo[1]), pg8::cvt_pk_bf16(lo[2], lo[3]), pg8::cvt_pk_bf16(hi[0], hi[1]), pg8::cvt_pk_bf16(hi[2], hi[3])}; return __builtin_bit_cast(bf16x8, w); }
__device__ __forceinline__ bf16x8 mkfrag_lo(const f32x4 lo) { const u32x4 w = (u32x4){pg8::cvt_pk_bf16(lo[0], lo[1]), pg8::cvt_pk_bf16(lo[2], lo[3]), 0u, 0u}; return __builtin_bit_cast(bf16x8, w); }
#define MFMA16(a, b, c) __builtin_amdgcn_mfma_f32_16x16x32_bf16((a), (b), (c), 0, 0, 0)
#define DPP_ADD(v, ctrl) (v) += __int_as_float(__builtin_amdgcn_mov_dpp(__float_as_int(v), (ctrl), 0xF, 0xF, true))
__device__ __forceinline__ float wave_sum_dpp(float v) {
    DPP_ADD(v, 0xB1); DPP_ADD(v, 0x4E); DPP_ADD(v, 0x141); DPP_ADD(v, 0x140);
    { auto p = __builtin_amdgcn_permlane16_swap(__float_as_uint(v), __float_as_uint(v), false, false); v = __uint_as_float(p[0]) + __uint_as_float(p[1]); }
    { auto p = __builtin_amdgcn_permlane32_swap(__float_as_uint(v), __float_as_uint(v), false, false); v = __uint_as_float(p[0]) + __uint_as_float(p[1]); }
    return v;
}
constexpr int GP_ = 72;
__device__ __forceinline__ void gla_decay(const Ctx& C, CArgs& a, const bf16_t* P, int tok0, int h, LAS float* TOT, float (&bv)[8], float& total) {
    const int col = h * 64 + C.lane; const float ba = a.in[I_GLA_B_ALPHA][col];
    float z[8];
#pragma unroll
    for (int i = 0; i < 8; ++i) z[i] = ldbf(P + (size_t)(tok0 + 8 * C.wave + i) * NP + EC_Z + col);
    float pre = 0.f;
#pragma unroll
    for (int i = 0; i < 8; ++i) { pre += logsigmoidf_(z[i] + ba) * (1.0f / 16.0f); bv[i] = pre; }
    TOT[C.wave * 64 + C.lane] = pre;
    __syncthreads();
    float off = 0.f, tot = 0.f;
#pragma unroll
    for (int w = 0; w < 8; ++w) { const float tv = TOT[w * 64 + C.lane]; tot += tv; if (w < C.wave) off += tv; }
#pragma unroll
    for (int i = 0; i < 8; ++i) bv[i] += off;
    total = tot;
}
__device__ __forceinline__ void gla_load_vt(const Ctx& C, const bf16_t* P, int tok0, int h, LAS unsigned char* VT) {
    unsigned lo[4], hi[4];
#pragma unroll
    for (int i = 0; i < 8; ++i) { const bf16_t* pr = P + (size_t)(tok0 + 8 * C.wave + i) * NP + EC_V + h * 128 + C.lane; const unsigned x0 = pr[0], x1 = pr[64];
        if (i & 1) { lo[i >> 1] |= x0 << 16; hi[i >> 1] |= x1 << 16; } else { lo[i >> 1] = x0; hi[i >> 1] = x1; } }
    *(LAS u32x4*)(VT + (C.lane * GP_ + 8 * C.wave) * 2) = (u32x4){lo[0], lo[1], lo[2], lo[3]};
    *(LAS u32x4*)(VT + ((C.lane + 64) * GP_ + 8 * C.wave) * 2) = (u32x4){hi[0], hi[1], hi[2], hi[3]};
}
__device__ __forceinline__ void gla_a_unit(const Ctx& C, CArgs& a, int uid, f32x4 (&Srun)[4], float& dprod) {
    const int h = uid & 3, n = (uid >> 2) & 127, b = uid >> 9, tok0 = b * SEQ + n * 64;
    const bf16_t* P = (const bf16_t*)(a.ws + WS_P);
    LAS unsigned char* lds = C.lds; constexpr int L_VT_ = 0, L_KST_ = 128 * GP_ * 2, L_TOT_ = L_KST_ + 64 * GP_ * 2, L_DLS_ = L_TOT_ + 2048;
    const int q = C.lane >> 4, li = C.lane & 15, w = C.wave;
    float kv[8];
#pragma unroll
    for (int i = 0; i < 8; ++i) kv[i] = ldbf(P + (size_t)(tok0 + 8 * w + i) * NP + EC_K + h * 64 + C.lane);
    gla_load_vt(C, P, tok0, h, lds + L_VT_);
    float bv[8], total;
    gla_decay(C, a, P, tok0, h, (LAS float*)(lds + L_TOT_), bv, total);
    { unsigned o[4];
#pragma unroll
      for (int i = 0; i < 8; ++i) { const unsigned x = f2bf(kv[i] * __expf(total - bv[i])); if (i & 1) o[i >> 1] |= x << 16; else o[i >> 1] = x; }
      *(LAS u32x4*)(lds + L_KST_ + (C.lane * GP_ + 8 * w) * 2) = (u32x4){o[0], o[1], o[2], o[3]}; }
    const int ug = (b * 4 + h) * 128 + n;
    const float dl = __expf(total);
    if (w == 0) { ((float*)(a.ws + WS_GLA_DL))[ug * 64 + C.lane] = dprod; ((LAS float*)(lds + L_DLS_))[C.lane] = dl; }
    dprod *= dl;
    __syncthreads();
    bf16_t* ST = (bf16_t*)(a.ws + WS_GLA_ST) + (size_t)ug * 8192;
    const bf16x8 v0 = *(const LAS bf16x8*)(lds + L_VT_ + ((16 * w + li) * GP_ + 8 * q) * 2), v1 = *(const LAS bf16x8*)(lds + L_VT_ + ((16 * w + li) * GP_ + 32 + 8 * q) * 2);
#pragma unroll
    for (int dt = 0; dt < 4; ++dt) { f32x4 c4 = (f32x4){0.f, 0.f, 0.f, 0.f};
        c4 = MFMA16(*(const LAS bf16x8*)(lds + L_KST_ + ((16 * dt + li) * GP_ + 8 * q) * 2), v0, c4); c4 = MFMA16(*(const LAS bf16x8*)(lds + L_KST_ + ((16 * dt + li) * GP_ + 32 + 8 * q) * 2), v1, c4);
        *(u32x2*)(ST + (16 * w + li) * 64 + 16 * dt + 4 * q) = (u32x2){pg8::cvt_pk_bf16(Srun[dt][0], Srun[dt][1]), pg8::cvt_pk_bf16(Srun[dt][2], Srun[dt][3])};
        const f32x4 dl4 = *(const LAS f32x4*)(lds + L_DLS_ + (16 * dt + 4 * q) * 4);
        Srun[dt] = Srun[dt] * dl4 + c4; }
    __syncthreads();
}
__device__ __forceinline__ void gla_a_group(LAS unsigned char* ldsb, CArgs& a, int gidx) {
    const int bh = gidx >> 4, g = gidx & 15, b = bh >> 2, h = bh & 3;
    f32x4 Srun[4]; float dprod = 1.f;
#pragma unroll
    for (int dt = 0; dt < 4; ++dt) Srun[dt] = (f32x4){0.f, 0.f, 0.f, 0.f};
#pragma unroll 1
    for (int j = 0; j < 8; ++j) { const Ctx Cu = mk_ctx(ldsb); gla_a_unit(Cu, a, (b << 9) | ((8 * g + j) << 2) | h, Srun, dprod); }
    const Ctx C = mk_ctx(ldsb); const int q = C.lane >> 4, li = C.lane & 15, w = C.wave;
    bf16_t* GL = (bf16_t*)(a.ws + WS_GLA_GL) + (size_t)gidx * 8192;
#pragma unroll
    for (int dt = 0; dt < 4; ++dt) *(u32x2*)(GL + (16 * w + li) * 64 + 16 * dt + 4 * q) = (u32x2){pg8::cvt_pk_bf16(Srun[dt][0], Srun[dt][1]), pg8::cvt_pk_bf16(Srun[dt][2], Srun[dt][3])};
    if (w == 0) ((float*)(a.ws + WS_GLA_GD))[gidx * 64 + C.lane] = dprod;
}
__device__ __forceinline__ void gla_c_unit(const Ctx& C, CArgs& a, int uid, const float (&carry)[2][8]) {
    const int h = uid & 3, n = (uid >> 2) & 127, b = uid >> 9, tok0 = b * SEQ + n * 64;
    const bf16_t* P = (const bf16_t*)(a.ws + WS_P);
    LAS unsigned char* lds = C.lds;
    constexpr int L_VT_ = 0, L_SB_ = 128 * GP_ * 2, L_QD_ = 2 * 128 * GP_ * 2, L_KD_ = L_QD_ + 64 * GP_ * 2, L_TOT_ = L_KD_ + 64 * GP_ * 2, L_PS_ = L_TOT_ + 2048;
    const int q = C.lane >> 4, li = C.lane & 15, w = C.wave;
    const int ug = (b * 4 + h) * 128 + n;
    float qv[8], kv[8];
#pragma unroll
    for (int i = 0; i < 8; ++i) { const bf16_t* pr = P + (size_t)(tok0 + 8 * w + i) * NP + h * 64 + C.lane; qv[i] = ldbf(pr + EC_Q); kv[i] = ldbf(pr + EC_K); }
    { const u32x4* ST = (const u32x4*)((const bf16_t*)(a.ws + WS_GLA_ST) + (size_t)ug * 8192); const int d8 = C.tid & 7;
      const f32x4* dcp = (const f32x4*)((const float*)(a.ws + WS_GLA_DL) + (size_t)ug * 64 + 8 * d8); const f32x4 dc0 = dcp[0], dc1 = dcp[1];
#pragma unroll
      for (int k = 0; k < 2; ++k) { const int p = C.tid + 512 * k, v = p >> 3; float f[8]; unpack8(ST[p], f);
#pragma unroll
          for (int e = 0; e < 8; ++e) f[e] += carry[k][e] * (e < 4 ? dc0[e] : dc1[e - 4]);
          *(LAS u32x4*)(lds + L_SB_ + (v * GP_ + 8 * d8) * 2) = (u32x4){pg8::cvt_pk_bf16(f[0], f[1]), pg8::cvt_pk_bf16(f[2], f[3]), pg8::cvt_pk_bf16(f[4], f[5]), pg8::cvt_pk_bf16(f[6], f[7])}; } }
    gla_load_vt(C, P, tok0, h, lds + L_VT_);
    float bv[8], total;
    gla_decay(C, a, P, tok0, h, (LAS float*)(lds + L_TOT_), bv, total);
#pragma unroll
    for (int i = 0; i < 8; ++i) { const int t = 8 * w + i;
        *((LAS bf16_t*)(lds + L_QD_) + t * GP_ + C.lane) = (bf16_t)f2bf(qv[i] * 0.125f * __expf(bv[i]));
        *((LAS bf16_t*)(lds + L_KD_) + t * GP_ + C.lane) = (bf16_t)f2bf(kv[i] * __expf(-bv[i])); }
    __syncthreads();
    const int ct = w & 3, vh = w >> 2;
    const bf16x8 qf0 = *(const LAS bf16x8*)(lds + L_QD_ + ((16 * ct + li) * GP_ + 8 * q) * 2), qf1 = *(const LAS bf16x8*)(lds + L_QD_ + ((16 * ct + li) * GP_ + 32 + 8 * q) * 2);
    f32x4 at[4];
#pragma unroll
    for (int st = 0; st < 4; ++st) { at[st] = (f32x4){0.f, 0.f, 0.f, 0.f};
        if (st <= ct) { at[st] = MFMA16(*(const LAS bf16x8*)(lds + L_KD_ + ((16 * st + li) * GP_ + 8 * q) * 2), qf0, at[st]); at[st] = MFMA16(*(const LAS bf16x8*)(lds + L_KD_ + ((16 * st + li) * GP_ + 32 + 8 * q) * 2), qf1, at[st]);
#pragma unroll
            for (int r = 0; r < 4; ++r) if (16 * st + 4 * q + r > 16 * ct + li) at[st][r] = 0.f; } }
    const bf16x8 ab0 = mkfrag(at[0], at[1]), ab1 = mkfrag(at[2], at[3]);
    f32x4 o[4]; float ss = 0.f;
#pragma unroll
    for (int vt = 0; vt < 4; ++vt) { const int vrow = 16 * (4 * vh + vt) + li; f32x4 c4 = (f32x4){0.f, 0.f, 0.f, 0.f};
        c4 = MFMA16(ldfrag2(lds, L_VT_, GP_, vrow, 4 * q, 16 + 4 * q), ab0, c4);
        if (ct >= 2) c4 = MFMA16(ldfrag2(lds, L_VT_, GP_, vrow, 32 + 4 * q, 48 + 4 * q), ab1, c4);
        c4 = MFMA16(*(const LAS bf16x8*)(lds + L_SB_ + (vrow * GP_ + 8 * q) * 2), qf0, c4); c4 = MFMA16(*(const LAS bf16x8*)(lds + L_SB_ + (vrow * GP_ + 32 + 8 * q) * 2), qf1, c4);
        o[vt] = c4; ss += (c4[0] * c4[0] + c4[1] * c4[1]) + (c4[2] * c4[2] + c4[3] * c4[3]); }
    { auto p1 = __builtin_amdgcn_permlane16_swap(__float_as_uint(ss), __float_as_uint(ss), false, false); ss = __uint_as_float(p1[0]) + __uint_as_float(p1[1]);
      auto p2 = __builtin_amdgcn_permlane32_swap(__float_as_uint(ss), __float_as_uint(ss), false, false); ss = __uint_as_float(p2[0]) + __uint_as_float(p2[1]); }
    LAS float* PS = (LAS float*)(lds + L_PS_);
    if (q == 0) PS[(16 * ct + li) * 2 + vh] = ss;
    __syncthreads();
    const float tot = PS[(16 * ct + li) * 2] + PS[(16 * ct + li) * 2 + 1];
    const float rstd = 1.0f / sqrtf(tot * (1.0f / 128.0f) + RMS_EPS);
    const size_t m = (size_t)(tok0 + 16 * ct + li);
#pragma unroll
    for (int vt = 0; vt < 4; ++vt) { const int vch = h * 128 + 16 * (4 * vh + vt) + 4 * q;
        const u32x2 gw = *(const u32x2*)(P + m * NP + EC_G + vch); const f32x4 gn = *(const f32x4*)(a.in[I_GLA_NORM] + vch);
        const f32x4 gvv = (f32x4){bf2f(gw.x & 0xffffu), __uint_as_float(gw.x & 0xffff0000u), bf2f(gw.y & 0xffffu), __uint_as_float(gw.y & 0xffff0000u)};
        f32x4 r4;
#pragma unroll
        for (int e = 0; e < 4; ++e) r4[e] = o[vt][e] * rstd * gn[e] * silu_fast(gvv[e]);
        *(u32x2*)((bf16_t*)(a.ws + WS_MIX) + m * D + vch) = (u32x2){pg8::cvt_pk_bf16(r4[0], r4[1]), pg8::cvt_pk_bf16(r4[2], r4[3])}; }
    __syncthreads();
}
__device__ __forceinline__ void gla_c_group(LAS unsigned char* ldsb, CArgs& a, int gidx) {
    const int bh = gidx >> 4, g = gidx & 15, b = bh >> 2, h = bh & 3;
    float carry[2][8], prod[8];
    { const Ctx C = mk_ctx(ldsb); const int d8 = C.tid & 7;
#pragma unroll
      for (int e = 0; e < 8; ++e) { carry[0][e] = 0.f; carry[1][e] = 0.f; prod[e] = 1.f; }
      for (int j0 = g - 1; j0 >= 0; j0 -= 4) {
          u32x4 l0[4], l1[4]; f32x4 da[4], db[4];
#pragma unroll
          for (int x = 0; x < 4; ++x) { const int j = j0 - x; if (j >= 0) { const int gj = (bh << 4) | j; const u32x4* GL = (const u32x4*)((const bf16_t*)(a.ws + WS_GLA_GL) + (size_t)gj * 8192); l0[x] = GL[C.tid]; l1[x] = GL[C.tid + 512];
                  const f32x4* gd = (const f32x4*)((const float*)(a.ws + WS_GLA_GD) + gj * 64 + 8 * d8); da[x] = gd[0]; db[x] = gd[1]; } }
#pragma unroll
          for (int x = 0; x < 4; ++x) { const int j = j0 - x; if (j >= 0) { float f0[8], f1[8]; unpack8(l0[x], f0); unpack8(l1[x], f1);
#pragma unroll
                  for (int e = 0; e < 8; ++e) { carry[0][e] += f0[e] * prod[e]; carry[1][e] += f1[e] * prod[e]; prod[e] *= (e < 4 ? da[x][e] : db[x][e - 4]); } } }
      } }
#pragma unroll 1
    for (int j = 0; j < 8; ++j) { const Ctx Cu = mk_ctx(ldsb); gla_c_unit(Cu, a, (b << 9) | ((8 * g + j) << 2) | h, carry); }
}
__device__ __forceinline__ float gelu_fast(float x) { const float u = 1.5957691216057308f * (x + 0.044715f * x * x * x); return x * fsigmoid(u); }
__device__ __forceinline__ void sgu_unit(const Ctx& C, CArgs& a, int uid) {
    const int tok0 = uid * 128;
    const bf16_t* P = (const bf16_t*)(a.ws + WS_P); bf16_t* MIX = (bf16_t*)(a.ws + WS_MIX);
    LAS unsigned char* lds = C.lds;
    constexpr int SP = 136, L_WL = 0, L_VHT = 128 * SP * 2, L_STS = 2 * 128 * SP * 2;
    LAS float* STS = (LAS float*)(lds + L_STS);
    const int q = C.lane >> 4, li = C.lane & 15, w = C.wave;
#pragma unroll 4
    for (int i = 0; i < 16; ++i) { const int t = 16 * w + i; const u32x4 wv = *(const u32x4*)(P + (size_t)(tok0 + t) * NP + EC_SV + 8 * C.lane); float f[8]; unpack8(wv, f); float s = 0.f;
#pragma unroll
        for (int j = 0; j < 8; ++j) { f[j] = gelu_fast(f[j]); s += f[j]; }
        const float mean = wave_sum_dpp(s) * (1.0f / 512.0f); float qq = 0.f;
#pragma unroll
        for (int j = 0; j < 8; ++j) { const float d = f[j] - mean; qq += d * d; }
        const float var = wave_sum_dpp(qq) * (1.0f / 512.0f);
        if (C.lane == 0) { STS[2 * t] = mean; STS[2 * t + 1] = 1.0f / sqrtf(var + LN_EPS); } }
    __syncthreads();
#pragma unroll 1
    for (int g = 0; g < 4; ++g) {
        { const unsigned char* wsrc = a.ws + WS_TAB + TAB_SGUW + (size_t)g * 32768;
#pragma unroll
          for (int k = 0; k < 4; ++k) { const int p = C.tid + 512 * k, row = p >> 4, c16 = p & 15; *(LAS u32x4*)(lds + L_WL + row * (SP * 2) + c16 * 16) = *(const u32x4*)(wsrc + p * 16); } }
#pragma unroll
        for (int k = 0; k < 4; ++k) { const int it = C.tid + 512 * k, sx = it >> 4, c8 = it & 15; const u32x4 wv = *(const u32x4*)(P + (size_t)(tok0 + sx) * NP + EC_SV + g * 128 + 8 * c8); float f[8]; unpack8(wv, f);
            const float mean = STS[2 * sx], rstd = STS[2 * sx + 1]; const float* lg = a.in[I_SGU_LN_G] + g * 128 + 8 * c8; const float* lb = a.in[I_SGU_LN_B] + g * 128 + 8 * c8;
#pragma unroll
            for (int j = 0; j < 8; ++j) *((LAS bf16_t*)(lds + L_VHT) + (8 * c8 + j) * SP + sx) = (bf16_t)f2bf((gelu_fast(f[j]) - mean) * rstd * lg[j] + lb[j]); }
        __syncthreads();
        const int ct4 = w >> 2;
#pragma unroll
        for (int tp = 0; tp < 2; ++tp) { const int tt = tp == 0 ? (w & 3) : 7 - (w & 3); const int nks = (tt + 2) >> 1;
            bf16x8 wf[4];
#pragma unroll
            for (int ks = 0; ks < 4; ++ks) if (ks < nks) wf[ks] = *(const LAS bf16x8*)(lds + L_WL + ((16 * tt + li) * SP + 32 * ks + 8 * q) * 2);
            const size_t m = (size_t)(tok0 + 16 * tt + li); const float bias = a.in[I_SGU_B][g * 128 + 16 * tt + li];
#pragma unroll
            for (int ct = 0; ct < 4; ++ct) { const int ctile = 4 * ct4 + ct; f32x4 acc = (f32x4){0.f, 0.f, 0.f, 0.f};
#pragma unroll
                for (int ks = 0; ks < 4; ++ks) if (ks < nks) acc = MFMA16(*(const LAS bf16x8*)(lds + L_VHT + ((16 * ctile + li) * SP + 32 * ks + 8 * q) * 2), wf[ks], acc);
                const int ch = g * 128 + 16 * ctile + 4 * q;
                const u32x2 uw = *(const u32x2*)(P + m * NP + EC_U + ch);
                const f32x4 uv = (f32x4){bf2f(uw.x & 0xffffu), __uint_as_float(uw.x & 0xffff0000u), bf2f(uw.y & 0xffffu), __uint_as_float(uw.y & 0xffff0000u)};
                f32x4 o;
#pragma unroll
                for (int e = 0; e < 4; ++e) o[e] = (acc[e] + bias) * gelu_fast(uv[e]);
                *(u32x2*)(MIX + m * D + 512 + ch) = (u32x2){pg8::cvt_pk_bf16(o[0], o[1]), pg8::cvt_pk_bf16(o[2], o[3])}; } }
        __syncthreads();
    }
}

__device__ __forceinline__ float lerp_tok(const bf16_t* P, size_t m, int col, float mu) {
    const float cur = ldbf(P + m * NP + col); const float prev = ((m & (SEQ - 1)) != 0) ? ldbf(P + (m - 1) * NP + col) : 0.f;
    return cur + (prev - cur) * mu;
}
__device__ __forceinline__ void conv_unit(const Ctx& C, CArgs& a, int uid) {
    const int b = uid >> 7, i64 = uid & 127, t0 = i64 * 64; const size_t mb = (size_t)b * SEQ;
    const bf16_t* P = (const bf16_t*)(a.ws + WS_P); bf16_t* MIX = (bf16_t*)(a.ws + WS_MIX);
    LAS bf16_t* Z = (LAS bf16_t*)C.lds; LAS float* YG = (LAS float*)(C.lds + 94 * 512 * 2);
#pragma unroll
    for (int bt = 0; bt < 2; ++bt) {
        u32x4 wa[6], wg[6];
#pragma unroll
        for (int k = 0; k < 6; ++k) { const int i = C.tid + 512 * (6 * bt + k); const int j = i >> 6, c8 = i & 63, t = t0 - 30 + j; wa[k] = (u32x4){0u, 0u, 0u, 0u}; wg[k] = wa[k];
            if (i < 94 * 64 && t >= 0) { const bf16_t* pr = P + (mb + t) * NP; wa[k] = *(const u32x4*)(pr + OC_CA + 8 * c8); wg[k] = *(const u32x4*)(pr + OC_CG + 8 * c8); } }
#pragma unroll
        for (int k = 0; k < 6; ++k) { const int i = C.tid + 512 * (6 * bt + k); const int j = i >> 6, c8 = i & 63;
            if (i < 94 * 64) { float fa[8], fg[8]; unpack8(wa[k], fa); unpack8(wg[k], fg); u32x4 o;
                o.x = pk2(fa[0] * fsigmoid(fg[0]), fa[1] * fsigmoid(fg[1])); o.y = pk2(fa[2] * fsigmoid(fg[2]), fa[3] * fsigmoid(fg[3]));
                o.z = pk2(fa[4] * fsigmoid(fg[4]), fa[5] * fsigmoid(fg[5])); o.w = pk2(fa[6] * fsigmoid(fg[6]), fa[7] * fsigmoid(fg[7]));
                *(LAS u32x4*)(Z + j * 512 + 8 * c8) = o; } }
    }
    __syncthreads();
    const int c = C.tid; float w[31];
    { const f32x4* wp = (const f32x4*)((const float*)(a.ws + WS_TAB + TAB_CWT) + c * 32);
#pragma unroll
      for (int j = 0; j < 8; ++j) { const f32x4 v = wp[j]; w[4 * j] = v[0]; w[4 * j + 1] = v[1]; w[4 * j + 2] = v[2]; if (j < 7) w[4 * j + 3] = v[3]; } }
    const float cb = a.in[I_CONV_B][c];
    float lg[8], lb[8];
#pragma unroll
    for (int k = 0; k < 8; ++k) { lg[k] = a.in[I_CONV_LN_G][C.lane + 64 * k]; lb[k] = a.in[I_CONV_LN_B][C.lane + 64 * k]; }
#pragma unroll 1
    for (int grp = 0; grp < 8; ++grp) {
        float zw[38];
#pragma unroll
        for (int j = 0; j < 38; ++j) zw[j] = bf2f((unsigned)Z[(8 * grp + j) * 512 + c]);
#pragma unroll
        for (int q = 0; q < 8; ++q) { float y = cb;
#pragma unroll
            for (int j = 0; j < 31; ++j) y += w[j] * zw[q + j];
            YG[q * 512 + c] = y; }
        __syncthreads();
        { float v[8]; float s = 0.f;
#pragma unroll
          for (int k = 0; k < 8; ++k) { v[k] = YG[C.wave * 512 + C.lane + 64 * k]; s += v[k]; }
          const float mean = wave_sum_dpp(s) * (1.0f / 512.0f); float q2 = 0.f;
#pragma unroll
          for (int k = 0; k < 8; ++k) { v[k] -= mean; q2 += v[k] * v[k]; }
          const float rstd = 1.0f / sqrtf(wave_sum_dpp(q2) * (1.0f / 512.0f) + LN_EPS);
          const size_t m = mb + t0 + 8 * grp + C.wave;
#pragma unroll
          for (int k = 0; k < 8; ++k) MIX[m * D + 512 + C.lane + 64 * k] = (bf16_t)f2bf(silu_fast(v[k] * rstd * lg[k] + lb[k])); }
        __syncthreads();
    }
}
constexpr int RMAT = 64 * RP * 2;
constexpr int L_PT = 0, L_RT = RMAT, L_BH = 2 * RMAT, L_KH = 3 * RMAT, L_BT = 4 * RMAT, L_KT = 5 * RMAT, L_VT = 6 * RMAT, L_NAPB = 7 * RMAT, L_NAPK = 8 * RMAT,
              L_ARB = 9 * RMAT, L_ARK = 10 * RMAT, L_WMT = 11 * RMAT, L_U0T = 12 * RMAT, L_BV = 13 * RMAT, L_AII = 14 * RMAT, L_TII = L_AII + 4096, L_REND = L_TII + 2560;
constexpr int L_TOT = L_AII;
constexpr int L_XWB = L_RT, L_XAB = L_RT + 5120, L_XWO = L_KH, L_XAO = L_NAPB;
constexpr int L_RAW = L_ARK, L_XRAW = L_PT;
static_assert(L_RAW + 65 * 192 * 2 <= L_BV && 65 * 64 * 2 <= RMAT, "raw tiles");
static_assert(L_REND <= LDS_BYTES - 64, "rwkv LDS map");
struct PrepK { float w0; f32x4 mx0, mx1; f32x4 m0v, m1v, k0v, k1v, v0v, v1v, a0a, a0b, ks0, ks1, ka0, ka1, rk0, rk1; bf16x8 lrf[4]; int colb, ldsb, rstride; };
__device__ __forceinline__ void prep_load_consts(const Ctx& C, CArgs& a, int h, PrepK& K) {
    const float* mu = a.in[I_RWKV_MU]; const int q = C.lane >> 4, li = C.lane & 15, w = C.wave;
    K.w0 = a.in[I_RWKV_W0][h * 64 + C.lane];
    const int g8 = C.tid & 7; K.mx0 = *(const f32x4*)(mu + 1536 + 8 * g8); K.mx1 = *(const f32x4*)(mu + 1536 + 8 * g8 + 4);
    const int chB = h * 64 + 8 * (C.tid & 7);
    K.m0v = *(const f32x4*)(mu + chB); K.m1v = *(const f32x4*)(mu + chB + 4); K.k0v = *(const f32x4*)(mu + 512 + chB); K.k1v = *(const f32x4*)(mu + 512 + chB + 4); K.v0v = *(const f32x4*)(mu + 1024 + chB); K.v1v = *(const f32x4*)(mu + 1024 + chB + 4);
    K.a0a = *(const f32x4*)(a.in[I_RWKV_A0] + chB); K.a0b = *(const f32x4*)(a.in[I_RWKV_A0] + chB + 4);
    K.ks0 = *(const f32x4*)(a.in[I_RWKV_K_K] + chB); K.ks1 = *(const f32x4*)(a.in[I_RWKV_K_K] + chB + 4); K.ka0 = *(const f32x4*)(a.in[I_RWKV_K_A] + chB); K.ka1 = *(const f32x4*)(a.in[I_RWKV_K_A] + chB + 4);
    K.rk0 = *(const f32x4*)(a.in[I_RWKV_R_K] + chB); K.rk1 = *(const f32x4*)(a.in[I_RWKV_R_K] + chB + 4);
    { const bf16_t* tb = (const bf16_t*)(a.ws + WS_TAB + ((w >> 2) == 0 ? TAB_W2TB : TAB_A2TB)) + (size_t)(h * 64 + li) * 32 + 8 * q;
#pragma unroll
      for (int nt = 0; nt < 4; ++nt) K.lrf[nt] = *(const bf16x8*)(tb + nt * 16 * 32); }
    const int p = C.tid & 31;
    K.colb = p < 24 ? (p >> 3) * 512 + h * 64 + 8 * (p & 7) : OC_XW + 8 * (p - 24);
    K.ldsb = p < 24 ? L_RAW + ((p >> 3) * 64 + 8 * (p & 7)) * 2 : L_XRAW + 8 * (p - 24) * 2;
    K.rstride = p < 24 ? 384 : 128;
}
__device__ __forceinline__ void prep_load_raw(const Ctx& C, CArgs& a, int uid, const PrepK& K, u32x4 (&pf)[5]) {
    const int n = (uid >> 3) & 127, b = uid >> 10; const size_t m0 = (size_t)b * SEQ + n * 64;
    const bf16_t* base = (const bf16_t*)(a.ws + WS_P) + (m0 + (C.tid >> 5)) * NP + K.colb;
#pragma unroll
    for (int k = 0; k < 4; ++k) pf[k] = *(const u32x4*)(base + (size_t)(16 * k) * NP);
    pf[4] = (u32x4){0u, 0u, 0u, 0u};
    if (C.tid < 32 && n != 0) pf[4] = *(const u32x4*)((const bf16_t*)(a.ws + WS_P) + (m0 - 1) * NP + K.colb);
}
__device__ __forceinline__ void rwkv_prep_unit(const Ctx& C, CArgs& a, int uid, int next_uid, const PrepK& K, u32x4 (&pf)[5]) {
    const int h = uid & 7, n = (uid >> 3) & 127, b = uid >> 10; const size_t m0 = (size_t)b * SEQ + n * 64;
    LAS unsigned char* lds = C.lds;
    LAS float* AII = (LAS float*)(lds + L_AII);
    const int q = C.lane >> 4, li = C.lane & 15, w = C.wave;
    const float w0 = K.w0;
    const f32x4 m0v = K.m0v, m1v = K.m1v, k0v = K.k0v, k1v = K.k1v, v0v = K.v0v, v1v = K.v1v, a0a = K.a0a, a0b = K.a0b, ks0 = K.ks0, ks1 = K.ks1, ka0 = K.ka0, ka1 = K.ka1, rk0 = K.rk0, rk1 = K.rk1;
    LAS bf16_t* RAW = (LAS bf16_t*)(lds + L_RAW);
    LAS float* TOT = (LAS float*)(lds + L_TOT);
    { LAS unsigned char* dst = lds + K.ldsb + (1 + (C.tid >> 5)) * K.rstride;
#pragma unroll
      for (int k = 0; k < 4; ++k) *(LAS u32x4*)(dst + 16 * k * K.rstride) = pf[k];
      if (C.tid < 32) *(LAS u32x4*)(lds + K.ldsb) = pf[4]; }
    if (next_uid >= 0) prep_load_raw(C, a, next_uid, K, pf);
    __syncthreads();
    { const int t = C.tid >> 3, g8 = C.tid & 7; float cur[8], prv[8];
      unpack8(*(const LAS u32x4*)(lds + L_XRAW + ((t + 1) * 64 + 8 * g8) * 2), cur); unpack8(*(const LAS u32x4*)(lds + L_XRAW + (t * 64 + 8 * g8) * 2), prv);
      float o[8];
#pragma unroll
      for (int e = 0; e < 8; ++e) { const float v = cur[e] + (prv[e] - cur[e]) * (e < 4 ? K.mx0[e] : K.mx1[e - 4]); o[e] = g8 < 4 ? ftanh(v) : v; }
      *(LAS u32x4*)(lds + (g8 < 4 ? L_XWB : L_XAB) + (t * 40 + 8 * (g8 & 3)) * 2) = (u32x4){pg8::cvt_pk_bf16(o[0], o[1]), pg8::cvt_pk_bf16(o[2], o[3]), pg8::cvt_pk_bf16(o[4], o[5]), pg8::cvt_pk_bf16(o[6], o[7])}; }
    __syncthreads();
    { const int mat = w >> 2, mt = w & 3;
      const bf16x8 af = *(const LAS bf16x8*)(lds + (mat == 0 ? L_XWB : L_XAB) + ((16 * mt + li) * 40 + 8 * q) * 2);
      LAS float* xo = (LAS float*)(lds + (mat == 0 ? L_XWO : L_XAO));
#pragma unroll
      for (int nt = 0; nt < 4; ++nt) { f32x4 c4 = (f32x4){0.f, 0.f, 0.f, 0.f}; c4 = MFMA16(af, K.lrf[nt], c4);
#pragma unroll
          for (int r = 0; r < 4; ++r) xo[(16 * mt + 4 * q + r) * 64 + 16 * nt + li] = c4[r]; } }
    __syncthreads();
    {
        float gl[8];
        { const LAS float* xwo = (const LAS float*)(lds + L_XWO) + C.lane;
          float pre = 0.f;
#pragma unroll
          for (int i = 0; i < 8; ++i) { pre += -0.6065306597126334f * fsigmoid(w0 + xwo[(8 * w + i) * 64]); gl[i] = pre; }
          TOT[w * 64 + C.lane] = pre; }
        __syncthreads();
        float off = 0.f, gC = 0.f;
#pragma unroll
        for (int ww = 0; ww < 8; ++ww) { const float tv = TOT[ww * 64 + C.lane]; gC += tv; if (ww < w) off += tv; }
        if (w == 0) { ((float*)((unsigned char*)a.out + OUT_R_GC))[(size_t)uid * 64 + C.lane] = __expf(gC); TOT[512 + C.lane] = gC; }
        LAS float* G = (LAS float*)(lds + L_XWO) + C.lane;
#pragma unroll
        for (int i = 0; i < 8; ++i) G[(8 * w + i) * 64] = off + gl[i];
    }
    __syncthreads();
    {
        const int t = C.tid >> 3, c8 = C.tid & 7;
        float rr[8], kk8[8], vv[8], av[8], g[8], gp[8], gc8[8];
        { float cur[8], prv[8];
          unpack8(*(const LAS u32x4*)(RAW + (t + 1) * 192 + 8 * c8), cur); unpack8(*(const LAS u32x4*)(RAW + t * 192 + 8 * c8), prv);
#pragma unroll
          for (int e = 0; e < 8; ++e) rr[e] = cur[e] + (prv[e] - cur[e]) * (e < 4 ? m0v[e] : m1v[e - 4]);
          unpack8(*(const LAS u32x4*)(RAW + (t + 1) * 192 + 64 + 8 * c8), cur); unpack8(*(const LAS u32x4*)(RAW + t * 192 + 64 + 8 * c8), prv);
#pragma unroll
          for (int e = 0; e < 8; ++e) kk8[e] = cur[e] + (prv[e] - cur[e]) * (e < 4 ? k0v[e] : k1v[e - 4]);
          unpack8(*(const LAS u32x4*)(RAW + (t + 1) * 192 + 128 + 8 * c8), cur); unpack8(*(const LAS u32x4*)(RAW + t * 192 + 128 + 8 * c8), prv);
#pragma unroll
          for (int e = 0; e < 8; ++e) vv[e] = cur[e] + (prv[e] - cur[e]) * (e < 4 ? v0v[e] : v1v[e - 4]); }
        { const LAS f32x4* xa = (const LAS f32x4*)((const LAS float*)(lds + L_XAO) + t * 64 + 8 * c8); const f32x4 x0 = xa[0], x1 = xa[1];
#pragma unroll
          for (int e = 0; e < 4; ++e) { av[e] = fsigmoid(a0a[e] + x0[e]); av[4 + e] = fsigmoid(a0b[e] + x1[e]); }
          const LAS f32x4* gq = (const LAS f32x4*)((const LAS float*)(lds + L_XWO) + t * 64 + 8 * c8); const f32x4 g0 = gq[0], g1 = gq[1];
          f32x4 p0 = (f32x4){0.f, 0.f, 0.f, 0.f}, p1 = p0; if (t > 0) { p0 = gq[-16]; p1 = gq[-15]; }
          const LAS f32x4* gcq = (const LAS f32x4*)(TOT + 512 + 8 * c8); const f32x4 c0 = gcq[0], c1 = gcq[1];
#pragma unroll
          for (int e = 0; e < 4; ++e) { g[e] = g0[e]; g[4 + e] = g1[e]; gp[e] = p0[e]; gp[4 + e] = p1[e]; gc8[e] = c0[e]; gc8[4 + e] = c1[e]; } }
        __syncthreads();
        float kkv[8], kp[8]; float n2 = 0.f, bon = 0.f;
#pragma unroll
        for (int e = 0; e < 8; ++e) { const float kks_ = e < 4 ? ks0[e] : ks1[e - 4], ka_ = e < 4 ? ka0[e] : ka1[e - 4], rk_ = e < 4 ? rk0[e] : rk1[e - 4];
            kkv[e] = kk8[e] * kks_; n2 += kkv[e] * kkv[e]; kp[e] = kk8[e] * (1.0f + (av[e] - 1.0f) * ka_); bon += rr[e] * kp[e] * rk_; }
        DPP_ADD(n2, 0xB1); DPP_ADD(n2, 0x4E); DPP_ADD(n2, 0x141); DPP_ADD(bon, 0xB1); DPP_ADD(bon, 0x4E); DPP_ADD(bon, 0x141);
        const float rn = __builtin_amdgcn_rsqf(fmaxf(n2, 1e-24f));
        float o_pt[8], o_rt[8], o_bh[8], o_kh[8], o_bv[8];
        LAS bf16_t* BTp = (LAS bf16_t*)(lds + L_BT) + (8 * c8) * RP + t; LAS bf16_t* KTp = (LAS bf16_t*)(lds + L_KT) + (8 * c8) * RP + t; LAS bf16_t* VTp = (LAS bf16_t*)(lds + L_VT) + (8 * c8) * RP + t;
        float t_bt[8], t_kt[8];
#pragma unroll
        for (int e = 0; e < 8; ++e) { const float kn = kkv[e] * rn, bbv = kn * av[e]; const float eg = __expf(g[e]), eng = __builtin_amdgcn_rcpf(eg), egp = __expf(gp[e]), egc = __expf(gc8[e] - g[e]);
            o_pt[e] = kn * egp; o_rt[e] = rr[e] * eg; o_bh[e] = bbv * eng; o_kh[e] = kp[e] * eng; o_bv[e] = bon * vv[e]; t_bt[e] = bbv * egc; t_kt[e] = kp[e] * egc; }
#pragma unroll
        for (int e = 0; e < 8; e += 2) { const unsigned pb = pg8::cvt_pk_bf16(t_bt[e], t_bt[e + 1]), pk = pg8::cvt_pk_bf16(t_kt[e], t_kt[e + 1]), pv = pg8::cvt_pk_bf16(vv[e], vv[e + 1]);
            BTp[e * RP] = (bf16_t)(pb & 0xffffu); BTp[(e + 1) * RP] = (bf16_t)(pb >> 16); KTp[e * RP] = (bf16_t)(pk & 0xffffu); KTp[(e + 1) * RP] = (bf16_t)(pk >> 16); VTp[e * RP] = (bf16_t)(pv & 0xffffu); VTp[(e + 1) * RP] = (bf16_t)(pv >> 16); }
        const int ro = (t * RP + 8 * c8) * 2;
#define PK8(o) (u32x4){pg8::cvt_pk_bf16(o[0], o[1]), pg8::cvt_pk_bf16(o[2], o[3]), pg8::cvt_pk_bf16(o[4], o[5]), pg8::cvt_pk_bf16(o[6], o[7])}
        *(LAS u32x4*)(lds + L_PT + ro) = PK8(o_pt); *(LAS u32x4*)(lds + L_RT + ro) = PK8(o_rt); *(LAS u32x4*)(lds + L_BH + ro) = PK8(o_bh); *(LAS u32x4*)(lds + L_KH + ro) = PK8(o_kh); *(LAS u32x4*)(lds + L_BV + ro) = PK8(o_bv);
#undef PK8
    }
    __syncthreads();
    {
        const int mat = w >> 1, half = w & 1;
        const int xb = mat < 2 ? L_PT : L_RT, yb = (mat & 1) ? L_KH : L_BH;
        const int ob = mat == 0 ? L_NAPB : (mat == 1 ? L_NAPK : (mat == 2 ? L_ARB : L_ARK));
        const bool strict = mat < 2;
        auto row_tiles = [&](auto MTc) { constexpr int mt = decltype(MTc)::value;
            const bf16x8 a0f = ldfrag(lds, xb, 16 * mt + li, 8 * q), a1f = ldfrag(lds, xb, 16 * mt + li, 32 + 8 * q);
            LAS unsigned char* orow = lds + ob + ((16 * mt + li) * RP + 4 * q) * 2;
#pragma unroll
            for (int nt = 0; nt < 4; ++nt) {
                if (nt > mt) { *(LAS u32x2*)(orow + 32 * nt) = (u32x2){0u, 0u}; continue; }
                f32x4 v4 = (f32x4){0.f, 0.f, 0.f, 0.f};
                v4 = MFMA16(ldfrag(lds, yb, 16 * nt + li, 8 * q), a0f, v4); v4 = MFMA16(ldfrag(lds, yb, 16 * nt + li, 32 + 8 * q), a1f, v4);
                if (nt == mt) {
#pragma unroll
                    for (int r = 0; r < 4; ++r) { const bool keep = strict ? (4 * q + r < li) : (4 * q + r <= li); v4[r] = keep ? v4[r] : 0.f; }
                    if (mat == 0) *(LAS f32x4*)(AII + (mt * 16 + li) * 16 + 4 * q) = v4; }
                *(LAS u32x2*)(orow + 32 * nt) = strict ? (u32x2){pg8::cvt_pk_bf16(-v4[0], -v4[1]), pg8::cvt_pk_bf16(-v4[2], -v4[3])} : (u32x2){pg8::cvt_pk_bf16(v4[0], v4[1]), pg8::cvt_pk_bf16(v4[2], v4[3])}; } };
        if (half == 0) { row_tiles(std::integral_constant<int, 0>{}); row_tiles(std::integral_constant<int, 3>{}); }
        else           { row_tiles(std::integral_constant<int, 1>{}); row_tiles(std::integral_constant<int, 2>{}); }
    }
    __syncthreads();
    f32x4 acc[4];
    if (w < 4) {
#pragma unroll
        for (int mt = 0; mt < 4; ++mt)
#pragma unroll
            for (int r = 0; r < 4; ++r) acc[mt][r] = bf2f((unsigned)*((const LAS bf16_t*)(lds + L_PT) + (16 * mt + 4 * q + r) * RP + 16 * w + li));
    } else {
        const int vs = w - 4;
        const bf16x8 b0 = ldfrag(lds, L_VT, 16 * vs + li, 8 * q), b1 = ldfrag(lds, L_VT, 16 * vs + li, 32 + 8 * q);
#pragma unroll
        for (int mt = 0; mt < 4; ++mt) { acc[mt] = (f32x4){0.f, 0.f, 0.f, 0.f};
            acc[mt] = MFMA16(ldfrag(lds, L_NAPK, 16 * mt + li, 8 * q), b0, acc[mt]); acc[mt] = MFMA16(ldfrag(lds, L_NAPK, 16 * mt + li, 32 + 8 * q), b1, acc[mt]); }
    }
    if (w == 0) {
        const int blk = q, c = li; float T[16];
#pragma unroll
        for (int r = 0; r < 16; ++r) { float tv = (r == c) ? 1.f : 0.f; const LAS f32x4* rowp = (const LAS f32x4*)(AII + (blk * 16 + r) * 16);
#pragma unroll
            for (int s4 = 0; s4 < 4; ++s4) { if (4 * s4 < r) { const f32x4 av = rowp[s4];
#pragma unroll
                for (int e = 0; e < 4; ++e) if (4 * s4 + e < r) tv -= av[e] * T[4 * s4 + e]; } }
            T[r] = tv; *((LAS bf16_t*)(lds + L_TII) + (blk * 16 + r) * 20 + c) = (bf16_t)f2bf(tv); }
    }
    __syncthreads();
    {
        const f32x4 z4 = (f32x4){0.f, 0.f, 0.f, 0.f};
        f32x4 X0, X1, X2, X3;
        X0 = MFMA16(ldfrag_lo(lds, L_TII, 20, li, 4 * q), mkfrag_lo(acc[0]), z4);
        acc[1] = MFMA16(ldfrag2(lds, L_NAPB, RP, 16 + li, 4 * q, 16 + 4 * q), mkfrag_lo(X0), acc[1]);
        X1 = MFMA16(ldfrag_lo(lds, L_TII, 20, 16 + li, 4 * q), mkfrag_lo(acc[1]), z4);
        const bf16x8 x01 = mkfrag(X0, X1);
        acc[2] = MFMA16(ldfrag2(lds, L_NAPB, RP, 32 + li, 4 * q, 16 + 4 * q), x01, acc[2]);
        X2 = MFMA16(ldfrag_lo(lds, L_TII, 20, 32 + li, 4 * q), mkfrag_lo(acc[2]), z4);
        acc[3] = MFMA16(ldfrag2(lds, L_NAPB, RP, 48 + li, 4 * q, 16 + 4 * q), x01, acc[3]);
        acc[3] = MFMA16(ldfrag2(lds, L_NAPB, RP, 48 + li, 32 + 4 * q, 48 + 4 * q), mkfrag_lo(X2), acc[3]);
        X3 = MFMA16(ldfrag_lo(lds, L_TII, 20, 48 + li, 4 * q), mkfrag_lo(acc[3]), z4);
        const int ob = (w < 4 ? L_WMT : L_U0T) + ((16 * (w & 3) + li) * RP + 4 * q) * 2;
        *(LAS u32x2*)(lds + ob) = (u32x2){pg8::cvt_pk_bf16(X0[0], X0[1]), pg8::cvt_pk_bf16(X0[2], X0[3])};
        *(LAS u32x2*)(lds + ob + 32) = (u32x2){pg8::cvt_pk_bf16(X1[0], X1[1]), pg8::cvt_pk_bf16(X1[2], X1[3])};
        *(LAS u32x2*)(lds + ob + 64) = (u32x2){pg8::cvt_pk_bf16(X2[0], X2[1]), pg8::cvt_pk_bf16(X2[2], X2[3])};
        *(LAS u32x2*)(lds + ob + 96) = (u32x2){pg8::cvt_pk_bf16(X3[0], X3[1]), pg8::cvt_pk_bf16(X3[2], X3[3])};
    }
    __syncthreads();
    {
        const int outp = w >> 1, half = w & 1;
#pragma unroll
        for (int mm = 0; mm < 2; ++mm) { const int mt = 2 * half + mm;
            if (outp == 0 || outp == 2) {
                const int rb = outp == 0 ? L_BT : L_ARB;
                const bf16x8 b0 = ldfrag(lds, rb, 16 * mt + li, 8 * q), b1 = ldfrag(lds, rb, 16 * mt + li, 32 + 8 * q);
                bf16_t* dst = (bf16_t*)(a.ws + (outp == 0 ? WS_R_GP : WS_R_RP)) + (size_t)uid * 4096 + (16 * mt + li) * 64;
#pragma unroll
                for (int g = 0; g < 2; ++g) { f32x4 d[2];
#pragma unroll
                    for (int e = 0; e < 2; ++e) { const int nt = 2 * g + e; f32x4 c4 = (f32x4){0.f, 0.f, 0.f, 0.f};
                        c4 = MFMA16(ldfrag(lds, L_WMT, 16 * nt + li, 8 * q), b0, c4); c4 = MFMA16(ldfrag(lds, L_WMT, 16 * nt + li, 32 + 8 * q), b1, c4);
                        if (outp == 2) { const u32x2 rw = *(const LAS u32x2*)(lds + L_RT + ((16 * mt + li) * RP + 16 * nt + 4 * q) * 2);
                            d[e] = (f32x4){bf2f(rw.x & 0xffffu) - c4[0], __uint_as_float(rw.x & 0xffff0000u) - c4[1], bf2f(rw.y & 0xffffu) - c4[2], __uint_as_float(rw.y & 0xffff0000u) - c4[3]}; }
                        else d[e] = -c4; }
                    const u32x4 wv = (u32x4){pg8::cvt_pk_bf16(d[0][0], d[0][1]), pg8::cvt_pk_bf16(d[0][2], d[0][3]), pg8::cvt_pk_bf16(d[1][0], d[1][1]), pg8::cvt_pk_bf16(d[1][2], d[1][3])};
                    *(u32x4*)(dst + 32 * g + 8 * q) = wv; }
            } else {
                const int ab0 = outp == 1 ? L_BT : L_ARB, ab1 = outp == 1 ? L_KT : L_ARK;
                const bf16x8 a00 = ldfrag(lds, ab0, 16 * mt + li, 8 * q), a01 = ldfrag(lds, ab0, 16 * mt + li, 32 + 8 * q), a10 = ldfrag(lds, ab1, 16 * mt + li, 8 * q), a11 = ldfrag(lds, ab1, 16 * mt + li, 32 + 8 * q);
                u32x2* dst = (u32x2*)(a.ws + (outp == 1 ? WS_R_HADD : WS_R_Y0)) + (size_t)uid * 1024;
#pragma unroll
                for (int nt = 0; nt < 4; ++nt) { f32x4 c4 = (f32x4){0.f, 0.f, 0.f, 0.f};
                    if (outp == 1) { c4 = MFMA16(a00, ldfrag(lds, L_U0T, 16 * nt + li, 8 * q), c4); c4 = MFMA16(a01, ldfrag(lds, L_U0T, 16 * nt + li, 32 + 8 * q), c4);
                                     c4 = MFMA16(a10, ldfrag(lds, L_VT, 16 * nt + li, 8 * q), c4); c4 = MFMA16(a11, ldfrag(lds, L_VT, 16 * nt + li, 32 + 8 * q), c4); }
                    else {
                                     c4 = MFMA16(ldfrag(lds, L_U0T, 16 * nt + li, 8 * q), a00, c4); c4 = MFMA16(ldfrag(lds, L_U0T, 16 * nt + li, 32 + 8 * q), a01, c4);
                                     c4 = MFMA16(ldfrag(lds, L_VT, 16 * nt + li, 8 * q), a10, c4); c4 = MFMA16(ldfrag(lds, L_VT, 16 * nt + li, 32 + 8 * q), a11, c4); }
                    dst[(nt * 4 + mt) * 64 + C.lane] = (u32x2){pg8::cvt_pk_bf16(c4[0], c4[1]), pg8::cvt_pk_bf16(c4[2], c4[3])}; }
            } }
        { const int nt = w >> 1; u32x2* bvf = (u32x2*)((unsigned char*)a.out + OUT_R_BVF) + (size_t)uid * 1024;
#pragma unroll
          for (int mm = 0; mm < 2; ++mm) { const int mt = 2 * (w & 1) + mm; bvf[(nt * 4 + mt) * 64 + C.lane] = *(const LAS u32x2*)(lds + L_BV + ((16 * mt + li) * RP + 16 * nt + 4 * q) * 2); } }
    }
    __syncthreads();
}
constexpr int R2_SLOT = 35072, R2_OG = 0, R2_OR = 9216, R2_OH = 18432, R2_OY = 26624, R2_OC = 34816;
static_assert(4 * R2_SLOT <= LDS_BYTES - 64, "R2 ring");
__device__ __forceinline__ void rwkv_scan(const Ctx& C, CArgs& a) {
    if (C.bid >= 32) return;
    const int b = C.bid >> 3, h = C.bid & 7, q = C.lane >> 4, li = C.lane & 15, w = C.wave;
    LAS unsigned char* lds = C.lds;
    unsigned char* ws = a.ws;
    if (w >= 4) {
        const int lw = w - 4;
        const unsigned char* src[9]; unsigned ustr[9]; unsigned ldo[9]; bool act[9];
#pragma unroll
        for (int k = 0; k < 9; ++k) { int j = lw + 4 * k; if (j > 34) j = 31;
            if (j < 18) { const int isR = j >= 9, jj = j - 9 * isR, p = 64 * jj + C.lane, row = p / 9; int c16 = p % 9; if (c16 > 7) c16 = 7;
                src[k] = ws + (isR ? WS_R_RP : WS_R_GP) + row * 128 + c16 * 16; ustr[k] = 8192u; ldo[k] = (unsigned)((isR ? R2_OR : R2_OG) + jj * 1024); act[k] = true; }
            else if (j < 34) { const int isY = j >= 26, jj = j - 18 - 8 * isY;
                src[k] = ws + (isY ? WS_R_Y0 : WS_R_HADD) + jj * 1024 + C.lane * 16; ustr[k] = 8192u; ldo[k] = (unsigned)((isY ? R2_OY : R2_OH) + jj * 1024); act[k] = true; }
            else { src[k] = (const unsigned char*)a.out + OUT_R_GC + (C.lane & 15) * 16; ustr[k] = 256u; ldo[k] = (unsigned)R2_OC; act[k] = C.lane < 16; } }
#define R2_ISSUE(n_, slot_) do { const size_t uid_ = ((size_t)b << 10) | ((size_t)(n_) << 3) | (size_t)h; \
        _Pragma("unroll") for (int k = 0; k < 9; ++k) { if (act[k]) __builtin_amdgcn_global_load_lds((const unsigned*)(src[k] + uid_ * ustr[k]), (LAS unsigned*)(lds + (slot_) * R2_SLOT + ldo[k]), 16, 0, 0); } } while (0)
        R2_ISSUE(0, 0); R2_ISSUE(1, 1); R2_ISSUE(2, 2);
#pragma unroll 1
        for (int n = 0; n < 128; ++n) {
            asm volatile("s_waitcnt vmcnt(18)" ::: "memory");
            __builtin_amdgcn_s_barrier();
            const int nn = n + 3 < 128 ? n + 3 : 127;
            R2_ISSUE(nn, (n + 3) & 3);
        }
        asm volatile("s_waitcnt vmcnt(0)" ::: "memory");
#undef R2_ISSUE
        return;
    }
    const int s = w;
    u32x2* YF = (u32x2*)((unsigned char*)a.out + OUT_R_Y);
    f32x4 H[4];
#pragma unroll
    for (int mt = 0; mt < 4; ++mt) H[mt] = (f32x4){0.f, 0.f, 0.f, 0.f};
#pragma unroll 1
    for (int n = 0; n < 128; ++n) {
        __builtin_amdgcn_s_barrier();
        asm volatile("" ::: "memory");
        LAS unsigned char* sl = lds + (n & 3) * R2_SLOT;
        const bf16x8 hb0 = mkfrag(H[0], H[1]), hb1 = mkfrag(H[2], H[3]);
        const size_t uid = ((size_t)b << 10) | ((size_t)n << 3) | (size_t)h;
#pragma unroll
        for (int mt = 0; mt < 4; ++mt) {
            const bf16x8 g0 = *(const LAS bf16x8*)(sl + R2_OG + (16 * mt + li) * 144 + 16 * q), g1 = *(const LAS bf16x8*)(sl + R2_OG + (16 * mt + li) * 144 + 64 + 16 * q);
            const bf16x8 r0 = *(const LAS bf16x8*)(sl + R2_OR + (16 * mt + li) * 144 + 16 * q), r1 = *(const LAS bf16x8*)(sl + R2_OR + (16 * mt + li) * 144 + 64 + 16 * q);
            const u32x2 ha = *(const LAS u32x2*)(sl + R2_OH + ((s * 4 + mt) * 64 + C.lane) * 8), y0 = *(const LAS u32x2*)(sl + R2_OY + ((s * 4 + mt) * 64 + C.lane) * 8);
            const f32x4 gc = *(const LAS f32x4*)(sl + R2_OC + (16 * mt + 4 * q) * 4);
            f32x4 hn = gc * H[mt] + (f32x4){bf2f(ha.x & 0xffffu), __uint_as_float(ha.x & 0xffff0000u), bf2f(ha.y & 0xffffu), __uint_as_float(ha.y & 0xffff0000u)};
            hn = MFMA16(g0, hb0, hn); hn = MFMA16(g1, hb1, hn);
            f32x4 yv = (f32x4){bf2f(y0.x & 0xffffu), __uint_as_float(y0.x & 0xffff0000u), bf2f(y0.y & 0xffffu), __uint_as_float(y0.y & 0xffff0000u)};
            yv = MFMA16(hb0, r0, yv); yv = MFMA16(hb1, r1, yv);
            YF[uid * 1024 + (s * 4 + mt) * 64 + C.lane] = (u32x2){pg8::cvt_pk_bf16(yv[0], yv[1]), pg8::cvt_pk_bf16(yv[2], yv[3])};
            H[mt] = hn; }
        asm volatile("s_waitcnt lgkmcnt(0)" ::: "memory");
    }
}
__device__ __forceinline__ void rwkv_post_phase(const Ctx& C, CArgs& a) {
    LAS unsigned char* lds = C.lds; const int h = C.wave, q = C.lane >> 4, li = C.lane & 15;
    const bf16_t* P = (const bf16_t*)(a.ws + WS_P); const float* mu = a.in[I_RWKV_MU];
    LAS bf16_t* XR = (LAS bf16_t*)lds;
    LAS bf16_t* XGB = (LAS bf16_t*)(lds + 65 * 96 * 2);
    bf16x8 gf[4][3];
#pragma unroll
    for (int nt = 0; nt < 4; ++nt)
#pragma unroll
        for (int ks = 0; ks < 3; ++ks) gf[nt][ks] = *(const bf16x8*)((const bf16_t*)(a.ws + WS_TAB + TAB_G2TB) + (size_t)(h * 64 + 16 * nt + li) * 96 + 32 * ks + 8 * q);
    f32x4 gg[4], gb[4];
#pragma unroll
    for (int nt = 0; nt < 4; ++nt) { gg[nt] = *(const f32x4*)(a.in[I_RWKV_GN_G] + h * 64 + 16 * nt + 4 * q); gb[nt] = *(const f32x4*)(a.in[I_RWKV_GN_B] + h * 64 + 16 * nt + 4 * q); }
    const u32x2* YF = (const u32x2*)((const unsigned char*)a.out + OUT_R_Y); const u32x2* BVF = (const u32x2*)((const unsigned char*)a.out + OUT_R_BVF); bf16_t* MIX = (bf16_t*)(a.ws + WS_MIX);
#pragma unroll 1
    for (int u = C.bid; u < 512; u += C.nblk) {
        const size_t m0 = (size_t)u * 64; const bool seq0 = (m0 & (SEQ - 1)) == 0;
        const size_t uid = ((size_t)(u >> 7) << 10) | ((size_t)(u & 127) << 3) | (size_t)h;
        for (int i = C.tid; i < 65 * 12; i += NTHREADS) { const int j = i / 12, c8 = i % 12; u32x4 v = (u32x4){0u, 0u, 0u, 0u}; if (j > 0 || !seq0) v = *(const u32x4*)(P + (m0 - 1 + j) * NP + OC_XG + 8 * c8); *(LAS u32x4*)(XR + j * 96 + 8 * c8) = v; }
        u32x2 yf[4][4], bf[4][4];
#pragma unroll
        for (int mt = 0; mt < 4; ++mt)
#pragma unroll
            for (int nt = 0; nt < 4; ++nt) { yf[mt][nt] = YF[uid * 1024 + (nt * 4 + mt) * 64 + C.lane]; bf[mt][nt] = BVF[uid * 1024 + (nt * 4 + mt) * 64 + C.lane]; }
        __syncthreads();
        for (int i = C.tid; i < 64 * 96; i += NTHREADS) { const int t = i / 96, j = i % 96; const float cur = bf2f((unsigned)XR[(t + 1) * 96 + j]), prev = bf2f((unsigned)XR[t * 96 + j]);
            XGB[t * 104 + j] = (bf16_t)f2bf(fsigmoid(cur + (prev - cur) * mu[1600 + j])); }
        __syncthreads();
#pragma unroll
        for (int mt = 0; mt < 4; ++mt) {
            bf16x8 xf[3];
#pragma unroll
            for (int ks = 0; ks < 3; ++ks) xf[ks] = *(const LAS bf16x8*)(XGB + (16 * mt + li) * 104 + 32 * ks + 8 * q);
            f32x4 g[4], y[4]; float sm = 0.f;
#pragma unroll
            for (int nt = 0; nt < 4; ++nt) { f32x4 c4 = (f32x4){0.f, 0.f, 0.f, 0.f};
#pragma unroll
                for (int ks = 0; ks < 3; ++ks) c4 = MFMA16(gf[nt][ks], xf[ks], c4);
                g[nt] = c4;
                const u32x2 yw = yf[mt][nt]; y[nt] = (f32x4){bf2f(yw.x & 0xffffu), __uint_as_float(yw.x & 0xffff0000u), bf2f(yw.y & 0xffffu), __uint_as_float(yw.y & 0xffff0000u)};
                sm += (y[nt][0] + y[nt][1]) + (y[nt][2] + y[nt][3]); }
            { auto p1 = __builtin_amdgcn_permlane16_swap(__float_as_uint(sm), __float_as_uint(sm), false, false); sm = __uint_as_float(p1[0]) + __uint_as_float(p1[1]);
              auto p2 = __builtin_amdgcn_permlane32_swap(__float_as_uint(sm), __float_as_uint(sm), false, false); sm = __uint_as_float(p2[0]) + __uint_as_float(p2[1]); }
            const float mean = sm * (1.0f / 64.0f); float sq = 0.f;
#pragma unroll
            for (int nt = 0; nt < 4; ++nt) { y[nt] = y[nt] - mean; sq += (y[nt][0] * y[nt][0] + y[nt][1] * y[nt][1]) + (y[nt][2] * y[nt][2] + y[nt][3] * y[nt][3]); }
            { auto p1 = __builtin_amdgcn_permlane16_swap(__float_as_uint(sq), __float_as_uint(sq), false, false); sq = __uint_as_float(p1[0]) + __uint_as_float(p1[1]);
              auto p2 = __builtin_amdgcn_permlane32_swap(__float_as_uint(sq), __float_as_uint(sq), false, false); sq = __uint_as_float(p2[0]) + __uint_as_float(p2[1]); }
            const float rstd = 1.0f / sqrtf(sq * (1.0f / 64.0f) + GN_EPS);
            bf16_t* orow = MIX + (m0 + 16 * mt + li) * D + h * 64 + 4 * q;
#pragma unroll
            for (int nt = 0; nt < 4; ++nt) { const u32x2 bw = bf[mt][nt]; const f32x4 bv = (f32x4){bf2f(bw.x & 0xffffu), __uint_as_float(bw.x & 0xffff0000u), bf2f(bw.y & 0xffffu), __uint_as_float(bw.y & 0xffff0000u)};
                const f32x4 o = (y[nt] * rstd * gg[nt] + gb[nt] + bv) * g[nt];
                *(u32x2*)(orow + 16 * nt) = (u32x2){pg8::cvt_pk_bf16(o[0], o[1]), pg8::cvt_pk_bf16(o[2], o[3])}; }
        }
        __syncthreads();
    }
}
__device__ __forceinline__ void final_norm(const Ctx& C, CArgs& a) {
    const int gw = C.bid * NWAVES + C.wave, NGW = C.nblk * NWAVES; const float* ssp = (const float*)(a.ws + WS_SSP); const bf16_t* X = (const bf16_t*)(a.ws + WS_X);
    f32x4 gv[4];
#pragma unroll
    for (int j = 0; j < 4; ++j) gv[j] = *((const f32x4*)a.in[I_NORM_FINAL] + C.lane + 64 * j);
    for (int m = gw; m < M; m += 2 * NGW) { const int m2 = (m + NGW < M) ? m + NGW : m;
        const float rs = pg8::row_rstd(ssp, m), rs2 = pg8::row_rstd(ssp, m2); const u32x2* xr = (const u32x2*)(X + (size_t)m * D) + C.lane; const u32x2* xr2 = (const u32x2*)(X + (size_t)m2 * D) + C.lane;
        u32x2 b1[4], b2[4];
#pragma unroll
        for (int j = 0; j < 4; ++j) { b1[j] = xr[64 * j]; b2[j] = xr2[64 * j]; }
        f32x4* orow = (f32x4*)(a.out + (size_t)m * D) + C.lane; f32x4* orow2 = (f32x4*)(a.out + (size_t)m2 * D) + C.lane;
#pragma unroll
        for (int j = 0; j < 4; ++j) { const f32x4 v = (f32x4){bf2f(b1[j].x & 0xffffu), __uint_as_float(b1[j].x & 0xffff0000u), bf2f(b1[j].y & 0xffffu), __uint_as_float(b1[j].y & 0xffff0000u)}; orow[64 * j] = v * gv[j] * rs; }
        if (m2 != m) {
#pragma unroll
            for (int j = 0; j < 4; ++j) { const f32x4 v = (f32x4){bf2f(b2[j].x & 0xffffu), __uint_as_float(b2[j].x & 0xffff0000u), bf2f(b2[j].y & 0xffffu), __uint_as_float(b2[j].y & 0xffff0000u)}; orow2[64 * j] = v * gv[j] * rs2; } } }
}

constexpr int N_PHASES = 16;
__global__ void __launch_bounds__(NTHREADS, 2) fwd_kernel(Args args) {
    extern __shared__ __attribute__((aligned(16))) unsigned char lds_raw[];
    LAS unsigned char* const lds = (LAS unsigned char*)lds_raw;
#if ONE_LAUNCH
    constexpr int lo = 0, hi = N_PHASES;
#else
    const int lo = get_args()->ph_lo, hi = get_args()->ph_hi;
#endif
#if ONE_LAUNCH
    cg::grid_group grid = cg::this_grid();
    volatile LAS unsigned* const bst = (volatile LAS unsigned*)(lds + LDS_BYTES - 64);
    if (threadIdx.x < 16) bst[threadIdx.x] = 0u;
    __syncthreads();
    if (get_args()->ph_lo < 0) grid.sync();
    (void)xcd_barrier_post((unsigned*)(get_args()->ws + WS_CTL), bst);
#define SEAM(k) do { if ((k) + 1 < hi) { XcdBarrier xb_; xb_.bar = (unsigned*)(get_args()->ws + WS_CTL); xb_.x = xb_xcc_id(); xb_.st = (volatile LAS unsigned*)(lds + LDS_BYTES - 64); xcd_barrier(xb_); } } while (0)
#else
#define SEAM(k) do { } while (0)
#endif
#define IN(k) (lo <= (k) && (k) < hi)
    if (PHK(0) && IN(0)) { const Ctx C = mk_ctx(lds); p0_prologue(C, *get_args()); SEAM(0); }
#define LAYER_BODY(layer) { \
        const int pb = 1 + 7 * layer; \
        if (PHK(1) && IN(pb)) { \
            CArgs& A = *get_args(); unsigned char* ws = A.ws; const Ctx C = mk_ctx(lds); \
            pg8::Gemm g{(const bf16_t*)(ws + WS_X), (const bf16_t*)(ws + (layer == 0 ? WS_WIN0 : WS_WIN1)), M, NP, D}; pg8::StaticOrder S; S.init(M, NP, C.nblk, C.bid); \
            pg8::EpiProj<0> E{(bf16_t*)(ws + WS_P), NP, (const float*)(ws + WS_SSP)}; \
            pg8::gemm_phase<pg8::EpiProj<0>, pg8::StaticOrder, true, true>(C.lds, C.tid, g, S, E); \
            { const int nun = (M / 256) * (NP / 256), extra = nun % C.nblk;        \
              const int nidle = extra ? C.nblk - extra : C.nblk, me = extra ? C.bid - extra : C.bid; \
              if (me >= 0) { const int lo_ = layer == 0 ? I_IN : PER_LAYER + I_IN, hi_ = layer == 0 ? PER_LAYER + I_IN : 2 * PER_LAYER; __syncthreads(); p0_weights(C, A, lo_, hi_, me * NWAVES + C.wave, nidle * NWAVES); } } \
            SEAM(pb); \
        } \
        if (IN(pb + 1)) { \
            CArgs& A = *get_args(); const Ctx C = mk_ctx(lds); \
            if (layer == 0) { if (PHK(2)) { for (int u = C.bid; u < 256; u += C.nblk) { const Ctx Cu = mk_ctx(lds); if (PHK(12)) sgu_unit(Cu, A, u); } for (int gi = C.bid; gi < 256; gi += C.nblk) gla_a_group(lds, A, gi); } } \
            else { if (PHK(3)) { u32x4 pf[5]; PrepK K; int hcur = -1; for (int u = C.bid; u < 4096; u += C.nblk) { const Ctx Cu = mk_ctx(lds); if ((u & 7) != hcur) { hcur = u & 7; prep_load_consts(Cu, A, hcur, K); prep_load_raw(Cu, A, u, K, pf); } const int nu = (u + C.nblk < 4096) ? u + C.nblk : -1; rwkv_prep_unit(Cu, A, u, (nu >= 0 && (nu & 7) == hcur) ? nu : -1, K, pf); } } } \
            SEAM(pb + 1); \
        } \
        if (IN(pb + 2)) { \
            CArgs& A = *get_args(); const Ctx C = mk_ctx(lds); \
            if (layer == 0) { } else { if (PHK(5)) { if (C.bid < 32 || C.nblk <= 32) rwkv_scan(C, A); if (C.bid >= 32 || C.nblk <= 32) { const int nb = C.nblk > 32 ? C.nblk - 32 : C.nblk; for (int u = (C.nblk > 32 ? C.bid - 32 : C.bid); u < 512; u += nb) { const Ctx Cu = mk_ctx(lds); for (int rr = 0; rr < REP_CONV; ++rr) conv_unit(Cu, A, u); } } } } \
            if (layer == 1) SEAM(pb + 2); \
        } \
        if (IN(pb + 3)) { \
            CArgs& A = *get_args(); const Ctx C = mk_ctx(lds); \
            if (layer == 0) { if (PHK(6)) for (int gi = C.bid; gi < 256; gi += C.nblk) gla_c_group(lds, A, gi); } \
            else { if (PHK(7)) rwkv_post_phase(C, A); } \
            SEAM(pb + 3); \
        } \
        if (PHK(8) && IN(pb + 4)) { \
            CArgs& A = *get_args(); unsigned char* ws = A.ws; const Ctx C = mk_ctx(lds); \
            pg8::Gemm g{(const bf16_t*)(ws + WS_MIX), (const bf16_t*)(ws + (layer == 0 ? WS_WOUT0 : WS_WOUT1)), M, D, D}; pg8::StaticOrder S; S.init(M, D, C.nblk, C.bid); \
            if (layer == 0) { pg8::EpiRes<true> E{A.in[I_X], (bf16_t*)(ws + WS_X), (float*)(ws + WS_SSP)}; pg8::gemm_phase<pg8::EpiRes<true>, pg8::StaticOrder, true, true>(C.lds, C.tid, g, S, E); } \
            else { pg8::EpiRes<false> E{nullptr, (bf16_t*)(ws + WS_X), (float*)(ws + WS_SSP)}; pg8::gemm_phase<pg8::EpiRes<false>, pg8::StaticOrder, true, true>(C.lds, C.tid, g, S, E); } \
            SEAM(pb + 4); \
        } \
        if (PHK(9) && IN(pb + 5)) { \
            CArgs& A = *get_args(); unsigned char* ws = A.ws; const Ctx C = mk_ctx(lds); \
            pg8::Gemm g{(const bf16_t*)(ws + WS_X), (const bf16_t*)(ws + (layer == 0 ? WS_WUP0 : WS_WUP1)), M, FF, D}; pg8::StaticOrder S; S.init(M, FF, C.nblk, C.bid); \
            pg8::EpiProj<1> E{(bf16_t*)(ws + WS_H), FF, (const float*)(ws + WS_SSP)}; \
            pg8::gemm_phase<pg8::EpiProj<1>, pg8::StaticOrder, true, true>(C.lds, C.tid, g, S, E); \
            SEAM(pb + 5); \
        } \
        if (PHK(10) && IN(pb + 6)) { \
            CArgs& A = *get_args(); unsigned char* ws = A.ws; const Ctx C = mk_ctx(lds); \
            pg8::Gemm g{(const bf16_t*)(ws + WS_H), (const bf16_t*)(ws + (layer == 0 ? WS_WDN0 : WS_WDN1)), M, D, FF}; pg8::StaticOrder S; S.init(M, D, C.nblk, C.bid); \
            pg8::EpiRes<false> E{nullptr, (bf16_t*)(ws + WS_X), (float*)(ws + WS_SSP)}; pg8::gemm_phase<pg8::EpiRes<false>, pg8::StaticOrder, true, true>(C.lds, C.tid, g, S, E); \
            SEAM(pb + 6); \
        } \
    }
    LAYER_BODY(0)
    LAYER_BODY(1)
#undef LAYER_BODY
    if (PHK(11) && IN(15)) { const Ctx C = mk_ctx(lds); final_norm(C, *get_args()); }
#undef IN
#undef SEAM
}

extern "C" void kernel_launch(void* const* d_in, const int* in_sizes, int n_in, void* d_out, int out_size, void* d_ws, size_t ws_size, hipStream_t stream) {
    static int grid = 0;
    if (grid == 0) {
        if (n_in != 32 || in_sizes[0] != M * D || out_size != M * D || ws_size < WS_END) { fprintf(stderr, "kernel_launch: unexpected shapes (n_in %d, in0 %d, out %d, ws %zu); nothing launched\n", n_in, n_in > 0 ? in_sizes[0] : -1, out_size, ws_size); grid = -1; return; }
        int dev = 0, cus = 0, per_cu = 0;
        if (hipGetDevice(&dev) != hipSuccess || hipDeviceGetAttribute(&cus, hipDeviceAttributeMultiprocessorCount, dev) != hipSuccess) { grid = -1; return; }
        if (hipFuncSetAttribute((const void*)fwd_kernel, hipFuncAttributeMaxDynamicSharedMemorySize, LDS_BYTES) != hipSuccess) { fprintf(stderr, "kernel_launch: hipFuncSetAttribute failed\n"); grid = -1; return; }
        if (hipOccupancyMaxActiveBlocksPerMultiprocessor(&per_cu, (const void*)fwd_kernel, NTHREADS, LDS_BYTES) != hipSuccess || per_cu < 1) { fprintf(stderr, "kernel_launch: occupancy query says %d blocks per CU\n", per_cu); per_cu = 1; }
        (void)hipGetLastError();
        grid = cus;
    }
    if (grid < 0) return;
    Args a{};
    for (int i = 0; i < 32; ++i) a.in[i] = (const float*)d_in[i];
    a.out = (float*)d_out; a.ws = (unsigned char*)d_ws;
#if ONE_LAUNCH
    a.ph_lo = 0; a.ph_hi = N_PHASES;
    if (hipMemsetAsync((char*)d_ws + WS_CTL, 0, 16384, stream) != hipSuccess) { fprintf(stderr, "kernel_launch: hipMemsetAsync failed\n"); return; }
    void* kargs[] = { &a };
    hipError_t e = hipLaunchCooperativeKernel((const void*)fwd_kernel, dim3(grid), dim3(NTHREADS), kargs, LDS_BYTES, stream);
    if (e != hipSuccess) fprintf(stderr, "kernel_launch: cooperative launch failed: %s (grid %d)\n", hipGetErrorString(e), grid);
#else
    for (int ph = 0; ph < N_PHASES; ++ph) {
        a.ph_lo = ph; a.ph_hi = ph + 1;
        hipLaunchKernelGGL(fwd_kernel, dim3(grid), dim3(NTHREADS), LDS_BYTES, stream, a);
        if ((REPEAT_PH >> ph) & 1) hipLaunchKernelGGL(fwd_kernel, dim3(grid), dim3(NTHREADS), LDS_BYTES, stream, a);
    }
#endif
}
```

```cpp
#include <hip/hip_runtime.h>
#include <hip/hip_cooperative_groups.h>
#include <cstdio>
#include <cstdint>
#include <type_traits>
namespace cg = cooperative_groups;

#ifndef ONE_LAUNCH
#define ONE_LAUNCH 1
#endif
#ifndef REP_STAGE
#define REP_STAGE 0
#endif
#ifndef REP_SGU
#define REP_SGU 1
#endif
#ifndef REP_GLAA
#define REP_GLAA 1
#endif
#ifndef REP_CONV
#define REP_CONV 1
#endif
#ifndef REP_PREP
#define REP_PREP 1
#endif
#ifndef REPEAT_PH
#define REPEAT_PH 0
#endif

#ifndef PH_MASK
#define PH_MASK 0xFFFF
#endif
#define PHK(b) (((PH_MASK) >> (b)) & 1)
#define LAS __attribute__((address_space(3)))
typedef unsigned short bf16_t;
typedef short bf16x8 __attribute__((ext_vector_type(8)));
typedef float f32x4 __attribute__((ext_vector_type(4)));
typedef float f32x2 __attribute__((ext_vector_type(2)));
typedef float f32x16 __attribute__((ext_vector_type(16)));
typedef unsigned u32x4 __attribute__((ext_vector_type(4)));
typedef unsigned u32x2 __attribute__((ext_vector_type(2)));
typedef LAS float lfloat;

constexpr int BATCH = 4, SEQ = 8192, D = 1024, FF = 4096;
constexpr int M = BATCH * SEQ;
constexpr int NP = 2816;
constexpr float RMS_EPS = 1e-6f, LN_EPS = 1e-5f, GN_EPS = 64e-5f;
constexpr int EC_Q = 0, EC_K = 256, EC_V = 512, EC_G = 1024, EC_U = 1536, EC_SV = 2048, EC_Z = 2560;
constexpr int OC_R = 0, OC_K = 512, OC_V = 1024, OC_CA = 1536, OC_CG = 2048, OC_XW = 2560, OC_XA = 2592, OC_XG = 2624;

constexpr size_t MiB = 1u << 20;
constexpr size_t WS_WIN0 = 2 * MiB, WS_WOUT0 = 8 * MiB, WS_WUP0 = 10 * MiB, WS_WDN0 = 18 * MiB;
constexpr size_t WS_WIN1 = 26 * MiB, WS_WOUT1 = 32 * MiB, WS_WUP1 = 34 * MiB, WS_WDN1 = 42 * MiB;
constexpr size_t WS_CTL = 0;
constexpr size_t WS_TAB = 1 * MiB;
constexpr size_t TAB_W2T = 0, TAB_A2T = 65536, TAB_G2T = 131072, TAB_CWT = 327680, TAB_GA2T = 393216, TAB_W2TB = 409600, TAB_A2TB = 442368, TAB_G2TB = 475136, TAB_SGUW = 589824;
constexpr size_t WS_SSP = 50 * MiB;
constexpr size_t WS_XN = 52 * MiB;
constexpr size_t WS_X = 436 * MiB;
constexpr size_t WS_MIX = 116 * MiB;
constexpr size_t WS_P = 180 * MiB;
constexpr size_t WS_H = 180 * MiB;
constexpr size_t WS_FREE = 436 * MiB;
constexpr size_t WS_END = 512 * MiB;
constexpr size_t WS_GLA_ST = WS_XN;
constexpr size_t WS_GLA_DL = 500 * MiB;
constexpr size_t WS_GLA_GD = WS_GLA_DL + 512 * 1024;
constexpr size_t WS_GLA_GL = WS_XN + 32 * MiB;
constexpr size_t WS_R_GP = WS_XN, WS_R_RP = WS_XN + 32 * MiB;
constexpr size_t WS_R_HADD = 356 * MiB, WS_R_Y0 = 388 * MiB;
constexpr size_t OUT_R_Y = 0, OUT_R_GC = 32 * MiB, OUT_R_BVF = 34 * MiB;
static_assert(WS_P + (size_t)M * NP * 2 <= WS_R_HADD, "P vs rwkv scratch");
static_assert(WS_R_Y0 + 32 * MiB <= WS_X && WS_X + 64 * MiB <= WS_GLA_DL && WS_GLA_DL + MiB <= WS_END, "ws map");

constexpr int NWAVES = 8, NTHREADS = 512;
constexpr int LDS_BYTES = 147456;

__device__ __forceinline__ float bf2f(unsigned v) { return __uint_as_float(v << 16); }
__device__ __forceinline__ unsigned f2bf(float f) { unsigned u = __float_as_uint(f); return (u + 0x7fffu + ((u >> 16) & 1u)) >> 16; }
__device__ __forceinline__ unsigned pk2(float lo, float hi) { return f2bf(lo) | (f2bf(hi) << 16); }
__device__ __forceinline__ float sigmoidf_(float x) { return 1.0f / (1.0f + __expf(-x)); }
__device__ __forceinline__ float fsigmoid(float x) { return __builtin_amdgcn_rcpf(1.0f + __expf(-x)); }
__device__ __forceinline__ float ftanh(float x) { return 1.0f - 2.0f * __builtin_amdgcn_rcpf(1.0f + __expf(2.0f * x)); }
__device__ __forceinline__ float silu_fast(float x) { return x * fsigmoid(x); }
__device__ __forceinline__ float siluf_(float x) { return x * sigmoidf_(x); }
__device__ __forceinline__ float geluf_(float x) { const float u = 1.5957691216057308f * (x + 0.044715f * x * x * x); return x * sigmoidf_(u); }
__device__ __forceinline__ float logsigmoidf_(float z) { return fminf(z, 0.f) - __logf(1.0f + __expf(-fabsf(z))); }
__device__ __forceinline__ float wave_sum(float v) {
#pragma unroll
    for (int o = 1; o < 64; o <<= 1) v += __shfl_xor(v, o);
    return v;
}
__device__ __forceinline__ void unpack8(const u32x4 w, float* f) {
    f[0] = bf2f(w.x & 0xffffu); f[1] = __uint_as_float(w.x & 0xffff0000u);
    f[2] = bf2f(w.y & 0xffffu); f[3] = __uint_as_float(w.y & 0xffff0000u);
    f[4] = bf2f(w.z & 0xffffu); f[5] = __uint_as_float(w.z & 0xffff0000u);
    f[6] = bf2f(w.w & 0xffffu); f[7] = __uint_as_float(w.w & 0xffff0000u);
}
__device__ __forceinline__ float ldbf(const bf16_t* p) { return bf2f((unsigned)*p); }

namespace pg8 {
#define PG8_LAS __attribute__((address_space(3)))
constexpr int BM = 256, BK = 64, HALF = 128, HTB = HALF * BK * 2, STAGE_BYTES = 8 * HTB, NXCD = 8, WGM = 8;
__host__ __device__ __forceinline__ int lds_byte(int r, int c) { const int st = (r >> 4) * 2 + (c >> 5), rr = r & 15, cc = c & 31, ob = rr * 64 + cc * 2; return st * 1024 + (ob ^ (((ob >> 9) & 1) << 5)); }
__host__ __device__ __forceinline__ void stage_rc(int b, int& R, int& C) { const int st = b / 1024, sb = b % 1024, swz = sb ^ (((sb >> 9) & 1) << 5); R = (st >> 1) * 16 + swz / 64; C = (st & 1) * 32 + (swz % 64) / 2; }
__host__ __device__ __forceinline__ int perm32(int rho) { const int n = rho >> 4, i = rho & 15; return 8 * (i >> 2) + 4 * n + (i & 3); }

struct Unit { int pm, pn; };
struct Gemm { const bf16_t* A; const bf16_t* Bt; int M, N, K; };
struct StaticOrder {
    int nM, nN, nwg, G, c;
    __host__ __device__ void init(int M_, int N_, int G_, int c_) { nM = M_ / BM; nN = N_ / BM; nwg = nM * nN; G = G_; c = c_; }
    __host__ __device__ bool next(int i, Unit& u) const {
        const long L = (long)i * G + c; if (L >= nwg) return false;
        int wgid = (int)L; { const int q = nwg / NXCD, r = nwg % NXCD, xcd = wgid % NXCD, off = wgid / NXCD; wgid = (xcd < r ? xcd * (q + 1) : r * (q + 1) + (xcd - r) * q) + off; }
        const int nig = WGM * nN, gid = wgid / nig, fm = gid * WGM, gsz = (nM - fm) < WGM ? (nM - fm) : WGM;
        u.pm = fm + ((wgid % nig) % gsz); u.pn = (wgid % nig) / gsz; return true;
    }
    __device__ __forceinline__ void a_ready(const Unit&) const {}
    __device__ __forceinline__ void done(const Unit&) const {}
};
typedef float f32x2_t_ __attribute__((ext_vector_type(2))); typedef __bf16 bf16x2_t_ __attribute__((ext_vector_type(2)));
__device__ __forceinline__ unsigned cvt_pk_bf16(float lo, float hi) { const f32x2_t_ v = {lo, hi}; const bf16x2_t_ b = __builtin_convertvector(v, bf16x2_t_); return __builtin_bit_cast(unsigned, b); }

__device__ __forceinline__ float row_rstd(const float* ssp, int r) {
    const f32x4* p = (const f32x4*)(ssp + (size_t)r * 16);
    const f32x4 a = p[0], b = p[1], c = p[2], d = p[3];
    const float s = ((a[0] + a[1]) + (a[2] + a[3])) + ((b[0] + b[1]) + (b[2] + b[3])) + ((c[0] + c[1]) + (c[2] + c[3])) + ((d[0] + d[1]) + (d[2] + d[3]));
    return 1.0f / sqrtf(s * (1.0f / 1024.0f) + RMS_EPS);
}
struct RstdState { float rs[2][4]; };
__device__ __forceinline__ void rstd_issue(const float* ssp, int row0, int fq, f32x4 (&raw)[2][4]) {
#pragma unroll
    for (int ai = 0; ai < 2; ++ai)
#pragma unroll
        for (int m = 0; m < 4; ++m) raw[ai][m] = *(const f32x4*)(ssp + (size_t)(row0 + ai * HALF + m * 16) * 16 + fq * 4);
}
__device__ __forceinline__ void rstd_finish(const f32x4 (&raw)[2][4], RstdState& st) {
#pragma unroll
    for (int ai = 0; ai < 2; ++ai)
#pragma unroll
        for (int m = 0; m < 4; ++m) { float s = (raw[ai][m][0] + raw[ai][m][1]) + (raw[ai][m][2] + raw[ai][m][3]);
            s += __shfl_xor(s, 16); s += __shfl_xor(s, 32);
            st.rs[ai][m] = __builtin_amdgcn_rsqf(s * (1.0f / 1024.0f) + RMS_EPS); }
}
template <int ACT> struct EpiProj {
    static constexpr bool PERM = true, AFTER_DRAIN = false;
    typedef RstdState State;
    bf16_t* O; int ldc; const float* ssp;
    __device__ __forceinline__ void init(State& st, const Unit& u, int wr, int fr, int fq) const {
        f32x4 raw[2][4]; rstd_issue(ssp, u.pm * BM + wr * 64 + fr, fq, raw); rstd_finish(raw, st);
    }
    __device__ __forceinline__ void operator()(const f32x4 (&acc)[2][2][4][2], State& st, const Unit& u, const Unit& un, bool has_next, int wr, int wc, int fr, int fq) const {
        const int row0 = u.pm * BM + wr * 64 + fr, col0 = u.pn * BM + wc * 32 + 8 * fq;
        f32x4 raw[2][4];
        if (has_next) rstd_issue(ssp, un.pm * BM + wr * 64 + fr, fq, raw);
#pragma unroll
        for (int ai = 0; ai < 2; ++ai)
#pragma unroll
            for (int m = 0; m < 4; ++m) { bf16_t* rowp = O + (size_t)(row0 + ai * HALF + m * 16) * ldc + col0; const float sc = st.rs[ai][m];
#pragma unroll
                for (int bj = 0; bj < 2; ++bj) { f32x4 v0 = acc[ai][bj][m][0] * sc, v1 = acc[ai][bj][m][1] * sc;
                    if (ACT == 1) {
#pragma unroll
                        for (int e = 0; e < 4; ++e) { const float a = fmaxf(v0[e], 0.f), b = fmaxf(v1[e], 0.f); v0[e] = a * a; v1[e] = b * b; } }
                    u32x4 w; w.x = cvt_pk_bf16(v0[0], v0[1]); w.y = cvt_pk_bf16(v0[2], v0[3]); w.z = cvt_pk_bf16(v1[0], v1[1]); w.w = cvt_pk_bf16(v1[2], v1[3]);
                    *(u32x4*)(rowp + bj * HALF) = w; } }
        if (has_next) rstd_finish(raw, st);
    }
};
template <bool BASE_F32> struct EpiRes {
    static constexpr bool PERM = true, AFTER_DRAIN = false;
    struct State {};
    const float* basef; bf16_t* X; float* ssp;
    __device__ __forceinline__ void init(State&, const Unit&, int, int, int) const {}
    __device__ __forceinline__ void operator()(const f32x4 (&acc)[2][2][4][2], State&, const Unit& u, const Unit&, bool, int wr, int wc, int fr, int fq) const {
        const int row0 = u.pm * BM + wr * 64 + fr, col0 = u.pn * BM + wc * 32 + 8 * fq;
#pragma unroll
        for (int ai = 0; ai < 2; ++ai) {
            f32x4 bf_[4][2][2]; u32x4 bb_[4][2];
#pragma unroll
            for (int m = 0; m < 4; ++m) { const size_t off = (size_t)(row0 + ai * HALF + m * 16) * D + col0;
#pragma unroll
                for (int bj = 0; bj < 2; ++bj) { if (BASE_F32) { bf_[m][bj][0] = *(const f32x4*)(basef + off + bj * HALF); bf_[m][bj][1] = *(const f32x4*)(basef + off + bj * HALF + 4); } else bb_[m][bj] = *(const u32x4*)(X + off + bj * HALF); } }
#pragma unroll
            for (int m = 0; m < 4; ++m) { const int r = row0 + ai * HALF + m * 16; const size_t off = (size_t)r * D + col0; float ss = 0.f;
#pragma unroll
                for (int bj = 0; bj < 2; ++bj) { f32x4 b0, b1;
                    if (BASE_F32) { b0 = bf_[m][bj][0]; b1 = bf_[m][bj][1]; }
                    else { const u32x4 bw = bb_[m][bj];
                        b0 = (f32x4){bf2f(bw.x & 0xffffu), __uint_as_float(bw.x & 0xffff0000u), bf2f(bw.y & 0xffffu), __uint_as_float(bw.y & 0xffff0000u)};
                        b1 = (f32x4){bf2f(bw.z & 0xffffu), __uint_as_float(bw.z & 0xffff0000u), bf2f(bw.w & 0xffffu), __uint_as_float(bw.w & 0xffff0000u)}; }
                    const f32x4 v0 = b0 + acc[ai][bj][m][0], v1 = b1 + acc[ai][bj][m][1];
                    ss += ((v0[0] * v0[0] + v0[1] * v0[1]) + (v0[2] * v0[2] + v0[3] * v0[3])) + ((v1[0] * v1[0] + v1[1] * v1[1]) + (v1[2] * v1[2] + v1[3] * v1[3]));
                    u32x4 w; w.x = cvt_pk_bf16(v0[0], v0[1]); w.y = cvt_pk_bf16(v0[2], v0[3]); w.z = cvt_pk_bf16(v1[0], v1[1]); w.w = cvt_pk_bf16(v1[2], v1[3]);
                    *(u32x4*)(X + off + bj * HALF) = w; }
                ss += __shfl_xor(ss, 16); ss += __shfl_xor(ss, 32);
                if (fq == 0) ssp[(size_t)r * 16 + u.pn * 4 + wc] = ss; }
        }
    }
};

template <class Epi, class Sched, bool ALIGN_EPI = false, bool SP2 = false>
__device__ __forceinline__ void gemm_phase(PG8_LAS unsigned char* lds, const int tid, const Gemm g, const Sched& S, const Epi& E) {
    const int wid = __builtin_amdgcn_readfirstlane(tid >> 6), lane = tid & 63, wr = wid >> 2, wc = wid & 3, fr = lane & 15, fq = lane >> 4;
    const int K = g.K, nt = K / BK;
    unsigned voffA[2], voffB[2];
#pragma unroll
    for (int i = 0; i < 2; ++i) { int R, C; stage_rc(tid * 16 + i * 8192, R, C); const int Rb = Epi::PERM ? ((R & ~31) + perm32(R & 31)) : R;
        voffA[i] = (unsigned)(R * K + C) * 2u; voffB[i] = (unsigned)(Rb * K + C) * 2u; }
    const size_t kstep = (size_t)(BK * 2);
    const size_t hstep = (size_t)HALF * K * 2;
    const size_t tstep = 2 * hstep;
    const unsigned ldsw = (unsigned)wid * 1024u;
    const int aoff = lds_byte(wr * 64 + fr, fq * 8), boff = lds_byte(wc * 32 + fr, fq * 8);
#define PG8_SA(b, h) (((b) * 2 + (h)) * HTB)
#define PG8_SB(b, h) ((4 + (b) * 2 + (h)) * HTB)
#define PG8_STAGE(bufoff, gbase, voff) do { _Pragma("unroll") for (int _i = 0; _i < 2; ++_i) \
        __builtin_amdgcn_global_load_lds((const unsigned*)((const char*)(gbase) + (voff)[_i]), (PG8_LAS unsigned*)(lds + (bufoff) + ldsw + _i * 8192), 16, 0, 0); } while (0)
#define PG8_LDA(dst, b, h) do { _Pragma("unroll") for (int m = 0; m < 4; ++m) _Pragma("unroll") for (int k = 0; k < 2; ++k) dst[m][k] = *(const PG8_LAS bf16x8*)(lds + PG8_SA(b, h) + aoff + m * 2048 + k * 1024); } while (0)
#define PG8_LDB(dst, b, h) do { _Pragma("unroll") for (int n = 0; n < 2; ++n) _Pragma("unroll") for (int k = 0; k < 2; ++k) dst[n][k] = *(const PG8_LAS bf16x8*)(lds + PG8_SB(b, h) + boff + n * 2048 + k * 1024); } while (0)
#define PG8_MMA(ai, bj, At, Bt) do { __builtin_amdgcn_s_setprio(1); _Pragma("unroll") for (int m = 0; m < 4; ++m) _Pragma("unroll") for (int n = 0; n < 2; ++n) _Pragma("unroll") for (int k = 0; k < 2; ++k) \
        acc[ai][bj][m][n] = __builtin_amdgcn_mfma_f32_16x16x32_bf16(Bt[n][k], At[m][k], acc[ai][bj][m][n], 0, 0, 0); __builtin_amdgcn_s_setprio(0); } while (0)
#define PG8_WAIT_V(n) asm volatile("s_waitcnt vmcnt(" #n ")" ::: "memory")
#define PG8_WAIT_L(n) asm volatile("s_waitcnt lgkmcnt(" #n ")" ::: "memory")
#define PG8_BAR __builtin_amdgcn_s_barrier()
#define PG8_SCHED __builtin_amdgcn_sched_barrier(0)
    Unit cur, nxt; int ui = 0;
    if (!S.next(0, cur)) return;
    f32x4 acc[2][2][4][2];
#pragma unroll
    for (int a = 0; a < 2; ++a)
#pragma unroll
        for (int b = 0; b < 2; ++b)
#pragma unroll
            for (int m = 0; m < 4; ++m)
#pragma unroll
                for (int n = 0; n < 2; ++n) acc[a][b][m][n] = (f32x4){0.f, 0.f, 0.f, 0.f};
    bf16x8 At[4][2], B0[2][2], B1[2][2];
    const char* cA = (const char*)g.A + (size_t)cur.pm * tstep; const char* cB = (const char*)g.Bt + (size_t)cur.pn * tstep;
    S.a_ready(cur);
    typename Epi::State est; E.init(est, cur, wr, fr, fq);
    if constexpr (SP2) {
        PG8_STAGE(PG8_SB(0, 0), cB, voffB); PG8_STAGE(PG8_SB(0, 1), cB + hstep, voffB); PG8_STAGE(PG8_SA(0, 0), cA, voffA); PG8_STAGE(PG8_SA(0, 1), cA + hstep, voffA);
        if (wr == 1) PG8_BAR;
        PG8_WAIT_V(2); PG8_BAR;
        PG8_STAGE(PG8_SB(1, 0), cB + kstep, voffB); PG8_STAGE(PG8_SA(1, 0), cA + kstep, voffA); PG8_STAGE(PG8_SB(1, 1), cB + hstep + kstep, voffB);
        PG8_WAIT_V(6); PG8_BAR;
    } else {
        PG8_STAGE(PG8_SB(0, 0), cB, voffB); PG8_STAGE(PG8_SA(0, 0), cA, voffA); PG8_STAGE(PG8_SB(0, 1), cB + hstep, voffB); PG8_STAGE(PG8_SA(0, 1), cA + hstep, voffA);
        if (wr == 1) PG8_BAR;
        PG8_WAIT_V(4); PG8_BAR;
        PG8_STAGE(PG8_SB(1, 0), cB + kstep, voffB); PG8_STAGE(PG8_SA(1, 0), cA + kstep, voffA); PG8_STAGE(PG8_SB(1, 1), cB + hstep + kstep, voffB);
        PG8_WAIT_V(6); PG8_BAR;
    }
    for (;;) {
        const bool has_next = S.next(ui + 1, nxt);
        const char* nA = has_next ? (const char*)g.A + (size_t)nxt.pm * tstep : cA; const char* nB = has_next ? (const char*)g.Bt + (size_t)nxt.pn * tstep : cB;
        for (int t = 0; t < nt; t += 2) {
            const bool last = (t == nt - 2);
            const char* a1 = cA + (size_t)(t + 1) * kstep;
            const char* a2 = last ? nA : cA + (size_t)(t + 2) * kstep; const char* b2 = last ? nB : cB + (size_t)(t + 2) * kstep;
            const char* a3 = a2 + kstep; const char* b3 = b2 + kstep;
            if (last && has_next) S.a_ready(nxt);
            if constexpr (SP2) {
            PG8_LDB(B0, 0, 0); PG8_LDB(B1, 0, 1); PG8_SCHED; PG8_LDA(At, 0, 0); PG8_STAGE(PG8_SA(1, 1), a1 + hstep, voffA);
            PG8_WAIT_V(8); PG8_WAIT_L(0); PG8_BAR; PG8_MMA(0, 0, At, B0); PG8_MMA(0, 1, At, B1); PG8_BAR; PG8_SCHED;
            PG8_LDA(At, 0, 1); PG8_STAGE(PG8_SB(0, 0), b2, voffB); PG8_STAGE(PG8_SB(0, 1), b2 + hstep, voffB); PG8_STAGE(PG8_SA(0, 0), a2, voffA);
            PG8_WAIT_V(8); PG8_WAIT_L(0); PG8_BAR; PG8_MMA(1, 0, At, B0); PG8_MMA(1, 1, At, B1); PG8_BAR; PG8_SCHED;
            PG8_LDB(B0, 1, 0); PG8_LDB(B1, 1, 1); PG8_SCHED; PG8_LDA(At, 1, 0); PG8_STAGE(PG8_SA(0, 1), a2 + hstep, voffA);
            PG8_WAIT_V(8); PG8_WAIT_L(0); PG8_BAR; PG8_MMA(0, 0, At, B0); PG8_MMA(0, 1, At, B1); PG8_BAR; PG8_SCHED;
            PG8_LDA(At, 1, 1); PG8_STAGE(PG8_SB(1, 0), b3, voffB); PG8_STAGE(PG8_SB(1, 1), b3 + hstep, voffB); PG8_STAGE(PG8_SA(1, 0), a3, voffA);
            PG8_WAIT_V(8); PG8_WAIT_L(0); PG8_BAR; PG8_MMA(1, 0, At, B0); PG8_MMA(1, 1, At, B1); PG8_BAR; PG8_SCHED;
            } else {
            PG8_LDB(B0, 0, 0); PG8_SCHED; PG8_LDA(At, 0, 0); PG8_STAGE(PG8_SA(1, 1), a1 + hstep, voffA);
            PG8_WAIT_L(8); PG8_BAR; PG8_WAIT_L(0); PG8_MMA(0, 0, At, B0); PG8_BAR; PG8_SCHED;
            PG8_LDB(B1, 0, 1); PG8_STAGE(PG8_SB(0, 0), b2, voffB);
            PG8_BAR; PG8_WAIT_L(0); PG8_MMA(0, 1, At, B1); PG8_BAR;
            PG8_LDA(At, 0, 1); PG8_STAGE(PG8_SA(0, 0), a2, voffA);
            PG8_BAR; PG8_WAIT_L(0); PG8_MMA(1, 0, At, B0); PG8_BAR; PG8_SCHED;
            PG8_STAGE(PG8_SB(0, 1), b2 + hstep, voffB);
            PG8_WAIT_V(6); PG8_BAR; PG8_MMA(1, 1, At, B1); PG8_BAR;
            PG8_LDB(B0, 1, 0); PG8_SCHED; PG8_LDA(At, 1, 0); PG8_STAGE(PG8_SA(0, 1), a2 + hstep, voffA);
            PG8_WAIT_L(8); PG8_BAR; PG8_WAIT_L(0); PG8_MMA(0, 0, At, B0); PG8_BAR; PG8_SCHED;
            PG8_LDB(B1, 1, 1); PG8_STAGE(PG8_SB(1, 0), b3, voffB);
            PG8_BAR; PG8_WAIT_L(0); PG8_MMA(0, 1, At, B1); PG8_BAR;
            PG8_LDA(At, 1, 1); PG8_STAGE(PG8_SA(1, 0), a3, voffA);
            PG8_BAR; PG8_WAIT_L(0); PG8_MMA(1, 0, At, B0); PG8_BAR; PG8_SCHED;
            PG8_STAGE(PG8_SB(1, 1), b3 + hstep, voffB);
            PG8_WAIT_V(6); PG8_BAR; PG8_MMA(1, 1, At, B1); PG8_BAR;
            }
        }
        if constexpr (ALIGN_EPI) { if (wr == 0) PG8_BAR; }
        if constexpr (!Epi::AFTER_DRAIN) { E(acc, est, cur, nxt, has_next, wr, wc, fr, fq); S.done(cur); }
        if (!has_next) break;
#pragma unroll
        for (int a = 0; a < 2; ++a)
#pragma unroll
            for (int b = 0; b < 2; ++b)
#pragma unroll
                for (int m = 0; m < 4; ++m)
#pragma unroll
                    for (int n = 0; n < 2; ++n) acc[a][b][m][n] = (f32x4){0.f, 0.f, 0.f, 0.f};
        cur = nxt; cA = nA; cB = nB; ++ui;
        if constexpr (ALIGN_EPI) { if (wr == 1) PG8_BAR; }
    }
    PG8_WAIT_V(0);
    if constexpr (!ALIGN_EPI) { if (wr == 0) PG8_BAR; }
    PG8_BAR;
#undef PG8_SA
#undef PG8_SB
#undef PG8_STAGE
#undef PG8_LDA
#undef PG8_LDB
#undef PG8_MMA
#undef PG8_WAIT_V
#undef PG8_WAIT_L
#undef PG8_BAR
#undef PG8_SCHED
}
}


#define XB_TMO      128
#define XB_XCNT(j)  (256  + 64 * (j))
#define XB_XSUB(j)  (1280 + 64 * (j))
#define XB_XGEN(j)  (2304 + 64 * (j))
#define XB_TOP      3328
#define XB_TOPGEN   3392
#define XCD_BAR_WORDS 3456
#define XB_SPIN_CAP (1u << 18)
__device__ __forceinline__ unsigned xb_ld(unsigned* p)              { return __hip_atomic_load(p, __ATOMIC_RELAXED, __HIP_MEMORY_SCOPE_AGENT); }
__device__ __forceinline__ unsigned xb_add(unsigned* p, unsigned v) { return __hip_atomic_fetch_add(p, v, __ATOMIC_RELAXED, __HIP_MEMORY_SCOPE_AGENT); }
__device__ __forceinline__ unsigned xb_xcc_id() { return (unsigned)__builtin_amdgcn_s_getreg((3 << 11) | 20) & 0xFu; }
#define XB_SPIN(cond, bar) do { unsigned _sp = 0; while (cond) { __builtin_amdgcn_s_sleep(1); \
    if ((++_sp & 255u) == 0u) { if (xb_ld(&(bar)[XB_TMO])) break; if (_sp > XB_SPIN_CAP) { atomicAdd(&(bar)[XB_TMO], 1u); break; } } } } while (0)
struct XcdBarrier { unsigned* bar; unsigned x; volatile LAS unsigned* st; };
__device__ __forceinline__ XcdBarrier xcd_barrier_post(unsigned* bar, volatile LAS unsigned* st) {
    XcdBarrier b; b.bar = bar; b.x = xb_xcc_id(); b.st = st;
    if (threadIdx.x == 0) (void)xb_add(&bar[XB_XCNT(b.x)], 1u);
    return b;
}
__device__ __forceinline__ void xcd_barrier_complete(unsigned* bar, unsigned x, unsigned& nloc, unsigned& nx) {
    const unsigned G = gridDim.x * gridDim.y * gridDim.z;
    unsigned sum, cnt, mine, sp = 0u;
    for (;;) {
        sum = 0u; cnt = 0u; mine = 0u;
#pragma unroll
        for (unsigned j = 0; j < 16; ++j) { const unsigned c = xb_ld(&bar[XB_XCNT(j)]); sum += c; cnt += (c > 0u) ? 1u : 0u; mine = (j == x) ? c : mine; }
        if (sum == G) break;
        __builtin_amdgcn_s_sleep(1);
        if ((++sp & 255u) == 0u) { if (xb_ld(&bar[XB_TMO])) break; if (sp > XB_SPIN_CAP) { atomicAdd(&bar[XB_TMO], 1u); break; } }
    }
    nloc = mine > 0u ? mine : 1u; nx = cnt > 0u ? cnt : 1u;
}
__device__ __forceinline__ void xcd_barrier(const XcdBarrier& b) {
    asm volatile("s_waitcnt vmcnt(0)" ::: "memory");
    __syncthreads();
    if (threadIdx.x == 0) {
        unsigned* bar = b.bar;
        __builtin_amdgcn_s_waitcnt(0);
        asm volatile("buffer_inv sc1" ::: "memory");
        unsigned nloc = b.st[0], nx = b.st[1];
        if (nloc == 0u) { xcd_barrier_complete(bar, b.x, nloc, nx); b.st[0] = nloc; b.st[1] = nx; }
        const unsigned old = xb_add(&bar[XB_XSUB(b.x)], 1u);
        const unsigned gen = old / nloc;
        if (old + 1u == (gen + 1u) * nloc) {
            __builtin_amdgcn_fence(__ATOMIC_RELEASE, "agent");
            asm volatile("s_waitcnt vmcnt(0)" ::: "memory");
            const unsigned og = xb_add(&bar[XB_TOP], 1u);
            const unsigned tg = og / nx;
            if (og + 1u == (tg + 1u) * nx) xb_add(&bar[XB_TOPGEN], 1u);
            else XB_SPIN(xb_ld(&bar[XB_TOPGEN]) == tg, bar);
            xb_add(&bar[XB_XGEN(b.x)], 1u);
            asm volatile("s_waitcnt vmcnt(0)" ::: "memory");
        } else {
            XB_SPIN(xb_ld(&bar[XB_XGEN(b.x)]) == gen, bar);
            asm volatile("s_waitcnt vmcnt(0)" ::: "memory");
        }
    }
    __syncthreads();
}

struct Args { const float* in[32]; float* out; unsigned char* ws; int ph_lo, ph_hi; };
enum { I_X = 0, I_NORM_MIX, I_NORM_FFN, I_W_UP, I_W_DOWN, I_NORM_FINAL, I_EVEN_W_IN, I_EVEN_W_OUT, I_GLA_W_ALPHA2, I_GLA_B_ALPHA, I_GLA_NORM,
       I_SGU_LN_G, I_SGU_LN_B, I_SGU_W, I_SGU_B, I_ODD_W_IN, I_ODD_W_OUT, I_RWKV_MU, I_RWKV_W0, I_RWKV_W2, I_RWKV_A0, I_RWKV_A2, I_RWKV_G2,
       I_RWKV_K_K, I_RWKV_K_A, I_RWKV_R_K, I_RWKV_GN_G, I_RWKV_GN_B, I_CONV_W, I_CONV_B, I_CONV_LN_G, I_CONV_LN_B };

struct Ctx { LAS unsigned char* lds; int tid, lane, wave, bid, nblk; };
__device__ __forceinline__ Ctx mk_ctx(LAS unsigned char* lds) { Ctx C; C.lds = lds; int t = threadIdx.x, b = blockIdx.x, g = gridDim.x; asm volatile("" : "+v"(t), "+s"(b), "+s"(g));
    C.tid = t; C.lane = t & 63; C.wave = __builtin_amdgcn_readfirstlane(t >> 6); C.bid = b; C.nblk = g; return C; }
typedef __attribute__((address_space(4))) const Args CArgs;
__device__ __forceinline__ CArgs* get_args() { CArgs* p = (CArgs*)__builtin_amdgcn_kernarg_segment_ptr(); asm volatile("" : "+s"(p)); return p; }

template <int MODE> __device__ __forceinline__ int colmap(int n) {
    if (MODE == 0) return n;
    if (MODE == 1) return n < 1536 ? n : (n < 2560 ? n + 16 : -2);
    return n < 1536 ? n : (n < 2560 ? n + 160 : (n < 2720 ? n - 1024 : -1));
}
template <int MODE> __device__ __forceinline__ void p0_transpose_item(const float* W, const float* gain, int K, int Nsrc, int Ndst, bf16_t* WT, LAS float* scr, int item, int lane) {
    const int nblk = Ndst / 32, kb = item / nblk, nb = item % nblk, k0 = 64 * kb, n0 = 32 * nb;
    const int src = colmap<MODE>(n0 + (lane & 31));
    if (MODE == 1 && n0 >= 2560) return;
    float wv_[32];
#pragma unroll
    for (int i = 0; i < 32; ++i) { const int kk = 2 * i + (lane >> 5); wv_[i] = src >= 0 ? W[(size_t)(k0 + kk) * Nsrc + src] : 0.f; }
    if (gain) {
#pragma unroll
        for (int i = 0; i < 32; ++i) wv_[i] *= gain[k0 + 2 * i + (lane >> 5)]; }
#pragma unroll
    for (int i = 0; i < 32; ++i) scr[(2 * i + (lane >> 5)) * 33 + (lane & 31)] = wv_[i];
    asm volatile("s_waitcnt lgkmcnt(0)" ::: "memory");
    const int c = lane & 7;
#pragma unroll
    for (int j = 0; j < 4; ++j) { const int n = (lane >> 3) + 8 * j; const LAS float* s = scr + (8 * c) * 33 + n;
        u32x4 o; o.x = pk2(s[0 * 33], s[1 * 33]); o.y = pk2(s[2 * 33], s[3 * 33]); o.z = pk2(s[4 * 33], s[5 * 33]); o.w = pk2(s[6 * 33], s[7 * 33]);
        *(u32x4*)(WT + (size_t)(n0 + n) * K + k0 + 8 * c) = o; }
    asm volatile("s_waitcnt lgkmcnt(0)" ::: "memory");
}
constexpr int I_IN = (D / 64) * (NP / 32), I_OUT = (D / 64) * (D / 32), I_UP = (D / 64) * (FF / 32), I_DN = (FF / 64) * (D / 32);
constexpr int PER_LAYER = I_IN + I_OUT + I_UP + I_DN;
__device__ __forceinline__ void p0_weights(const Ctx& C, CArgs& a, int lo, int hi, int gw, int NGW) {
    LAS float* scr = (LAS float*)(C.lds + C.wave * 16384);
    unsigned char* ws = a.ws;
    for (int it = lo + gw; it < hi; it += NGW) {
        const int layer = it / PER_LAYER; int r = it % PER_LAYER;
        if (r < I_IN) { if (layer == 0) p0_transpose_item<1>(a.in[I_EVEN_W_IN], a.in[I_NORM_MIX], D, 2576, NP, (bf16_t*)(ws + WS_WIN0), scr, r, C.lane);
                        else p0_transpose_item<2>(a.in[I_ODD_W_IN], a.in[I_NORM_MIX] + D, D, 2720, NP, (bf16_t*)(ws + WS_WIN1), scr, r, C.lane); continue; } r -= I_IN;
        if (r < I_OUT) { p0_transpose_item<0>(layer == 0 ? a.in[I_EVEN_W_OUT] : a.in[I_ODD_W_OUT], nullptr, D, D, D, (bf16_t*)(ws + (layer == 0 ? WS_WOUT0 : WS_WOUT1)), scr, r, C.lane); continue; } r -= I_OUT;
        if (r < I_UP) { p0_transpose_item<0>(a.in[I_W_UP] + (size_t)layer * D * FF, a.in[I_NORM_FFN] + layer * D, D, FF, FF, (bf16_t*)(ws + (layer == 0 ? WS_WUP0 : WS_WUP1)), scr, r, C.lane); continue; } r -= I_UP;
        p0_transpose_item<0>(a.in[I_W_DOWN] + (size_t)layer * FF * D, nullptr, FF, D, D, (bf16_t*)(ws + (layer == 0 ? WS_WDN0 : WS_WDN1)), scr, r, C.lane);
    }
}
__device__ __forceinline__ void p0_prologue(const Ctx& C, CArgs& a) {
    const int gw = C.bid * NWAVES + C.wave, NGW = C.nblk * NWAVES;
    unsigned char* ws = a.ws;
    p0_weights(C, a, 0, I_IN, gw, NGW);
    { const int gt = C.bid * NTHREADS + C.tid, NGT = C.nblk * NTHREADS; float* tab = (float*)(ws + WS_TAB);
      for (int i = gt; i < 512 * 32; i += NGT) { const int c = i >> 5, j = i & 31; tab[TAB_W2T / 4 + i] = a.in[I_RWKV_W2][j * 512 + c]; tab[TAB_A2T / 4 + i] = a.in[I_RWKV_A2][j * 512 + c];
          ((bf16_t*)(ws + WS_TAB + TAB_W2TB))[i] = (bf16_t)f2bf(a.in[I_RWKV_W2][j * 512 + c]); ((bf16_t*)(ws + WS_TAB + TAB_A2TB))[i] = (bf16_t)f2bf(a.in[I_RWKV_A2][j * 512 + c]);
          tab[TAB_CWT / 4 + i] = j < 31 ? a.in[I_CONV_W][j * 512 + c] : 0.f; }
      for (int i = gt; i < 512 * 96; i += NGT) { const int c = i / 96, j = i % 96; tab[TAB_G2T / 4 + i] = a.in[I_RWKV_G2][j * 512 + c]; ((bf16_t*)(ws + WS_TAB + TAB_G2TB))[i] = (bf16_t)f2bf(a.in[I_RWKV_G2][j * 512 + c]); }
      for (int i = gt; i < 256 * 128; i += NGT) { const int n = i >> 7, k8 = i & 127; float wa[16];
#pragma unroll
          for (int j = 0; j < 16; ++j) wa[j] = a.in[I_GLA_W_ALPHA2][j * 256 + n];
          unsigned o[4];
#pragma unroll
          for (int e = 0; e < 8; ++e) { const int k = 8 * k8 + e; const f32x4* wr = (const f32x4*)(a.in[I_EVEN_W_IN] + (size_t)k * 2576 + 1536); float acc = 0.f;
#pragma unroll
              for (int j4 = 0; j4 < 4; ++j4) { const f32x4 v = wr[j4]; acc += v[0] * wa[4 * j4] + v[1] * wa[4 * j4 + 1] + v[2] * wa[4 * j4 + 2] + v[3] * wa[4 * j4 + 3]; }
              acc *= a.in[I_NORM_MIX][k];
              if (e & 1) o[e >> 1] |= f2bf(acc) << 16; else o[e >> 1] = f2bf(acc); }
          *(u32x4*)((bf16_t*)(ws + WS_WIN0) + (size_t)(2560 + n) * D + 8 * k8) = (u32x4){o[0], o[1], o[2], o[3]}; }
      for (int i = gt; i < 4 * 128 * 128; i += NGT) { const int t = (i >> 7) & 127, sx = i & 127; ((bf16_t*)(ws + WS_TAB + TAB_SGUW))[i] = (bf16_t)f2bf(sx <= t ? a.in[I_SGU_W][i] : 0.f); } }
    const float* x = a.in[I_X]; bf16_t* X = (bf16_t*)(ws + WS_X); float* SSP = (float*)(ws + WS_SSP);
    for (int m = gw; m < M; m += 2 * NGW) {
        const int m2 = m + NGW; const bool has2 = m2 < M;
        const f32x4* xr = (const f32x4*)(x + (size_t)m * D) + C.lane; const f32x4* xr2 = (const f32x4*)(x + (size_t)(has2 ? m2 : m) * D) + C.lane; f32x4 v[4], v2[4]; float s = 0.f, s2 = 0.f;
#pragma unroll
        for (int j = 0; j < 4; ++j) { v[j] = xr[64 * j]; v2[j] = xr2[64 * j]; }
#pragma unroll
        for (int j = 0; j < 4; ++j) { s += (v[j][0] * v[j][0] + v[j][1] * v[j][1]) + (v[j][2] * v[j][2] + v[j][3] * v[j][3]); s2 += (v2[j][0] * v2[j][0] + v2[j][1] * v2[j][1]) + (v2[j][2] * v2[j][2] + v2[j][3] * v2[j][3]); }
        s = wave_sum(s); s2 = wave_sum(s2);
        u32x2* o8 = (u32x2*)(X + (size_t)m * D) + C.lane;
#pragma unroll
        for (int j = 0; j < 4; ++j) { u32x2 w; w.x = pk2(v[j][0], v[j][1]); w.y = pk2(v[j][2], v[j][3]); o8[64 * j] = w; }
        if (C.lane < 16) SSP[(size_t)m * 16 + C.lane] = (C.lane == 0) ? s : 0.f;
        if (has2) { u32x2* o82 = (u32x2*)(X + (size_t)m2 * D) + C.lane;
#pragma unroll
            for (int j = 0; j < 4; ++j) { u32x2 w; w.x = pk2(v2[j][0], v2[j][1]); w.y = pk2(v2[j][2], v2[j][3]); o82[64 * j] = w; }
            if (C.lane < 16) SSP[(size_t)m2 * 16 + C.lane] = (C.lane == 0) ? s2 : 0.f; }
    }
}

constexpr int RP = 72;
__device__ __forceinline__ bf16x8 ldfrag(LAS unsigned char* lds, int base, int row, int col) { return *(const LAS bf16x8*)(lds + base + (row * RP + col) * 2); }
__device__ __forceinline__ bf16x8 ldfrag2(LAS unsigned char* lds, int base, int pitch, int row, int c0, int c1) {
    const u32x2 lo = *(const LAS u32x2*)(lds + base + (row * pitch + c0) * 2), hi = *(const LAS u32x2*)(lds + base + (row * pitch + c1) * 2);
    const u32x4 w = (u32x4){lo.x, lo.y, hi.x, hi.y}; return __builtin_bit_cast(bf16x8, w);
}
__device__ __forceinline__ bf16x8 ldfrag_lo(LAS unsigned char* lds, int base, int pitch, int row, int c0) {
    const u32x2 lo = *(const LAS u32x2*)(lds + base + (row * pitch + c0) * 2); const u32x4 w = (u32x4){lo.x, lo.y, 0u, 0u}; return __builtin_bit_cast(bf16x8, w);
}
__device__ __forceinline__ bf16x8 mkfrag(const f32x4 lo, const f32x4 hi) { const u32x4 w = (u32x4){pg8::cvt_pk_bf16(lo[0], lo[1]), pg8::cvt_pk_bf16(lo[2], lo[3]), pg8::cvt_pk_bf16(hi[0], hi[1]), pg8::cvt_pk_bf16(hi[2], hi[3])}; return __builtin_bit_cast(bf16x8, w); }
__device__ __forceinline__ bf16x8 mkfrag_lo(const f32x4 lo) { const u32x4 w = (u32x4){pg8::cvt_pk_bf16(lo[0], lo[1]), pg8::cvt_pk_bf16(lo[2], lo[3]), 0u, 0u}; return __builtin_bit_cast(bf16x8, w); }
#define MFMA16(a, b, c) __builtin_amdgcn_mfma_f32_16x16x32_bf16((a), (b), (c), 0, 0, 0)
#define DPP_ADD(v, ctrl) (v) += __int_as_float(__builtin_amdgcn_mov_dpp(__float_as_int(v), (ctrl), 0xF, 0xF, true))
__device__ __forceinline__ float wave_sum_dpp(float v) {
    DPP_ADD(v, 0xB1); DPP_ADD(v, 0x4E); DPP_ADD(v, 0x141); DPP_ADD(v, 0x140);
    { auto p = __builtin_amdgcn_permlane16_swap(__float_as_uint(v), __float_as_uint(v), false, false); v = __uint_as_float(p[0]) + __uint_as_float(p[1]); }
    { auto p = __builtin_amdgcn_permlane32_swap(__float_as_uint(v), __float_as_uint(v), false, false); v = __uint_as_float(p[0]) + __uint_as_float(p[1]); }
    return v;
}
constexpr int GP_ = 72;
__device__ __forceinline__ void gla_decay(const Ctx& C, CArgs& a, const bf16_t* P, int tok0, int h, LAS float* TOT, float (&bv)[8], float& total) {
    const int col = h * 64 + C.lane; const float ba = a.in[I_GLA_B_ALPHA][col];
    float z[8];
#pragma unroll
    for (int i = 0; i < 8; ++i) z[i] = ldbf(P + (size_t)(tok0 + 8 * C.wave + i) * NP + EC_Z + col);
    float pre = 0.f;
#pragma unroll
    for (int i = 0; i < 8; ++i) { pre += logsigmoidf_(z[i] + ba) * (1.0f / 16.0f); bv[i] = pre; }
    TOT[C.wave * 64 + C.lane] = pre;
    __syncthreads();
    float off = 0.f, tot = 0.f;
#pragma unroll
    for (int w = 0; w < 8; ++w) { const float tv = TOT[w * 64 + C.lane]; tot += tv; if (w < C.wave) off += tv; }
#pragma unroll
    for (int i = 0; i < 8; ++i) bv[i] += off;
    total = tot;
}
__device__ __forceinline__ void gla_load_vt(const Ctx& C, const bf16_t* P, int tok0, int h, LAS unsigned char* VT) {
    unsigned lo[4], hi[4];
#pragma unroll
    for (int i = 0; i < 8; ++i) { const bf16_t* pr = P + (size_t)(tok0 + 8 * C.wave + i) * NP + EC_V + h * 128 + C.lane; const unsigned x0 = pr[0], x1 = pr[64];
        if (i & 1) { lo[i >> 1] |= x0 << 16; hi[i >> 1] |= x1 << 16; } else { lo[i >> 1] = x0; hi[i >> 1] = x1; } }
    *(LAS u32x4*)(VT + (C.lane * GP_ + 8 * C.wave) * 2) = (u32x4){lo[0], lo[1], lo[2], lo[3]};
    *(LAS u32x4*)(VT + ((C.lane + 64) * GP_ + 8 * C.wave) * 2) = (u32x4){hi[0], hi[1], hi[2], hi[3]};
}
__device__ __forceinline__ void gla_a_unit(const Ctx& C, CArgs& a, int uid, f32x4 (&Srun)[4], float& dprod) {
    const int h = uid & 3, n = (uid >> 2) & 127, b = uid >> 9, tok0 = b * SEQ + n * 64;
    const bf16_t* P = (const bf16_t*)(a.ws + WS_P);
    LAS unsigned char* lds = C.lds; constexpr int L_VT_ = 0, L_KST_ = 128 * GP_ * 2, L_TOT_ = L_KST_ + 64 * GP_ * 2, L_DLS_ = L_TOT_ + 2048;
    const int q = C.lane >> 4, li = C.lane & 15, w = C.wave;
    float kv[8];
#pragma unroll
    for (int i = 0; i < 8; ++i) kv[i] = ldbf(P + (size_t)(tok0 + 8 * w + i) * NP + EC_K + h * 64 + C.lane);
    gla_load_vt(C, P, tok0, h, lds + L_VT_);
    float bv[8], total;
    gla_decay(C, a, P, tok0, h, (LAS float*)(lds + L_TOT_), bv, total);
    { unsigned o[4];
#pragma unroll
      for (int i = 0; i < 8; ++i) { const unsigned x = f2bf(kv[i] * __expf(total - bv[i])); if (i & 1) o[i >> 1] |= x << 16; else o[i >> 1] = x; }
      *(LAS u32x4*)(lds + L_KST_ + (C.lane * GP_ + 8 * w) * 2) = (u32x4){o[0], o[1], o[2], o[3]}; }
    const int ug = (b * 4 + h) * 128 + n;
    const float dl = __expf(total);
    if (w == 0) { ((float*)(a.ws + WS_GLA_DL))[ug * 64 + C.lane] = dprod; ((LAS float*)(lds + L_DLS_))[C.lane] = dl; }
    dprod *= dl;
    __syncthreads();
    bf16_t* ST = (bf16_t*)(a.ws + WS_GLA_ST) + (size_t)ug * 8192;
    const bf16x8 v0 = *(const LAS bf16x8*)(lds + L_VT_ + ((16 * w + li) * GP_ + 8 * q) * 2), v1 = *(const LAS bf16x8*)(lds + L_VT_ + ((16 * w + li) * GP_ + 32 + 8 * q) * 2);
#pragma unroll
    for (int dt = 0; dt < 4; ++dt) { f32x4 c4 = (f32x4){0.f, 0.f, 0.f, 0.f};
        c4 = MFMA16(*(const LAS bf16x8*)(lds + L_KST_ + ((16 * dt + li) * GP_ + 8 * q) * 2), v0, c4); c4 = MFMA16(*(const LAS bf16x8*)(lds + L_KST_ + ((16 * dt + li) * GP_ + 32 + 8 * q) * 2), v1, c4);
        *(u32x2*)(ST + (16 * w + li) * 64 + 16 * dt + 4 * q) = (u32x2){pg8::cvt_pk_bf16(Srun[dt][0], Srun[dt][1]), pg8::cvt_pk_bf16(Srun[dt][2], Srun[dt][3])};
        const f32x4 dl4 = *(const LAS f32x4*)(lds + L_DLS_ + (16 * dt + 4 * q) * 4);
        Srun[dt] = Srun[dt] * dl4 + c4; }
    __syncthreads();
}
__device__ __forceinline__ void gla_a_group(LAS unsigned char* ldsb, CArgs& a, int gidx) {
    const int bh = gidx >> 4, g = gidx & 15, b = bh >> 2, h = bh & 3;
    f32x4 Srun[4]; float dprod = 1.f;
#pragma unroll
    for (int dt = 0; dt < 4; ++dt) Srun[dt] = (f32x4){0.f, 0.f, 0.f, 0.f};
#pragma unroll 1
    for (int j = 0; j < 8; ++j) { const Ctx Cu = mk_ctx(ldsb); gla_a_unit(Cu, a, (b << 9) | ((8 * g + j) << 2) | h, Srun, dprod); }
    const Ctx C = mk_ctx(ldsb); const int q = C.lane >> 4, li = C.lane & 15, w = C.wave;
    bf16_t* GL = (bf16_t*)(a.ws + WS_GLA_GL) + (size_t)gidx * 8192;
#pragma unroll
    for (int dt = 0; dt < 4; ++dt) *(u32x2*)(GL + (16 * w + li) * 64 + 16 * dt + 4 * q) = (u32x2){pg8::cvt_pk_bf16(Srun[dt][0], Srun[dt][1]), pg8::cvt_pk_bf16(Srun[dt][2], Srun[dt][3])};
    if (w == 0) ((float*)(a.ws + WS_GLA_GD))[gidx * 64 + C.lane] = dprod;
}
__device__ __forceinline__ void gla_c_unit(const Ctx& C, CArgs& a, int uid, const float (&carry)[2][8]) {
    const int h = uid & 3, n = (uid >> 2) & 127, b = uid >> 9, tok0 = b * SEQ + n * 64;
    const bf16_t* P = (const bf16_t*)(a.ws + WS_P);
    LAS unsigned char* lds = C.lds;
    constexpr int L_VT_ = 0, L_SB_ = 128 * GP_ * 2, L_QD_ = 2 * 128 * GP_ * 2, L_KD_ = L_QD_ + 64 * GP_ * 2, L_TOT_ = L_KD_ + 64 * GP_ * 2, L_PS_ = L_TOT_ + 2048;
    const int q = C.lane >> 4, li = C.lane & 15, w = C.wave;
    const int ug = (b * 4 + h) * 128 + n;
    float qv[8], kv[8];
#pragma unroll
    for (int i = 0; i < 8; ++i) { const bf16_t* pr = P + (size_t)(tok0 + 8 * w + i) * NP + h * 64 + C.lane; qv[i] = ldbf(pr + EC_Q); kv[i] = ldbf(pr + EC_K); }
    { const u32x4* ST = (const u32x4*)((const bf16_t*)(a.ws + WS_GLA_ST) + (size_t)ug * 8192); const int d8 = C.tid & 7;
      const f32x4* dcp = (const f32x4*)((const float*)(a.ws + WS_GLA_DL) + (size_t)ug * 64 + 8 * d8); const f32x4 dc0 = dcp[0], dc1 = dcp[1];
#pragma unroll
      for (int k = 0; k < 2; ++k) { const int p = C.tid + 512 * k, v = p >> 3; float f[8]; unpack8(ST[p], f);
#pragma unroll
          for (int e = 0; e < 8; ++e) f[e] += carry[k][e] * (e < 4 ? dc0[e] : dc1[e - 4]);
          *(LAS u32x4*)(lds + L_SB_ + (v * GP_ + 8 * d8) * 2) = (u32x4){pg8::cvt_pk_bf16(f[0], f[1]), pg8::cvt_pk_bf16(f[2], f[3]), pg8::cvt_pk_bf16(f[4], f[5]), pg8::cvt_pk_bf16(f[6], f[7])}; } }
    gla_load_vt(C, P, tok0, h, lds + L_VT_);
    float bv[8], total;
    gla_decay(C, a, P, tok0, h, (LAS float*)(lds + L_TOT_), bv, total);
#pragma unroll
    for (int i = 0; i < 8; ++i) { const int t = 8 * w + i;
        *((LAS bf16_t*)(lds + L_QD_) + t * GP_ + C.lane) = (bf16_t)f2bf(qv[i] * 0.125f * __expf(bv[i]));
        *((LAS bf16_t*)(lds + L_KD_) + t * GP_ + C.lane) = (bf16_t)f2bf(kv[i] * __expf(-bv[i])); }
    __syncthreads();
    const int ct = w & 3, vh = w >> 2;
    const bf16x8 qf0 = *(const LAS bf16x8*)(lds + L_QD_ + ((16 * ct + li) * GP_ + 8 * q) * 2), qf1 = *(const LAS bf16x8*)(lds + L_QD_ + ((16 * ct + li) * GP_ + 32 + 8 * q) * 2);
    f32x4 at[4];
#pragma unroll
    for (int st = 0; st < 4; ++st) { at[st] = (f32x4){0.f, 0.f, 0.f, 0.f};
        if (st <= ct) { at[st] = MFMA16(*(const LAS bf16x8*)(lds + L_KD_ + ((16 * st + li) * GP_ + 8 * q) * 2), qf0, at[st]); at[st] = MFMA16(*(const LAS bf16x8*)(lds + L_KD_ + ((16 * st + li) * GP_ + 32 + 8 * q) * 2), qf1, at[st]);
#pragma unroll
            for (int r = 0; r < 4; ++r) if (16 * st + 4 * q + r > 16 * ct + li) at[st][r] = 0.f; } }
    const bf16x8 ab0 = mkfrag(at[0], at[1]), ab1 = mkfrag(at[2], at[3]);
    f32x4 o[4]; float ss = 0.f;
#pragma unroll
    for (int vt = 0; vt < 4; ++vt) { const int vrow = 16 * (4 * vh + vt) + li; f32x4 c4 = (f32x4){0.f, 0.f, 0.f, 0.f};
        c4 = MFMA16(ldfrag2(lds, L_VT_, GP_, vrow, 4 * q, 16 + 4 * q), ab0, c4);
        if (ct >= 2) c4 = MFMA16(ldfrag2(lds, L_VT_, GP_, vrow, 32 + 4 * q, 48 + 4 * q), ab1, c4);
        c4 = MFMA16(*(const LAS bf16x8*)(lds + L_SB_ + (vrow * GP_ + 8 * q) * 2), qf0, c4); c4 = MFMA16(*(const LAS bf16x8*)(lds + L_SB_ + (vrow * GP_ + 32 + 8 * q) * 2), qf1, c4);
        o[vt] = c4; ss += (c4[0] * c4[0] + c4[1] * c4[1]) + (c4[2] * c4[2] + c4[3] * c4[3]); }
    { auto p1 = __builtin_amdgcn_permlane16_swap(__float_as_uint(ss), __float_as_uint(ss), false, false); ss = __uint_as_float(p1[0]) + __uint_as_float(p1[1]);
      auto p2 = __builtin_amdgcn_permlane32_swap(__float_as_uint(ss), __float_as_uint(ss), false, false); ss = __uint_as_float(p2[0]) + __uint_as_float(p2[1]); }
    LAS float* PS = (LAS float*)(lds + L_PS_);
    if (q == 0) PS[(16 * ct + li) * 2 + vh] = ss;
    __syncthreads();
    const float tot = PS[(16 * ct + li) * 2] + PS[(16 * ct + li) * 2 + 1];
    const float rstd = 1.0f / sqrtf(tot * (1.0f / 128.0f) + RMS_EPS);
    const size_t m = (size_t)(tok0 + 16 * ct + li);
#pragma unroll
    for (int vt = 0; vt < 4; ++vt) { const int vch = h * 128 + 16 * (4 * vh + vt) + 4 * q;
        const u32x2 gw = *(const u32x2*)(P + m * NP + EC_G + vch); const f32x4 gn = *(const f32x4*)(a.in[I_GLA_NORM] + vch);
        const f32x4 gvv = (f32x4){bf2f(gw.x & 0xffffu), __uint_as_float(gw.x & 0xffff0000u), bf2f(gw.y & 0xffffu), __uint_as_float(gw.y & 0xffff0000u)};
        f32x4 r4;
#pragma unroll
        for (int e = 0; e < 4; ++e) r4[e] = o[vt][e] * rstd * gn[e] * silu_fast(gvv[e]);
        *(u32x2*)((bf16_t*)(a.ws + WS_MIX) + m * D + vch) = (u32x2){pg8::cvt_pk_bf16(r4[0], r4[1]), pg8::cvt_pk_bf16(r4[2], r4[3])}; }
    __syncthreads();
}
__device__ __forceinline__ void gla_c_group(LAS unsigned char* ldsb, CArgs& a, int gidx) {
    const int bh = gidx >> 4, g = gidx & 15, b = bh >> 2, h = bh & 3;
    float carry[2][8], prod[8];
    { const Ctx C = mk_ctx(ldsb); const int d8 = C.tid & 7;
#pragma unroll
      for (int e = 0; e < 8; ++e) { carry[0][e] = 0.f; carry[1][e] = 0.f; prod[e] = 1.f; }
      for (int j0 = g - 1; j0 >= 0; j0 -= 4) {
          u32x4 l0[4], l1[4]; f32x4 da[4], db[4];
#pragma unroll
          for (int x = 0; x < 4; ++x) { const int j = j0 - x; if (j >= 0) { const int gj = (bh << 4) | j; const u32x4* GL = (const u32x4*)((const bf16_t*)(a.ws + WS_GLA_GL) + (size_t)gj * 8192); l0[x] = GL[C.tid]; l1[x] = GL[C.tid + 512];
                  const f32x4* gd = (const f32x4*)((const float*)(a.ws + WS_GLA_GD) + gj * 64 + 8 * d8); da[x] = gd[0]; db[x] = gd[1]; } }
#pragma unroll
          for (int x = 0; x < 4; ++x) { const int j = j0 - x; if (j >= 0) { float f0[8], f1[8]; unpack8(l0[x], f0); unpack8(l1[x], f1);
#pragma unroll
                  for (int e = 0; e < 8; ++e) { carry[0][e] += f0[e] * prod[e]; carry[1][e] += f1[e] * prod[e]; prod[e] *= (e < 4 ? da[x][e] : db[x][e - 4]); } } }
      } }
#pragma unroll 1
    for (int j = 0; j < 8; ++j) { const Ctx Cu = mk_ctx(ldsb); gla_c_unit(Cu, a, (b << 9) | ((8 * g + j) << 2) | h, carry); }
}
__device__ __forceinline__ float gelu_fast(float x) { const float u = 1.5957691216057308f * (x + 0.044715f * x * x * x); return x * fsigmoid(u); }
__device__ __forceinline__ void sgu_unit(const Ctx& C, CArgs& a, int uid) {
    const int tok0 = uid * 128;
    const bf16_t* P = (const bf16_t*)(a.ws + WS_P); bf16_t* MIX = (bf16_t*)(a.ws + WS_MIX);
    LAS unsigned char* lds = C.lds;
    constexpr int SP = 136, L_WL = 0, L_VHT = 128 * SP * 2, L_STS = 2 * 128 * SP * 2;
    LAS float* STS = (LAS float*)(lds + L_STS);
    const int q = C.lane >> 4, li = C.lane & 15, w = C.wave;
#pragma unroll 4
    for (int i = 0; i < 16; ++i) { const int t = 16 * w + i; const u32x4 wv = *(const u32x4*)(P + (size_t)(tok0 + t) * NP + EC_SV + 8 * C.lane); float f[8]; unpack8(wv, f); float s = 0.f;
#pragma unroll
        for (int j = 0; j < 8; ++j) { f[j] = gelu_fast(f[j]); s += f[j]; }
        const float mean = wave_sum_dpp(s) * (1.0f / 512.0f); float qq = 0.f;
#pragma unroll
        for (int j = 0; j < 8; ++j) { const float d = f[j] - mean; qq += d * d; }
        const float var = wave_sum_dpp(qq) * (1.0f / 512.0f);
        if (C.lane == 0) { STS[2 * t] = mean; STS[2 * t + 1] = 1.0f / sqrtf(var + LN_EPS); } }
    __syncthreads();
#pragma unroll 1
    for (int g = 0; g < 4; ++g) {
        { const unsigned char* wsrc = a.ws + WS_TAB + TAB_SGUW + (size_t)g * 32768;
#pragma unroll
          for (int k = 0; k < 4; ++k) { const int p = C.tid + 512 * k, row = p >> 4, c16 = p & 15; *(LAS u32x4*)(lds + L_WL + row * (SP * 2) + c16 * 16) = *(const u32x4*)(wsrc + p * 16); } }
#pragma unroll
        for (int k = 0; k < 4; ++k) { const int it = C.tid + 512 * k, sx = it >> 4, c8 = it & 15; const u32x4 wv = *(const u32x4*)(P + (size_t)(tok0 + sx) * NP + EC_SV + g * 128 + 8 * c8); float f[8]; unpack8(wv, f);
            const float mean = STS[2 * sx], rstd = STS[2 * sx + 1]; const float* lg = a.in[I_SGU_LN_G] + g * 128 + 8 * c8; const float* lb = a.in[I_SGU_LN_B] + g * 128 + 8 * c8;
#pragma unroll
            for (int j = 0; j < 8; ++j) *((LAS bf16_t*)(lds + L_VHT) + (8 * c8 + j) * SP + sx) = (bf16_t)f2bf((gelu_fast(f[j]) - mean) * rstd * lg[j] + lb[j]); }
        __syncthreads();
        const int ct4 = w >> 2;
#pragma unroll
        for (int tp = 0; tp < 2; ++tp) { const int tt = tp == 0 ? (w & 3) : 7 - (w & 3); const int nks = (tt + 2) >> 1;
            bf16x8 wf[4];
#pragma unroll
            for (int ks = 0; ks < 4; ++ks) if (ks < nks) wf[ks] = *(const LAS bf16x8*)(lds + L_WL + ((16 * tt + li) * SP + 32 * ks + 8 * q) * 2);
            const size_t m = (size_t)(tok0 + 16 * tt + li); const float bias = a.in[I_SGU_B][g * 128 + 16 * tt + li];
#pragma unroll
            for (int ct = 0; ct < 4; ++ct) { const int ctile = 4 * ct4 + ct; f32x4 acc = (f32x4){0.f, 0.f, 0.f, 0.f};
#pragma unroll
                for (int ks = 0; ks < 4; ++ks) if (ks < nks) acc = MFMA16(*(const LAS bf16x8*)(lds + L_VHT + ((16 * ctile + li) * SP + 32 * ks + 8 * q) * 2), wf[ks], acc);
                const int ch = g * 128 + 16 * ctile + 4 * q;
                const u32x2 uw = *(const u32x2*)(P + m * NP + EC_U + ch);
                const f32x4 uv = (f32x4){bf2f(uw.x & 0xffffu), __uint_as_float(uw.x & 0xffff0000u), bf2f(uw.y & 0xffffu), __uint_as_float(uw.y & 0xffff0000u)};
                f32x4 o;
#pragma unroll
                for (int e = 0; e < 4; ++e) o[e] = (acc[e] + bias) * gelu_fast(uv[e]);
                *(u32x2*)(MIX + m * D + 512 + ch) = (u32x2){pg8::cvt_pk_bf16(o[0], o[1]), pg8::cvt_pk_bf16(o[2], o[3])}; } }
        __syncthreads();
    }
}

__device__ __forceinline__ float lerp_tok(const bf16_t* P, size_t m, int col, float mu) {
    const float cur = ldbf(P + m * NP + col); const float prev = ((m & (SEQ - 1)) != 0) ? ldbf(P + (m - 1) * NP + col) : 0.f;
    return cur + (prev - cur) * mu;
}
__device__ __forceinline__ void conv_unit(const Ctx& C, CArgs& a, int uid) {
    const int b = uid >> 7, i64 = uid & 127, t0 = i64 * 64; const size_t mb = (size_t)b * SEQ;
    const bf16_t* P = (const bf16_t*)(a.ws + WS_P); bf16_t* MIX = (bf16_t*)(a.ws + WS_MIX);
    LAS bf16_t* Z = (LAS bf16_t*)C.lds; LAS float* YG = (LAS float*)(C.lds + 94 * 512 * 2);
#pragma unroll
    for (int bt = 0; bt < 2; ++bt) {
        u32x4 wa[6], wg[6];
#pragma unroll
        for (int k = 0; k < 6; ++k) { const int i = C.tid + 512 * (6 * bt + k); const int j = i >> 6, c8 = i & 63, t = t0 - 30 + j; wa[k] = (u32x4){0u, 0u, 0u, 0u}; wg[k] = wa[k];
            if (i < 94 * 64 && t >= 0) { const bf16_t* pr = P + (mb + t) * NP; wa[k] = *(const u32x4*)(pr + OC_CA + 8 * c8); wg[k] = *(const u32x4*)(pr + OC_CG + 8 * c8); } }
#pragma unroll
        for (int k = 0; k < 6; ++k) { const int i = C.tid + 512 * (6 * bt + k); const int j = i >> 6, c8 = i & 63;
            if (i < 94 * 64) { float fa[8], fg[8]; unpack8(wa[k], fa); unpack8(wg[k], fg); u32x4 o;
                o.x = pk2(fa[0] * fsigmoid(fg[0]), fa[1] * fsigmoid(fg[1])); o.y = pk2(fa[2] * fsigmoid(fg[2]), fa[3] * fsigmoid(fg[3]));
                o.z = pk2(fa[4] * fsigmoid(fg[4]), fa[5] * fsigmoid(fg[5])); o.w = pk2(fa[6] * fsigmoid(fg[6]), fa[7] * fsigmoid(fg[7]));
                *(LAS u32x4*)(Z + j * 512 + 8 * c8) = o; } }
    }
    __syncthreads();
    const int c = C.tid; float w[31];
    { const f32x4* wp = (const f32x4*)((const float*)(a.ws + WS_TAB + TAB_CWT) + c * 32);
#pragma unroll
      for (int j = 0; j < 8; ++j) { const f32x4 v = wp[j]; w[4 * j] = v[0]; w[4 * j + 1] = v[1]; w[4 * j + 2] = v[2]; if (j < 7) w[4 * j + 3] = v[3]; } }
    const float cb = a.in[I_CONV_B][c];
    float lg[8], lb[8];
#pragma unroll
    for (int k = 0; k < 8; ++k) { lg[k] = a.in[I_CONV_LN_G][C.lane + 64 * k]; lb[k] = a.in[I_CONV_LN_B][C.lane + 64 * k]; }
#pragma unroll 1
    for (int grp = 0; grp < 8; ++grp) {
        float zw[38];
#pragma unroll
        for (int j = 0; j < 38; ++j) zw[j] = bf2f((unsigned)Z[(8 * grp + j) * 512 + c]);
#pragma unroll
        for (int q = 0; q < 8; ++q) { float y = cb;
#pragma unroll
            for (int j = 0; j < 31; ++j) y += w[j] * zw[q + j];
            YG[q * 512 + c] = y; }
        __syncthreads();
        { float v[8]; float s = 0.f;
#pragma unroll
          for (int k = 0; k < 8; ++k) { v[k] = YG[C.wave * 512 + C.lane + 64 * k]; s += v[k]; }
          const float mean = wave_sum_dpp(s) * (1.0f / 512.0f); float q2 = 0.f;
#pragma unroll
          for (int k = 0; k < 8; ++k) { v[k] -= mean; q2 += v[k] * v[k]; }
          const float rstd = 1.0f / sqrtf(wave_sum_dpp(q2) * (1.0f / 512.0f) + LN_EPS);
          const size_t m = mb + t0 + 8 * grp + C.wave;
#pragma unroll
          for (int k = 0; k < 8; ++k) MIX[m * D + 512 + C.lane + 64 * k] = (bf16_t)f2bf(silu_fast(v[k] * rstd * lg[k] + lb[k])); }
        __syncthreads();
    }
}
constexpr int RMAT = 64 * RP * 2;
constexpr int L_PT = 0, L_RT = RMAT, L_BH = 2 * RMAT, L_KH = 3 * RMAT, L_BT = 4 * RMAT, L_KT = 5 * RMAT, L_VT = 6 * RMAT, L_NAPB = 7 * RMAT, L_NAPK = 8 * RMAT,
              L_ARB = 9 * RMAT, L_ARK = 10 * RMAT, L_WMT = 11 * RMAT, L_U0T = 12 * RMAT, L_BV = 13 * RMAT, L_AII = 14 * RMAT, L_TII = L_AII + 4096, L_REND = L_TII + 2560;
constexpr int L_TOT = L_AII;
constexpr int L_XWB = L_RT, L_XAB = L_RT + 5120, L_XWO = L_KH, L_XAO = L_NAPB;
constexpr int L_RAW = L_ARK, L_XRAW = L_PT;
static_assert(L_RAW + 65 * 192 * 2 <= L_BV && 65 * 64 * 2 <= RMAT, "raw tiles");
static_assert(L_REND <= LDS_BYTES - 64, "rwkv LDS map");
struct PrepK { float w0; f32x4 mx0, mx1; f32x4 m0v, m1v, k0v, k1v, v0v, v1v, a0a, a0b, ks0, ks1, ka0, ka1, rk0, rk1; bf16x8 lrf[4]; int colb, ldsb, rstride; };
__device__ __forceinline__ void prep_load_consts(const Ctx& C, CArgs& a, int h, PrepK& K) {
    const float* mu = a.in[I_RWKV_MU]; const int q = C.lane >> 4, li = C.lane & 15, w = C.wave;
    K.w0 = a.in[I_RWKV_W0][h * 64 + C.lane];
    const int g8 = C.tid & 7; K.mx0 = *(const f32x4*)(mu + 1536 + 8 * g8); K.mx1 = *(const f32x4*)(mu + 1536 + 8 * g8 + 4);
    const int chB = h * 64 + 8 * (C.tid & 7);
    K.m0v = *(const f32x4*)(mu + chB); K.m1v = *(const f32x4*)(mu + chB + 4); K.k0v = *(const f32x4*)(mu + 512 + chB); K.k1v = *(const f32x4*)(mu + 512 + chB + 4); K.v0v = *(const f32x4*)(mu + 1024 + chB); K.v1v = *(const f32x4*)(mu + 1024 + chB + 4);
    K.a0a = *(const f32x4*)(a.in[I_RWKV_A0] + chB); K.a0b = *(const f32x4*)(a.in[I_RWKV_A0] + chB + 4);
    K.ks0 = *(const f32x4*)(a.in[I_RWKV_K_K] + chB); K.ks1 = *(const f32x4*)(a.in[I_RWKV_K_K] + chB + 4); K.ka0 = *(const f32x4*)(a.in[I_RWKV_K_A] + chB); K.ka1 = *(const f32x4*)(a.in[I_RWKV_K_A] + chB + 4);
    K.rk0 = *(const f32x4*)(a.in[I_RWKV_R_K] + chB); K.rk1 = *(const f32x4*)(a.in[I_RWKV_R_K] + chB + 4);
    { const bf16_t* tb = (const bf16_t*)(a.ws + WS_TAB + ((w >> 2) == 0 ? TAB_W2TB : TAB_A2TB)) + (size_t)(h * 64 + li) * 32 + 8 * q;
#pragma unroll
      for (int nt = 0; nt < 4; ++nt) K.lrf[nt] = *(const bf16x8*)(tb + nt * 16 * 32); }
    const int p = C.tid & 31;
    K.colb = p < 24 ? (p >> 3) * 512 + h * 64 + 8 * (p & 7) : OC_XW + 8 * (p - 24);
    K.ldsb = p < 24 ? L_RAW + ((p >> 3) * 64 + 8 * (p & 7)) * 2 : L_XRAW + 8 * (p - 24) * 2;
    K.rstride = p < 24 ? 384 : 128;
}
__device__ __forceinline__ void prep_load_raw(const Ctx& C, CArgs& a, int uid, const PrepK& K, u32x4 (&pf)[5]) {
    const int n = (uid >> 3) & 127, b = uid >> 10; const size_t m0 = (size_t)b * SEQ + n * 64;
    const bf16_t* base = (const bf16_t*)(a.ws + WS_P) + (m0 + (C.tid >> 5)) * NP + K.colb;
#pragma unroll
    for (int k = 0; k < 4; ++k) pf[k] = *(const u32x4*)(base + (size_t)(16 * k) * NP);
    pf[4] = (u32x4){0u, 0u, 0u, 0u};
    if (C.tid < 32 && n != 0) pf[4] = *(const u32x4*)((const bf16_t*)(a.ws + WS_P) + (m0 - 1) * NP + K.colb);
}
__device__ __forceinline__ void rwkv_prep_unit(const Ctx& C, CArgs& a, int uid, int next_uid, const PrepK& K, u32x4 (&pf)[5]) {
    const int h = uid & 7, n = (uid >> 3) & 127, b = uid >> 10; const size_t m0 = (size_t)b * SEQ + n * 64;
    LAS unsigned char* lds = C.lds;
    LAS float* AII = (LAS float*)(lds + L_AII);
    const int q = C.lane >> 4, li = C.lane & 15, w = C.wave;
    const float w0 = K.w0;
    const f32x4 m0v = K.m0v, m1v = K.m1v, k0v = K.k0v, k1v = K.k1v, v0v = K.v0v, v1v = K.v1v, a0a = K.a0a, a0b = K.a0b, ks0 = K.ks0, ks1 = K.ks1, ka0 = K.ka0, ka1 = K.ka1, rk0 = K.rk0, rk1 = K.rk1;
    LAS bf16_t* RAW = (LAS bf16_t*)(lds + L_RAW);
    LAS float* TOT = (LAS float*)(lds + L_TOT);
    { LAS unsigned char* dst = lds + K.ldsb + (1 + (C.tid >> 5)) * K.rstride;
#pragma unroll
      for (int k = 0; k < 4; ++k) *(LAS u32x4*)(dst + 16 * k * K.rstride) = pf[k];
      if (C.tid < 32) *(LAS u32x4*)(lds + K.ldsb) = pf[4]; }
    if (next_uid >= 0) prep_load_raw(C, a, next_uid, K, pf);
    __syncthreads();
    { const int t = C.tid >> 3, g8 = C.tid & 7; float cur[8], prv[8];
      unpack8(*(const LAS u32x4*)(lds + L_XRAW + ((t + 1) * 64 + 8 * g8) * 2), cur); unpack8(*(const LAS u32x4*)(lds + L_XRAW + (t * 64 + 8 * g8) * 2), prv);
      float o[8];
#pragma unroll
      for (int e = 0; e < 8; ++e) { const float v = cur[e] + (prv[e] - cur[e]) * (e < 4 ? K.mx0[e] : K.mx1[e - 4]); o[e] = g8 < 4 ? ftanh(v) : v; }
      *(LAS u32x4*)(lds + (g8 < 4 ? L_XWB : L_XAB) + (t * 40 + 8 * (g8 & 3)) * 2) = (u32x4){pg8::cvt_pk_bf16(o[0], o[1]), pg8::cvt_pk_bf16(o[2], o[3]), pg8::cvt_pk_bf16(o[4], o[5]), pg8::cvt_pk_bf16(o[6], o[7])}; }
    __syncthreads();
    { const int mat = w >> 2, mt = w & 3;
      const bf16x8 af = *(const LAS bf16x8*)(lds + (mat == 0 ? L_XWB : L_XAB) + ((16 * mt + li) * 40 + 8 * q) * 2);
      LAS float* xo = (LAS float*)(lds + (mat == 0 ? L_XWO : L_XAO));
#pragma unroll
      for (int nt = 0; nt < 4; ++nt) { f32x4 c4 = (f32x4){0.f, 0.f, 0.f, 0.f}; c4 = MFMA16(af, K.lrf[nt], c4);
#pragma unroll
          for (int r = 0; r < 4; ++r) xo[(16 * mt + 4 * q + r) * 64 + 16 * nt + li] = c4[r]; } }
    __syncthreads();
    {
        float gl[8];
        { const LAS float* xwo = (const LAS float*)(lds + L_XWO) + C.lane;
          float pre = 0.f;
#pragma unroll
          for (int i = 0; i < 8; ++i) { pre += -0.6065306597126334f * fsigmoid(w0 + xwo[(8 * w + i) * 64]); gl[i] = pre; }
          TOT[w * 64 + C.lane] = pre; }
        __syncthreads();
        float off = 0.f, gC = 0.f;
#pragma unroll
        for (int ww = 0; ww < 8; ++ww) { const float tv = TOT[ww * 64 + C.lane]; gC += tv; if (ww < w) off += tv; }
        if (w == 0) { ((float*)((unsigned char*)a.out + OUT_R_GC))[(size_t)uid * 64 + C.lane] = __expf(gC); TOT[512 + C.lane] = gC; }
        LAS float* G = (LAS float*)(lds + L_XWO) + C.lane;
#pragma unroll
        for (int i = 0; i < 8; ++i) G[(8 * w + i) * 64] = off + gl[i];
    }
    __syncthreads();
    {
        const int t = C.tid >> 3, c8 = C.tid & 7;
        float rr[8], kk8[8], vv[8], av[8], g[8], gp[8], gc8[8];
        { float cur[8], prv[8];
          unpack8(*(const LAS u32x4*)(RAW + (t + 1) * 192 + 8 * c8), cur); unpack8(*(const LAS u32x4*)(RAW + t * 192 + 8 * c8), prv);
#pragma unroll
          for (int e = 0; e < 8; ++e) rr[e] = cur[e] + (prv[e] - cur[e]) * (e < 4 ? m0v[e] : m1v[e - 4]);
          unpack8(*(const LAS u32x4*)(RAW + (t + 1) * 192 + 64 + 8 * c8), cur); unpack8(*(const LAS u32x4*)(RAW + t * 192 + 64 + 8 * c8), prv);
#pragma unroll
          for (int e = 0; e < 8; ++e) kk8[e] = cur[e] + (prv[e] - cur[e]) * (e < 4 ? k0v[e] : k1v[e - 4]);
          unpack8(*(const LAS u32x4*)(RAW + (t + 1) * 192 + 128 + 8 * c8), cur); unpack8(*(const LAS u32x4*)(RAW + t * 192 + 128 + 8 * c8), prv);
#pragma unroll
          for (int e = 0; e < 8; ++e) vv[e] = cur[e] + (prv[e] - cur[e]) * (e < 4 ? v0v[e] : v1v[e - 4]); }
        { const LAS f32x4* xa = (const LAS f32x4*)((const LAS float*)(lds + L_XAO) + t * 64 + 8 * c8); const f32x4 x0 = xa[0], x1 = xa[1];
#pragma unroll
          for (int e = 0; e < 4; ++e) { av[e] = fsigmoid(a0a[e] + x0[e]); av[4 + e] = fsigmoid(a0b[e] + x1[e]); }
          const LAS f32x4* gq = (const LAS f32x4*)((const LAS float*)(lds + L_XWO) + t * 64 + 8 * c8); const f32x4 g0 = gq[0], g1 = gq[1];
          f32x4 p0 = (f32x4){0.f, 0.f, 0.f, 0.f}, p1 = p0; if (t > 0) { p0 = gq[-16]; p1 = gq[-15]; }
          const LAS f32x4* gcq = (const LAS f32x4*)(TOT + 512 + 8 * c8); const f32x4 c0 = gcq[0], c1 = gcq[1];
#pragma unroll
          for (int e = 0; e < 4; ++e) { g[e] = g0[e]; g[4 + e] = g1[e]; gp[e] = p0[e]; gp[4 + e] = p1[e]; gc8[e] = c0[e]; gc8[4 + e] = c1[e]; } }
        __syncthreads();
        float kkv[8], kp[8]; float n2 = 0.f, bon = 0.f;
#pragma unroll
        for (int e = 0; e < 8; ++e) { const float kks_ = e < 4 ? ks0[e] : ks1[e - 4], ka_ = e < 4 ? ka0[e] : ka1[e - 4], rk_ = e < 4 ? rk0[e] : rk1[e - 4];
            kkv[e] = kk8[e] * kks_; n2 += kkv[e] * kkv[e]; kp[e] = kk8[e] * (1.0f + (av[e] - 1.0f) * ka_); bon += rr[e] * kp[e] * rk_; }
        DPP_ADD(n2, 0xB1); DPP_ADD(n2, 0x4E); DPP_ADD(n2, 0x141); DPP_ADD(bon, 0xB1); DPP_ADD(bon, 0x4E); DPP_ADD(bon, 0x141);
        const float rn = __builtin_amdgcn_rsqf(fmaxf(n2, 1e-24f));
        float o_pt[8], o_rt[8], o_bh[8], o_kh[8], o_bv[8];
        LAS bf16_t* BTp = (LAS bf16_t*)(lds + L_BT) + (8 * c8) * RP + t; LAS bf16_t* KTp = (LAS bf16_t*)(lds + L_KT) + (8 * c8) * RP + t; LAS bf16_t* VTp = (LAS bf16_t*)(lds + L_VT) + (8 * c8) * RP + t;
        float t_bt[8], t_kt[8];
#pragma unroll
        for (int e = 0; e < 8; ++e) { const float kn = kkv[e] * rn, bbv = kn * av[e]; const float eg = __expf(g[e]), eng = __builtin_amdgcn_rcpf(eg), egp = __expf(gp[e]), egc = __expf(gc8[e] - g[e]);
            o_pt[e] = kn * egp; o_rt[e] = rr[e] * eg; o_bh[e] = bbv * eng; o_kh[e] = kp[e] * eng; o_bv[e] = bon * vv[e]; t_bt[e] = bbv * egc; t_kt[e] = kp[e] * egc; }
#pragma unroll
        for (int e = 0; e < 8; e += 2) { const unsigned pb = pg8::cvt_pk_bf16(t_bt[e], t_bt[e + 1]), pk = pg8::cvt_pk_bf16(t_kt[e], t_kt[e + 1]), pv = pg8::cvt_pk_bf16(vv[e], vv[e + 1]);
            BTp[e * RP] = (bf16_t)(pb & 0xffffu); BTp[(e + 1) * RP] = (bf16_t)(pb >> 16); KTp[e * RP] = (bf16_t)(pk & 0xffffu); KTp[(e + 1) * RP] = (bf16_t)(pk >> 16); VTp[e * RP] = (bf16_t)(pv & 0xffffu); VTp[(e + 1) * RP] = (bf16_t)(pv >> 16); }
        const int ro = (t * RP + 8 * c8) * 2;
#define PK8(o) (u32x4){pg8::cvt_pk_bf16(o[0], o[1]), pg8::cvt_pk_bf16(o[2], o[3]), pg8::cvt_pk_bf16(o[4], o[5]), pg8::cvt_pk_bf16(o[6], o[7])}
        *(LAS u32x4*)(lds + L_PT + ro) = PK8(o_pt); *(LAS u32x4*)(lds + L_RT + ro) = PK8(o_rt); *(LAS u32x4*)(lds + L_BH + ro) = PK8(o_bh); *(LAS u32x4*)(lds + L_KH + ro) = PK8(o_kh); *(LAS u32x4*)(lds + L_BV + ro) = PK8(o_bv);
#undef PK8
    }
    __syncthreads();
    {
        const int mat = w >> 1, half = w & 1;
        const int xb = mat < 2 ? L_PT : L_RT, yb = (mat & 1) ? L_KH : L_BH;
        const int ob = mat == 0 ? L_NAPB : (mat == 1 ? L_NAPK : (mat == 2 ? L_ARB : L_ARK));
        const bool strict = mat < 2;
        auto row_tiles = [&](auto MTc) { constexpr int mt = decltype(MTc)::value;
            const bf16x8 a0f = ldfrag(lds, xb, 16 * mt + li, 8 * q), a1f = ldfrag(lds, xb, 16 * mt + li, 32 + 8 * q);
            LAS unsigned char* orow = lds + ob + ((16 * mt + li) * RP + 4 * q) * 2;
#pragma unroll
            for (int nt = 0; nt < 4; ++nt) {
                if (nt > mt) { *(LAS u32x2*)(orow + 32 * nt) = (u32x2){0u, 0u}; continue; }
                f32x4 v4 = (f32x4){0.f, 0.f, 0.f, 0.f};
                v4 = MFMA16(ldfrag(lds, yb, 16 * nt + li, 8 * q), a0f, v4); v4 = MFMA16(ldfrag(lds, yb, 16 * nt + li, 32 + 8 * q), a1f, v4);
                if (nt == mt) {
#pragma unroll
                    for (int r = 0; r < 4; ++r) { const bool keep = strict ? (4 * q + r < li) : (4 * q + r <= li); v4[r] = keep ? v4[r] : 0.f; }
                    if (mat == 0) *(LAS f32x4*)(AII + (mt * 16 + li) * 16 + 4 * q) = v4; }
                *(LAS u32x2*)(orow + 32 * nt) = strict ? (u32x2){pg8::cvt_pk_bf16(-v4[0], -v4[1]), pg8::cvt_pk_bf16(-v4[2], -v4[3])} : (u32x2){pg8::cvt_pk_bf16(v4[0], v4[1]), pg8::cvt_pk_bf16(v4[2], v4[3])}; } };
        if (half == 0) { row_tiles(std::integral_constant<int, 0>{}); row_tiles(std::integral_constant<int, 3>{}); }
        else           { row_tiles(std::integral_constant<int, 1>{}); row_tiles(std::integral_constant<int, 2>{}); }
    }
    __syncthreads();
    f32x4 acc[4];
    if (w < 4) {
#pragma unroll
        for (int mt = 0; mt < 4; ++mt)
#pragma unroll
            for (int r = 0; r < 4; ++r) acc[mt][r] = bf2f((unsigned)*((const LAS bf16_t*)(lds + L_PT) + (16 * mt + 4 * q + r) * RP + 16 * w + li));
    } else {
        const int vs = w - 4;
        const bf16x8 b0 = ldfrag(lds, L_VT, 16 * vs + li, 8 * q), b1 = ldfrag(lds, L_VT, 16 * vs + li, 32 + 8 * q);
#pragma unroll
        for (int mt = 0; mt < 4; ++mt) { acc[mt] = (f32x4){0.f, 0.f, 0.f, 0.f};
            acc[mt] = MFMA16(ldfrag(lds, L_NAPK, 16 * mt + li, 8 * q), b0, acc[mt]); acc[mt] = MFMA16(ldfrag(lds, L_NAPK, 16 * mt + li, 32 + 8 * q), b1, acc[mt]); }
    }
    if (w == 0) {
        const int blk = q, c = li; float T[16];
#pragma unroll
        for (int r = 0; r < 16; ++r) { float tv = (r == c) ? 1.f : 0.f; const LAS f32x4* rowp = (const LAS f32x4*)(AII + (blk * 16 + r) * 16);
#pragma unroll
            for (int s4 = 0; s4 < 4; ++s4) { if (4 * s4 < r) { const f32x4 av = rowp[s4];
#pragma unroll
                for (int e = 0; e < 4; ++e) if (4 * s4 + e < r) tv -= av[e] * T[4 * s4 + e]; } }
            T[r] = tv; *((LAS bf16_t*)(lds + L_TII) + (blk * 16 + r) * 20 + c) = (bf16_t)f2bf(tv); }
    }
    __syncthreads();
    {
        const f32x4 z4 = (f32x4){0.f, 0.f, 0.f, 0.f};
        f32x4 X0, X1, X2, X3;
        X0 = MFMA16(ldfrag_lo(lds, L_TII, 20, li, 4 * q), mkfrag_lo(acc[0]), z4);
        acc[1] = MFMA16(ldfrag2(lds, L_NAPB, RP, 16 + li, 4 * q, 16 + 4 * q), mkfrag_lo(X0), acc[1]);
        X1 = MFMA16(ldfrag_lo(lds, L_TII, 20, 16 + li, 4 * q), mkfrag_lo(acc[1]), z4);
        const bf16x8 x01 = mkfrag(X0, X1);
        acc[2] = MFMA16(ldfrag2(lds, L_NAPB, RP, 32 + li, 4 * q, 16 + 4 * q), x01, acc[2]);
        X2 = MFMA16(ldfrag_lo(lds, L_TII, 20, 32 + li, 4 * q), mkfrag_lo(acc[2]), z4);
        acc[3] = MFMA16(ldfrag2(lds, L_NAPB, RP, 48 + li, 4 * q, 16 + 4 * q), x01, acc[3]);
        acc[3] = MFMA16(ldfrag2(lds, L_NAPB, RP, 48 + li, 32 + 4 * q, 48 + 4 * q), mkfrag_lo(X2), acc[3]);
        X3 = MFMA16(ldfrag_lo(lds, L_TII, 20, 48 + li, 4 * q), mkfrag_lo(acc[3]), z4);
        const int ob = (w < 4 ? L_WMT : L_U0T) + ((16 * (w & 3) + li) * RP + 4 * q) * 2;
        *(LAS u32x2*)(lds + ob) = (u32x2){pg8::cvt_pk_bf16(X0[0], X0[1]), pg8::cvt_pk_bf16(X0[2], X0[3])};
        *(LAS u32x2*)(lds + ob + 32) = (u32x2){pg8::cvt_pk_bf16(X1[0], X1[1]), pg8::cvt_pk_bf16(X1[2], X1[3])};
        *(LAS u32x2*)(lds + ob + 64) = (u32x2){pg8::cvt_pk_bf16(X2[0], X2[1]), pg8::cvt_pk_bf16(X2[2], X2[3])};
        *(LAS u32x2*)(lds + ob + 96) = (u32x2){pg8::cvt_pk_bf16(X3[0], X3[1]), pg8::cvt_pk_bf16(X3[2], X3[3])};
    }
    __syncthreads();
    {
        const int outp = w >> 1, half = w & 1;
#pragma unroll
        for (int mm = 0; mm < 2; ++mm) { const int mt = 2 * half + mm;
            if (outp == 0 || outp == 2) {
                const int rb = outp == 0 ? L_BT : L_ARB;
                const bf16x8 b0 = ldfrag(lds, rb, 16 * mt + li, 8 * q), b1 = ldfrag(lds, rb, 16 * mt + li, 32 + 8 * q);
                bf16_t* dst = (bf16_t*)(a.ws + (outp == 0 ? WS_R_GP : WS_R_RP)) + (size_t)uid * 4096 + (16 * mt + li) * 64;
#pragma unroll
                for (int g = 0; g < 2; ++g) { f32x4 d[2];
#pragma unroll
                    for (int e = 0; e < 2; ++e) { const int nt = 2 * g + e; f32x4 c4 = (f32x4){0.f, 0.f, 0.f, 0.f};
                        c4 = MFMA16(ldfrag(lds, L_WMT, 16 * nt + li, 8 * q), b0, c4); c4 = MFMA16(ldfrag(lds, L_WMT, 16 * nt + li, 32 + 8 * q), b1, c4);
                        if (outp == 2) { const u32x2 rw = *(const LAS u32x2*)(lds + L_RT + ((16 * mt + li) * RP + 16 * nt + 4 * q) * 2);
                            d[e] = (f32x4){bf2f(rw.x & 0xffffu) - c4[0], __uint_as_float(rw.x & 0xffff0000u) - c4[1], bf2f(rw.y & 0xffffu) - c4[2], __uint_as_float(rw.y & 0xffff0000u) - c4[3]}; }
                        else d[e] = -c4; }
                    const u32x4 wv = (u32x4){pg8::cvt_pk_bf16(d[0][0], d[0][1]), pg8::cvt_pk_bf16(d[0][2], d[0][3]), pg8::cvt_pk_bf16(d[1][0], d[1][1]), pg8::cvt_pk_bf16(d[1][2], d[1][3])};
                    *(u32x4*)(dst + 32 * g + 8 * q) = wv; }
            } else {
                const int ab0 = outp == 1 ? L_BT : L_ARB, ab1 = outp == 1 ? L_KT : L_ARK;
                const bf16x8 a00 = ldfrag(lds, ab0, 16 * mt + li, 8 * q), a01 = ldfrag(lds, ab0, 16 * mt + li, 32 + 8 * q), a10 = ldfrag(lds, ab1, 16 * mt + li, 8 * q), a11 = ldfrag(lds, ab1, 16 * mt + li, 32 + 8 * q);
                u32x2* dst = (u32x2*)(a.ws + (outp == 1 ? WS_R_HADD : WS_R_Y0)) + (size_t)uid * 1024;
#pragma unroll
                for (int nt = 0; nt < 4; ++nt) { f32x4 c4 = (f32x4){0.f, 0.f, 0.f, 0.f};
                    if (outp == 1) { c4 = MFMA16(a00, ldfrag(lds, L_U0T, 16 * nt + li, 8 * q), c4); c4 = MFMA16(a01, ldfrag(lds, L_U0T, 16 * nt + li, 32 + 8 * q), c4);
                                     c4 = MFMA16(a10, ldfrag(lds, L_VT, 16 * nt + li, 8 * q), c4); c4 = MFMA16(a11, ldfrag(lds, L_VT, 16 * nt + li, 32 + 8 * q), c4); }
                    else {
                                     c4 = MFMA16(ldfrag(lds, L_U0T, 16 * nt + li, 8 * q), a00, c4); c4 = MFMA16(ldfrag(lds, L_U0T, 16 * nt + li, 32 + 8 * q), a01, c4);
                                     c4 = MFMA16(ldfrag(lds, L_VT, 16 * nt + li, 8 * q), a10, c4); c4 = MFMA16(ldfrag(lds, L_VT, 16 * nt + li, 32 + 8 * q), a11, c4); }
                    dst[(nt * 4 + mt) * 64 + C.lane] = (u32x2){pg8::cvt_pk_bf16(c4[0], c4[1]), pg8::cvt_pk_bf16(c4[2], c4[3])}; }
            } }
        { const int nt = w >> 1; u32x2* bvf = (u32x2*)((unsigned char*)a.out + OUT_R_BVF) + (size_t)uid * 1024;
#pragma unroll
          for (int mm = 0; mm < 2; ++mm) { const int mt = 2 * (w & 1) + mm; bvf[(nt * 4 + mt) * 64 + C.lane] = *(const LAS u32x2*)(lds + L_BV + ((16 * mt + li) * RP + 16 * nt + 4 * q) * 2); } }
    }
    __syncthreads();
}
#ifndef R2_SPLIT
#define R2_SPLIT 2
#endif
constexpr int R2_NSB = 32 * R2_SPLIT, R2_NCW = 4 / R2_SPLIT, R2_NH = 2 * R2_NCW, R2_NJ = 18 + 2 * R2_NH + 1, R2_KMAX = (R2_NJ + 3) / 4;
constexpr int R2_OG = 0, R2_OR = 9216, R2_OH = 18432, R2_OY = R2_OH + R2_NH * 1024, R2_OC = R2_OY + R2_NH * 1024, R2_SLOT = R2_OC + 256;
constexpr int R2_NSLOT = (LDS_BYTES - 64) / R2_SLOT < 8 ? (LDS_BYTES - 64) / R2_SLOT : 8;
static_assert(R2_NSLOT >= 3 && (R2_NSLOT - 2) * R2_KMAX <= 63, "R2 ring");
__device__ __forceinline__ void rwkv_scan(const Ctx& C, CArgs& a) {
    if (C.bid >= R2_NSB) return;
    const int bh = C.bid / R2_SPLIT, part = C.bid % R2_SPLIT, b = bh >> 3, h = bh & 7, q = C.lane >> 4, li = C.lane & 15, w = C.wave;
    LAS unsigned char* lds = C.lds;
    unsigned char* ws = a.ws;
    if (w >= 4) {
        const int lw = w - 4;
        const unsigned char* src[R2_KMAX]; unsigned ustr[R2_KMAX]; unsigned ldo[R2_KMAX]; bool act[R2_KMAX];
#pragma unroll
        for (int k = 0; k < R2_KMAX; ++k) { int j = lw + 4 * k; if (j >= R2_NJ) j = 18;
            if (j >= 18 && j < 18 + 2 * R2_NH) j = (j < 18 + R2_NH) ? 18 + R2_NH * part + (j - 18) : 26 + R2_NH * part + (j - 18 - R2_NH); else if (j >= 18) j = 34;
            if (j < 18) { const int isR = j >= 9, jj = j - 9 * isR, p = 64 * jj + C.lane, row = p / 9; int c16 = p % 9; if (c16 > 7) c16 = 7;
                src[k] = ws + (isR ? WS_R_RP : WS_R_GP) + row * 128 + c16 * 16; ustr[k] = 8192u; ldo[k] = (unsigned)((isR ? R2_OR : R2_OG) + jj * 1024); act[k] = true; }
            else if (j < 34) { const int isY = j >= 26, jj = j - 18 - 8 * isY;
                src[k] = ws + (isY ? WS_R_Y0 : WS_R_HADD) + jj * 1024 + C.lane * 16; ustr[k] = 8192u; ldo[k] = (unsigned)((isY ? R2_OY : R2_OH) + (jj - R2_NH * part) * 1024); act[k] = true; }
            else { src[k] = (const unsigned char*)a.out + OUT_R_GC + (C.lane & 15) * 16; ustr[k] = 256u; ldo[k] = (unsigned)R2_OC; act[k] = C.lane < 16; } }
#define R2_ISSUE(n_, slot_) do { const size_t uid_ = ((size_t)b << 10) | ((size_t)(n_) << 3) | (size_t)h; \
        _Pragma("unroll") for (int k = 0; k < R2_KMAX; ++k) { if (act[k]) __builtin_amdgcn_global_load_lds((const unsigned*)(src[k] + uid_ * ustr[k]), (LAS unsigned*)(lds + (slot_) * R2_SLOT + ldo[k]), 16, 0, 0); } } while (0)
#pragma unroll
        for (int i = 0; i < R2_NSLOT - 1; ++i) R2_ISSUE(i, i);
        int slot = R2_NSLOT - 1;
#pragma unroll 1
        for (int n = 0; n < 128; ++n) {
            asm volatile("s_waitcnt vmcnt(%0)" :: "n"((R2_NSLOT - 2) * R2_KMAX) : "memory");
            __builtin_amdgcn_s_barrier();
            const int nn = n + R2_NSLOT - 1 < 128 ? n + R2_NSLOT - 1 : 127;
            R2_ISSUE(nn, slot);
            slot = slot + 1 == R2_NSLOT ? 0 : slot + 1;
        }
        asm volatile("s_waitcnt vmcnt(0)" ::: "memory");
#undef R2_ISSUE
        return;
    }
    if (w >= R2_NCW) {
#pragma unroll 1
        for (int n = 0; n < 128; ++n) __builtin_amdgcn_s_barrier();
        return;
    }
    const int s = part * R2_NCW + w;
    u32x2* YF = (u32x2*)((unsigned char*)a.out + OUT_R_Y);
    f32x4 H[4];
#pragma unroll
    for (int mt = 0; mt < 4; ++mt) H[mt] = (f32x4){0.f, 0.f, 0.f, 0.f};
    int cslot = 0;
#pragma unroll 1
    for (int n = 0; n < 128; ++n) {
        __builtin_amdgcn_s_barrier();
        asm volatile("" ::: "memory");
        LAS unsigned char* sl = lds + cslot * R2_SLOT; cslot = cslot + 1 == R2_NSLOT ? 0 : cslot + 1;
        const bf16x8 hb0 = mkfrag(H[0], H[1]), hb1 = mkfrag(H[2], H[3]);
        const size_t uid = ((size_t)b << 10) | ((size_t)n << 3) | (size_t)h;
#pragma unroll
        for (int mt = 0; mt < 4; ++mt) {
            const bf16x8 g0 = *(const LAS bf16x8*)(sl + R2_OG + (16 * mt + li) * 144 + 16 * q), g1 = *(const LAS bf16x8*)(sl + R2_OG + (16 * mt + li) * 144 + 64 + 16 * q);
            const bf16x8 r0 = *(const LAS bf16x8*)(sl + R2_OR + (16 * mt + li) * 144 + 16 * q), r1 = *(const LAS bf16x8*)(sl + R2_OR + (16 * mt + li) * 144 + 64 + 16 * q);
            const u32x2 ha = *(const LAS u32x2*)(sl + R2_OH + ((w * 4 + mt) * 64 + C.lane) * 8), y0 = *(const LAS u32x2*)(sl + R2_OY + ((w * 4 + mt) * 64 + C.lane) * 8);
            const f32x4 gc = *(const LAS f32x4*)(sl + R2_OC + (16 * mt + 4 * q) * 4);
            f32x4 hn = gc * H[mt] + (f32x4){bf2f(ha.x & 0xffffu), __uint_as_float(ha.x & 0xffff0000u), bf2f(ha.y & 0xffffu), __uint_as_float(ha.y & 0xffff0000u)};
            hn = MFMA16(g0, hb0, hn); hn = MFMA16(g1, hb1, hn);
            f32x4 yv = (f32x4){bf2f(y0.x & 0xffffu), __uint_as_float(y0.x & 0xffff0000u), bf2f(y0.y & 0xffffu), __uint_as_float(y0.y & 0xffff0000u)};
            yv = MFMA16(hb0, r0, yv); yv = MFMA16(hb1, r1, yv);
            YF[uid * 1024 + (s * 4 + mt) * 64 + C.lane] = (u32x2){pg8::cvt_pk_bf16(yv[0], yv[1]), pg8::cvt_pk_bf16(yv[2], yv[3])};
            H[mt] = hn; }
        asm volatile("s_waitcnt lgkmcnt(0)" ::: "memory");
    }
}
__device__ __forceinline__ void rwkv_post_phase(const Ctx& C, CArgs& a) {
    LAS unsigned char* lds = C.lds; const int h = C.wave, q = C.lane >> 4, li = C.lane & 15;
    const bf16_t* P = (const bf16_t*)(a.ws + WS_P); const float* mu = a.in[I_RWKV_MU];
    LAS bf16_t* XR = (LAS bf16_t*)lds;
    LAS bf16_t* XGB = (LAS bf16_t*)(lds + 65 * 96 * 2);
    bf16x8 gf[4][3];
#pragma unroll
    for (int nt = 0; nt < 4; ++nt)
#pragma unroll
        for (int ks = 0; ks < 3; ++ks) gf[nt][ks] = *(const bf16x8*)((const bf16_t*)(a.ws + WS_TAB + TAB_G2TB) + (size_t)(h * 64 + 16 * nt + li) * 96 + 32 * ks + 8 * q);
    f32x4 gg[4], gb[4];
#pragma unroll
    for (int nt = 0; nt < 4; ++nt) { gg[nt] = *(const f32x4*)(a.in[I_RWKV_GN_G] + h * 64 + 16 * nt + 4 * q); gb[nt] = *(const f32x4*)(a.in[I_RWKV_GN_B] + h * 64 + 16 * nt + 4 * q); }
    const u32x2* YF = (const u32x2*)((const unsigned char*)a.out + OUT_R_Y); const u32x2* BVF = (const u32x2*)((const unsigned char*)a.out + OUT_R_BVF); bf16_t* MIX = (bf16_t*)(a.ws + WS_MIX);
#pragma unroll 1
    for (int u = C.bid; u < 512; u += C.nblk) {
        const size_t m0 = (size_t)u * 64; const bool seq0 = (m0 & (SEQ - 1)) == 0;
        const size_t uid = ((size_t)(u >> 7) << 10) | ((size_t)(u & 127) << 3) | (size_t)h;
        for (int i = C.tid; i < 65 * 12; i += NTHREADS) { const int j = i / 12, c8 = i % 12; u32x4 v = (u32x4){0u, 0u, 0u, 0u}; if (j > 0 || !seq0) v = *(const u32x4*)(P + (m0 - 1 + j) * NP + OC_XG + 8 * c8); *(LAS u32x4*)(XR + j * 96 + 8 * c8) = v; }
        u32x2 yf[4][4], bf[4][4];
#pragma unroll
        for (int mt = 0; mt < 4; ++mt)
#pragma unroll
            for (int nt = 0; nt < 4; ++nt) { yf[mt][nt] = YF[uid * 1024 + (nt * 4 + mt) * 64 + C.lane]; bf[mt][nt] = BVF[uid * 1024 + (nt * 4 + mt) * 64 + C.lane]; }
        __syncthreads();
        for (int i = C.tid; i < 64 * 96; i += NTHREADS) { const int t = i / 96, j = i % 96; const float cur = bf2f((unsigned)XR[(t + 1) * 96 + j]), prev = bf2f((unsigned)XR[t * 96 + j]);
            XGB[t * 104 + j] = (bf16_t)f2bf(fsigmoid(cur + (prev - cur) * mu[1600 + j])); }
        __syncthreads();
#pragma unroll
        for (int mt = 0; mt < 4; ++mt) {
            bf16x8 xf[3];
#pragma unroll
            for (int ks = 0; ks < 3; ++ks) xf[ks] = *(const LAS bf16x8*)(XGB + (16 * mt + li) * 104 + 32 * ks + 8 * q);
            f32x4 g[4], y[4]; float sm = 0.f;
#pragma unroll
            for (int nt = 0; nt < 4; ++nt) { f32x4 c4 = (f32x4){0.f, 0.f, 0.f, 0.f};
#pragma unroll
                for (int ks = 0; ks < 3; ++ks) c4 = MFMA16(gf[nt][ks], xf[ks], c4);
                g[nt] = c4;
                const u32x2 yw = yf[mt][nt]; y[nt] = (f32x4){bf2f(yw.x & 0xffffu), __uint_as_float(yw.x & 0xffff0000u), bf2f(yw.y & 0xffffu), __uint_as_float(yw.y & 0xffff0000u)};
                sm += (y[nt][0] + y[nt][1]) + (y[nt][2] + y[nt][3]); }
            { auto p1 = __builtin_amdgcn_permlane16_swap(__float_as_uint(sm), __float_as_uint(sm), false, false); sm = __uint_as_float(p1[0]) + __uint_as_float(p1[1]);
              auto p2 = __builtin_amdgcn_permlane32_swap(__float_as_uint(sm), __float_as_uint(sm), false, false); sm = __uint_as_float(p2[0]) + __uint_as_float(p2[1]); }
            const float mean = sm * (1.0f / 64.0f); float sq = 0.f;
#pragma unroll
            for (int nt = 0; nt < 4; ++nt) { y[nt] = y[nt] - mean; sq += (y[nt][0] * y[nt][0] + y[nt][1] * y[nt][1]) + (y[nt][2] * y[nt][2] + y[nt][3] * y[nt][3]); }
            { auto p1 = __builtin_amdgcn_permlane16_swap(__float_as_uint(sq), __float_as_uint(sq), false, false); sq = __uint_as_float(p1[0]) + __uint_as_float(p1[1]);
              auto p2 = __builtin_amdgcn_permlane32_swap(__float_as_uint(sq), __float_as_uint(sq), false, false); sq = __uint_as_float(p2[0]) + __uint_as_float(p2[1]); }
            const float rstd = 1.0f / sqrtf(sq * (1.0f / 64.0f) + GN_EPS);
            bf16_t* orow = MIX + (m0 + 16 * mt + li) * D + h * 64 + 4 * q;
#pragma unroll
            for (int nt = 0; nt < 4; ++nt) { const u32x2 bw = bf[mt][nt]; const f32x4 bv = (f32x4){bf2f(bw.x & 0xffffu), __uint_as_float(bw.x & 0xffff0000u), bf2f(bw.y & 0xffffu), __uint_as_float(bw.y & 0xffff0000u)};
                const f32x4 o = (y[nt] * rstd * gg[nt] + gb[nt] + bv) * g[nt];
                *(u32x2*)(orow + 16 * nt) = (u32x2){pg8::cvt_pk_bf16(o[0], o[1]), pg8::cvt_pk_bf16(o[2], o[3])}; }
        }
        __syncthreads();
    }
}
__device__ __forceinline__ void final_norm(const Ctx& C, CArgs& a) {
    const int gw = C.bid * NWAVES + C.wave, NGW = C.nblk * NWAVES; const float* ssp = (const float*)(a.ws + WS_SSP); const bf16_t* X = (const bf16_t*)(a.ws + WS_X);
    f32x4 gv[4];
#pragma unroll
    for (int j = 0; j < 4; ++j) gv[j] = *((const f32x4*)a.in[I_NORM_FINAL] + C.lane + 64 * j);
    for (int m = gw; m < M; m += 2 * NGW) { const int m2 = (m + NGW < M) ? m + NGW : m;
        const float rs = pg8::row_rstd(ssp, m), rs2 = pg8::row_rstd(ssp, m2); const u32x2* xr = (const u32x2*)(X + (size_t)m * D) + C.lane; const u32x2* xr2 = (const u32x2*)(X + (size_t)m2 * D) + C.lane;
        u32x2 b1[4], b2[4];
#pragma unroll
        for (int j = 0; j < 4; ++j) { b1[j] = xr[64 * j]; b2[j] = xr2[64 * j]; }
        f32x4* orow = (f32x4*)(a.out + (size_t)m * D) + C.lane; f32x4* orow2 = (f32x4*)(a.out + (size_t)m2 * D) + C.lane;
#pragma unroll
        for (int j = 0; j < 4; ++j) { const f32x4 v = (f32x4){bf2f(b1[j].x & 0xffffu), __uint_as_float(b1[j].x & 0xffff0000u), bf2f(b1[j].y & 0xffffu), __uint_as_float(b1[j].y & 0xffff0000u)}; orow[64 * j] = v * gv[j] * rs; }
        if (m2 != m) {
#pragma unroll
            for (int j = 0; j < 4; ++j) { const f32x4 v = (f32x4){bf2f(b2[j].x & 0xffffu), __uint_as_float(b2[j].x & 0xffff0000u), bf2f(b2[j].y & 0xffffu), __uint_as_float(b2[j].y & 0xffff0000u)}; orow2[64 * j] = v * gv[j] * rs2; } } }
}

constexpr int N_PHASES = 16;
__global__ void __launch_bounds__(NTHREADS, 2) fwd_kernel(Args args) {
    extern __shared__ __attribute__((aligned(16))) unsigned char lds_raw[];
    LAS unsigned char* const lds = (LAS unsigned char*)lds_raw;
#if ONE_LAUNCH
    constexpr int lo = 0, hi = N_PHASES;
#else
    const int lo = get_args()->ph_lo, hi = get_args()->ph_hi;
#endif
#if ONE_LAUNCH
    cg::grid_group grid = cg::this_grid();
    volatile LAS unsigned* const bst = (volatile LAS unsigned*)(lds + LDS_BYTES - 64);
    if (threadIdx.x < 16) bst[threadIdx.x] = 0u;
    __syncthreads();
    if (get_args()->ph_lo < 0) grid.sync();
    (void)xcd_barrier_post((unsigned*)(get_args()->ws + WS_CTL), bst);
#define SEAM(k) do { if ((k) + 1 < hi) { XcdBarrier xb_; xb_.bar = (unsigned*)(get_args()->ws + WS_CTL); xb_.x = xb_xcc_id(); xb_.st = (volatile LAS unsigned*)(lds + LDS_BYTES - 64); xcd_barrier(xb_); } } while (0)
#else
#define SEAM(k) do { } while (0)
#endif
#define IN(k) (lo <= (k) && (k) < hi)
    if (PHK(0) && IN(0)) { const Ctx C = mk_ctx(lds); p0_prologue(C, *get_args()); SEAM(0); }
#define LAYER_BODY(layer) { \
        const int pb = 1 + 7 * layer; \
        if (PHK(1) && IN(pb)) { \
            CArgs& A = *get_args(); unsigned char* ws = A.ws; const Ctx C = mk_ctx(lds); \
            pg8::Gemm g{(const bf16_t*)(ws + WS_X), (const bf16_t*)(ws + (layer == 0 ? WS_WIN0 : WS_WIN1)), M, NP, D}; pg8::StaticOrder S; S.init(M, NP, C.nblk, C.bid); \
            pg8::EpiProj<0> E{(bf16_t*)(ws + WS_P), NP, (const float*)(ws + WS_SSP)}; \
            pg8::gemm_phase<pg8::EpiProj<0>, pg8::StaticOrder, true, true>(C.lds, C.tid, g, S, E); \
            { const int nun = (M / 256) * (NP / 256), extra = nun % C.nblk;        \
              const int nidle = extra ? C.nblk - extra : C.nblk, me = extra ? C.bid - extra : C.bid; \
              if (me >= 0) { const int lo_ = layer == 0 ? I_IN : PER_LAYER + I_IN, hi_ = layer == 0 ? PER_LAYER + I_IN : 2 * PER_LAYER; __syncthreads(); p0_weights(C, A, lo_, hi_, me * NWAVES + C.wave, nidle * NWAVES); } } \
            SEAM(pb); \
        } \
        if (IN(pb + 1)) { \
            CArgs& A = *get_args(); const Ctx C = mk_ctx(lds); \
            if (layer == 0) { if (PHK(2)) { for (int u = C.bid; u < 256; u += C.nblk) { const Ctx Cu = mk_ctx(lds); if (PHK(12)) sgu_unit(Cu, A, u); } for (int gi = C.bid; gi < 256; gi += C.nblk) gla_a_group(lds, A, gi); } } \
            else { if (PHK(3)) { u32x4 pf[5]; PrepK K; int hcur = -1; for (int u = C.bid; u < 4096; u += C.nblk) { const Ctx Cu = mk_ctx(lds); if ((u & 7) != hcur) { hcur = u & 7; prep_load_consts(Cu, A, hcur, K); prep_load_raw(Cu, A, u, K, pf); } const int nu = (u + C.nblk < 4096) ? u + C.nblk : -1; rwkv_prep_unit(Cu, A, u, (nu >= 0 && (nu & 7) == hcur) ? nu : -1, K, pf); } } } \
            SEAM(pb + 1); \
        } \
        if (IN(pb + 2)) { \
            CArgs& A = *get_args(); const Ctx C = mk_ctx(lds); \
            if (layer == 0) { } else { if (PHK(5)) { if (C.bid < R2_NSB || C.nblk <= R2_NSB) rwkv_scan(C, A); if (C.bid >= R2_NSB || C.nblk <= R2_NSB) { const int nb = C.nblk > R2_NSB ? C.nblk - R2_NSB : C.nblk; for (int u = (C.nblk > R2_NSB ? C.bid - R2_NSB : C.bid); u < 512; u += nb) { const Ctx Cu = mk_ctx(lds); for (int rr = 0; rr < REP_CONV; ++rr) conv_unit(Cu, A, u); } } } } \
            if (layer == 1) SEAM(pb + 2); \
        } \
        if (IN(pb + 3)) { \
            CArgs& A = *get_args(); const Ctx C = mk_ctx(lds); \
            if (layer == 0) { if (PHK(6)) for (int gi = C.bid; gi < 256; gi += C.nblk) gla_c_group(lds, A, gi); } \
            else { if (PHK(7)) rwkv_post_phase(C, A); } \
            SEAM(pb + 3); \
        } \
        if (PHK(8) && IN(pb + 4)) { \
            CArgs& A = *get_args(); unsigned char* ws = A.ws; const Ctx C = mk_ctx(lds); \
            pg8::Gemm g{(const bf16_t*)(ws + WS_MIX), (const bf16_t*)(ws + (layer == 0 ? WS_WOUT0 : WS_WOUT1)), M, D, D}; pg8::StaticOrder S; S.init(M, D, C.nblk, C.bid); \
            if (layer == 0) { pg8::EpiRes<true> E{A.in[I_X], (bf16_t*)(ws + WS_X), (float*)(ws + WS_SSP)}; pg8::gemm_phase<pg8::EpiRes<true>, pg8::StaticOrder, true, true>(C.lds, C.tid, g, S, E); } \
            else { pg8::EpiRes<false> E{nullptr, (bf16_t*)(ws + WS_X), (float*)(ws + WS_SSP)}; pg8::gemm_phase<pg8::EpiRes<false>, pg8::StaticOrder, true, true>(C.lds, C.tid, g, S, E); } \
            SEAM(pb + 4); \
        } \
        if (PHK(9) && IN(pb + 5)) { \
            CArgs& A = *get_args(); unsigned char* ws = A.ws; const Ctx C = mk_ctx(lds); \
            pg8::Gemm g{(const bf16_t*)(ws + WS_X), (const bf16_t*)(ws + (layer == 0 ? WS_WUP0 : WS_WUP1)), M, FF, D}; pg8::StaticOrder S; S.init(M, FF, C.nblk, C.bid); \
            pg8::EpiProj<1> E{(bf16_t*)(ws + WS_H), FF, (const float*)(ws + WS_SSP)}; \
            pg8::gemm_phase<pg8::EpiProj<1>, pg8::StaticOrder, true, true>(C.lds, C.tid, g, S, E); \
            SEAM(pb + 5); \
        } \
        if (PHK(10) && IN(pb + 6)) { \
            CArgs& A = *get_args(); unsigned char* ws = A.ws; const Ctx C = mk_ctx(lds); \
            pg8::Gemm g{(const bf16_t*)(ws + WS_H), (const bf16_t*)(ws + (layer == 0 ? WS_WDN0 : WS_WDN1)), M, D, FF}; pg8::StaticOrder S; S.init(M, D, C.nblk, C.bid); \
            pg8::EpiRes<false> E{nullptr, (bf16_t*)(ws + WS_X), (float*)(ws + WS_SSP)}; pg8::gemm_phase<pg8::EpiRes<false>, pg8::StaticOrder, true, true>(C.lds, C.tid, g, S, E); \
            SEAM(pb + 6); \
        } \
    }
    LAYER_BODY(0)
    LAYER_BODY(1)
#undef LAYER_BODY
    if (PHK(11) && IN(15)) { const Ctx C = mk_ctx(lds); final_norm(C, *get_args()); }
#undef IN
#undef SEAM
}

extern "C" void kernel_launch(void* const* d_in, const int* in_sizes, int n_in, void* d_out, int out_size, void* d_ws, size_t ws_size, hipStream_t stream) {
    static int grid = 0;
    if (grid == 0) {
        if (n_in != 32 || in_sizes[0] != M * D || out_size != M * D || ws_size < WS_END) { fprintf(stderr, "kernel_launch: unexpected shapes (n_in %d, in0 %d, out %d, ws %zu); nothing launched\n", n_in, n_in > 0 ? in_sizes[0] : -1, out_size, ws_size); grid = -1; return; }
        int dev = 0, cus = 0, per_cu = 0;
        if (hipGetDevice(&dev) != hipSuccess || hipDeviceGetAttribute(&cus, hipDeviceAttributeMultiprocessorCount, dev) != hipSuccess) { grid = -1; return; }
        if (hipFuncSetAttribute((const void*)fwd_kernel, hipFuncAttributeMaxDynamicSharedMemorySize, LDS_BYTES) != hipSuccess) { fprintf(stderr, "kernel_launch: hipFuncSetAttribute failed\n"); grid = -1; return; }
        if (hipOccupancyMaxActiveBlocksPerMultiprocessor(&per_cu, (const void*)fwd_kernel, NTHREADS, LDS_BYTES) != hipSuccess || per_cu < 1) { fprintf(stderr, "kernel_launch: occupancy query says %d blocks per CU\n", per_cu); per_cu = 1; }
        (void)hipGetLastError();
        grid = cus;
    }
    if (grid < 0) return;
    Args a{};
    for (int i = 0; i < 32; ++i) a.in[i] = (const float*)d_in[i];
    a.out = (float*)d_out; a.ws = (unsigned char*)d_ws;
#if ONE_LAUNCH
    a.ph_lo = 0; a.ph_hi = N_PHASES;
    if (hipMemsetAsync((char*)d_ws + WS_CTL, 0, 16384, stream) != hipSuccess) { fprintf(stderr, "kernel_launch: hipMemsetAsync failed\n"); return; }
    void* kargs[] = { &a };
    hipError_t e = hipLaunchCooperativeKernel((const void*)fwd_kernel, dim3(grid), dim3(NTHREADS), kargs, LDS_BYTES, stream);
    if (e != hipSuccess) fprintf(stderr, "kernel_launch: cooperative launch failed: %s (grid %d)\n", hipGetErrorString(e), grid);
#else
    for (int ph = 0; ph < N_PHASES; ++ph) {
        a.ph_lo = ph; a.ph_hi = ph + 1;
        hipLaunchKernelGGL(fwd_kernel, dim3(grid), dim3(NTHREADS), LDS_BYTES, stream, a);
        if ((REPEAT_PH >> ph) & 1) hipLaunchKernelGGL(fwd_kernel, dim3(grid), dim3(NTHREADS), LDS_BYTES, stream, a);
    }
#endif
}
```

```cpp
#include <hip/hip_runtime.h>
#include <hip/hip_cooperative_groups.h>
#include <cstdio>
#include <cstdint>
#include <type_traits>
namespace cg = cooperative_groups;

#ifndef ONE_LAUNCH
#define ONE_LAUNCH 1
#endif
#ifndef REP_STAGE
#define REP_STAGE 0
#endif
#ifndef REP_SGU
#define REP_SGU 1
#endif
#ifndef REP_GLAA
#define REP_GLAA 1
#endif
#ifndef REP_CONV
#define REP_CONV 1
#endif
#ifndef REP_PREP
#define REP_PREP 1
#endif
#ifndef REPEAT_PH
#define REPEAT_PH 0
#endif

#ifndef PH_MASK
#define PH_MASK 0xFFFF
#endif
#define PHK(b) (((PH_MASK) >> (b)) & 1)
#define LAS __attribute__((address_space(3)))
typedef unsigned short bf16_t;
typedef short bf16x8 __attribute__((ext_vector_type(8)));
typedef float f32x4 __attribute__((ext_vector_type(4)));
typedef float f32x2 __attribute__((ext_vector_type(2)));
typedef float f32x16 __attribute__((ext_vector_type(16)));
typedef unsigned u32x4 __attribute__((ext_vector_type(4)));
typedef unsigned u32x2 __attribute__((ext_vector_type(2)));
typedef LAS float lfloat;

constexpr int BATCH = 4, SEQ = 8192, D = 1024, FF = 4096;
constexpr int M = BATCH * SEQ;
constexpr int NP = 2816;
constexpr float RMS_EPS = 1e-6f, LN_EPS = 1e-5f, GN_EPS = 64e-5f;
constexpr int EC_Q = 0, EC_K = 256, EC_V = 512, EC_G = 1024, EC_U = 1536, EC_SV = 2048, EC_Z = 2560;
constexpr int OC_R = 0, OC_K = 512, OC_V = 1024, OC_CA = 1536, OC_CG = 2048, OC_XW = 2560, OC_XA = 2592, OC_XG = 2624;

constexpr size_t MiB = 1u << 20;
constexpr size_t WS_WIN0 = 2 * MiB, WS_WOUT0 = 8 * MiB, WS_WUP0 = 10 * MiB, WS_WDN0 = 18 * MiB;
constexpr size_t WS_WIN1 = 26 * MiB, WS_WOUT1 = 32 * MiB, WS_WUP1 = 34 * MiB, WS_WDN1 = 42 * MiB;
constexpr size_t WS_CTL = 0;
constexpr size_t WS_TAB = 1 * MiB;
constexpr size_t TAB_W2T = 0, TAB_A2T = 65536, TAB_G2T = 131072, TAB_CWT = 327680, TAB_GA2T = 393216, TAB_W2TB = 409600, TAB_A2TB = 442368, TAB_G2TB = 475136, TAB_SGUW = 589824;
constexpr size_t WS_SSP = 50 * MiB;
constexpr size_t WS_XN = 52 * MiB;
constexpr size_t WS_X = 436 * MiB;
constexpr size_t WS_MIX = 116 * MiB;
constexpr size_t WS_P = 180 * MiB;
constexpr size_t WS_H = 180 * MiB;
constexpr size_t WS_FREE = 436 * MiB;
constexpr size_t WS_END = 512 * MiB;
constexpr size_t WS_GLA_ST = WS_XN;
constexpr size_t WS_GLA_DL = 500 * MiB;
constexpr size_t WS_GLA_GD = WS_GLA_DL + 512 * 1024;
constexpr size_t WS_GLA_GL = WS_XN + 32 * MiB;
constexpr size_t WS_R_GP = WS_XN, WS_R_RP = WS_XN + 32 * MiB;
constexpr size_t WS_R_HADD = 356 * MiB, WS_R_Y0 = 388 * MiB;
constexpr size_t OUT_R_Y = 0, OUT_R_GC = 32 * MiB, OUT_R_BVF = 34 * MiB;
static_assert(WS_P + (size_t)M * NP * 2 <= WS_R_HADD, "P vs rwkv scratch");
static_assert(WS_R_Y0 + 32 * MiB <= WS_X && WS_X + 64 * MiB <= WS_GLA_DL && WS_GLA_DL + MiB <= WS_END, "ws map");

constexpr int NWAVES = 8, NTHREADS = 512;
constexpr int LDS_BYTES = 147456;

__device__ __forceinline__ float bf2f(unsigned v) { return __uint_as_float(v << 16); }
__device__ __forceinline__ unsigned f2bf(float f) { unsigned u = __float_as_uint(f); return (u + 0x7fffu + ((u >> 16) & 1u)) >> 16; }
__device__ __forceinline__ unsigned pk2(float lo, float hi) { return f2bf(lo) | (f2bf(hi) << 16); }
__device__ __forceinline__ float sigmoidf_(float x) { return 1.0f / (1.0f + __expf(-x)); }
__device__ __forceinline__ float fsigmoid(float x) { return __builtin_amdgcn_rcpf(1.0f + __expf(-x)); }
__device__ __forceinline__ float ftanh(float x) { return 1.0f - 2.0f * __builtin_amdgcn_rcpf(1.0f + __expf(2.0f * x)); }
__device__ __forceinline__ float silu_fast(float x) { return x * fsigmoid(x); }
__device__ __forceinline__ float siluf_(float x) { return x * sigmoidf_(x); }
__device__ __forceinline__ float geluf_(float x) { const float u = 1.5957691216057308f * (x + 0.044715f * x * x * x); return x * sigmoidf_(u); }
__device__ __forceinline__ float logsigmoidf_(float z) { return fminf(z, 0.f) - __logf(1.0f + __expf(-fabsf(z))); }
__device__ __forceinline__ float wave_sum(float v) {
#pragma unroll
    for (int o = 1; o < 64; o <<= 1) v += __shfl_xor(v, o);
    return v;
}
__device__ __forceinline__ void unpack8(const u32x4 w, float* f) {
    f[0] = bf2f(w.x & 0xffffu); f[1] = __uint_as_float(w.x & 0xffff0000u);
    f[2] = bf2f(w.y & 0xffffu); f[3] = __uint_as_float(w.y & 0xffff0000u);
    f[4] = bf2f(w.z & 0xffffu); f[5] = __uint_as_float(w.z & 0xffff0000u);
    f[6] = bf2f(w.w & 0xffffu); f[7] = __uint_as_float(w.w & 0xffff0000u);
}
__device__ __forceinline__ float ldbf(const bf16_t* p) { return bf2f((unsigned)*p); }

namespace pg8 {
#define PG8_LAS __attribute__((address_space(3)))
constexpr int BM = 256, BK = 64, HALF = 128, HTB = HALF * BK * 2, STAGE_BYTES = 8 * HTB, NXCD = 8, WGM = 4;
__host__ __device__ __forceinline__ int lds_byte(int r, int c) { const int st = (r >> 4) * 2 + (c >> 5), rr = r & 15, cc = c & 31, ob = rr * 64 + cc * 2; return st * 1024 + (ob ^ (((ob >> 9) & 1) << 5)); }
__host__ __device__ __forceinline__ void stage_rc(int b, int& R, int& C) { const int st = b / 1024, sb = b % 1024, swz = sb ^ (((sb >> 9) & 1) << 5); R = (st >> 1) * 16 + swz / 64; C = (st & 1) * 32 + (swz % 64) / 2; }
__host__ __device__ __forceinline__ int perm32(int rho) { const int n = rho >> 4, i = rho & 15; return 8 * (i >> 2) + 4 * n + (i & 3); }

struct Unit { int pm, pn; };
struct Gemm { const bf16_t* A; const bf16_t* Bt; int M, N, K; };
struct StaticOrder {
    int nM, nN, nwg, G, c, wgm;
    __host__ __device__ void init(int M_, int N_, int G_, int c_, int wgm_ = WGM) { nM = M_ / BM; nN = N_ / BM; nwg = nM * nN; G = G_; c = c_; wgm = wgm_; }
    __host__ __device__ bool next(int i, Unit& u) const {
        const long L = (long)i * G + c; if (L >= nwg) return false;
        int wgid = (int)L; { const int q = nwg / NXCD, r = nwg % NXCD, xcd = wgid % NXCD, off = wgid / NXCD; wgid = (xcd < r ? xcd * (q + 1) : r * (q + 1) + (xcd - r) * q) + off; }
        const int nig = wgm * nN, gid = wgid / nig, fm = gid * wgm, gsz = (nM - fm) < wgm ? (nM - fm) : wgm;
        u.pm = fm + ((wgid % nig) % gsz); u.pn = (wgid % nig) / gsz; return true;
    }
    __device__ __forceinline__ void a_ready(const Unit&) const {}
    __device__ __forceinline__ void done(const Unit&) const {}
};
typedef float f32x2_t_ __attribute__((ext_vector_type(2))); typedef __bf16 bf16x2_t_ __attribute__((ext_vector_type(2)));
__device__ __forceinline__ unsigned cvt_pk_bf16(float lo, float hi) { const f32x2_t_ v = {lo, hi}; const bf16x2_t_ b = __builtin_convertvector(v, bf16x2_t_); return __builtin_bit_cast(unsigned, b); }

__device__ __forceinline__ void st16_wt(void* p, const u32x4 w) { asm volatile("s_nop 1\n\tglobal_store_dwordx4 %0, %1, off sc1 nt\n\ts_nop 1" :: "v"(p), "v"(w) : "memory"); }
__device__ __forceinline__ float row_rstd(const float* ssp, int r) {
    const f32x4* p = (const f32x4*)(ssp + (size_t)r * 16);
    const f32x4 a = p[0], b = p[1], c = p[2], d = p[3];
    const float s = ((a[0] + a[1]) + (a[2] + a[3])) + ((b[0] + b[1]) + (b[2] + b[3])) + ((c[0] + c[1]) + (c[2] + c[3])) + ((d[0] + d[1]) + (d[2] + d[3]));
    return 1.0f / sqrtf(s * (1.0f / 1024.0f) + RMS_EPS);
}
struct RstdState { float rs[2][4]; };
__device__ __forceinline__ void rstd_issue(const float* ssp, int row0, int fq, f32x4 (&raw)[2][4]) {
#pragma unroll
    for (int ai = 0; ai < 2; ++ai)
#pragma unroll
        for (int m = 0; m < 4; ++m) raw[ai][m] = *(const f32x4*)(ssp + (size_t)(row0 + ai * HALF + m * 16) * 16 + fq * 4);
}
__device__ __forceinline__ void rstd_finish(const f32x4 (&raw)[2][4], RstdState& st) {
#pragma unroll
    for (int ai = 0; ai < 2; ++ai)
#pragma unroll
        for (int m = 0; m < 4; ++m) { float s = (raw[ai][m][0] + raw[ai][m][1]) + (raw[ai][m][2] + raw[ai][m][3]);
            s += __shfl_xor(s, 16); s += __shfl_xor(s, 32);
            st.rs[ai][m] = __builtin_amdgcn_rsqf(s * (1.0f / 1024.0f) + RMS_EPS); }
}
template <int ACT> struct EpiProj {
    static constexpr bool PERM = true, AFTER_DRAIN = false;
    typedef RstdState State;
    bf16_t* O; int ldc; const float* ssp;
    __device__ __forceinline__ void init(State& st, const Unit& u, int wr, int fr, int fq) const {
        f32x4 raw[2][4]; rstd_issue(ssp, u.pm * BM + wr * 64 + fr, fq, raw); rstd_finish(raw, st);
    }
    __device__ __forceinline__ void operator()(const f32x4 (&acc)[2][2][4][2], State& st, const Unit& u, const Unit& un, bool has_next, int wr, int wc, int fr, int fq) const {
        const int row0 = u.pm * BM + wr * 64 + fr, col0 = u.pn * BM + wc * 32 + 8 * fq;
        f32x4 raw[2][4];
        if (has_next) rstd_issue(ssp, un.pm * BM + wr * 64 + fr, fq, raw);
#pragma unroll
        for (int ai = 0; ai < 2; ++ai)
#pragma unroll
            for (int m = 0; m < 4; ++m) { bf16_t* rowp = O + (size_t)(row0 + ai * HALF + m * 16) * ldc + col0; const float sc = st.rs[ai][m];
#pragma unroll
                for (int bj = 0; bj < 2; ++bj) { f32x4 v0 = acc[ai][bj][m][0] * sc, v1 = acc[ai][bj][m][1] * sc;
                    if (ACT == 1) {
#pragma unroll
                        for (int e = 0; e < 4; ++e) { const float a = fmaxf(v0[e], 0.f), b = fmaxf(v1[e], 0.f); v0[e] = a * a; v1[e] = b * b; } }
                    u32x4 w; w.x = cvt_pk_bf16(v0[0], v0[1]); w.y = cvt_pk_bf16(v0[2], v0[3]); w.z = cvt_pk_bf16(v1[0], v1[1]); w.w = cvt_pk_bf16(v1[2], v1[3]);
                    st16_wt(rowp + bj * HALF, w); } }
        if (has_next) rstd_finish(raw, st);
    }
};
template <bool BASE_F32> struct EpiRes {
    static constexpr bool PERM = true, AFTER_DRAIN = false;
    struct State {};
    const float* basef; bf16_t* X; float* ssp;
    __device__ __forceinline__ void init(State&, const Unit&, int, int, int) const {}
    __device__ __forceinline__ void operator()(const f32x4 (&acc)[2][2][4][2], State&, const Unit& u, const Unit&, bool, int wr, int wc, int fr, int fq) const {
        const int row0 = u.pm * BM + wr * 64 + fr, col0 = u.pn * BM + wc * 32 + 8 * fq;
#pragma unroll
        for (int ai = 0; ai < 2; ++ai) {
            f32x4 bf_[4][2][2]; u32x4 bb_[4][2];
#pragma unroll
            for (int m = 0; m < 4; ++m) { const size_t off = (size_t)(row0 + ai * HALF + m * 16) * D + col0;
#pragma unroll
                for (int bj = 0; bj < 2; ++bj) { if (BASE_F32) { bf_[m][bj][0] = *(const f32x4*)(basef + off + bj * HALF); bf_[m][bj][1] = *(const f32x4*)(basef + off + bj * HALF + 4); } else bb_[m][bj] = *(const u32x4*)(X + off + bj * HALF); } }
#pragma unroll
            for (int m = 0; m < 4; ++m) { const int r = row0 + ai * HALF + m * 16; const size_t off = (size_t)r * D + col0; float ss = 0.f;
#pragma unroll
                for (int bj = 0; bj < 2; ++bj) { f32x4 b0, b1;
                    if (BASE_F32) { b0 = bf_[m][bj][0]; b1 = bf_[m][bj][1]; }
                    else { const u32x4 bw = bb_[m][bj];
                        b0 = (f32x4){bf2f(bw.x & 0xffffu), __uint_as_float(bw.x & 0xffff0000u), bf2f(bw.y & 0xffffu), __uint_as_float(bw.y & 0xffff0000u)};
                        b1 = (f32x4){bf2f(bw.z & 0xffffu), __uint_as_float(bw.z & 0xffff0000u), bf2f(bw.w & 0xffffu), __uint_as_float(bw.w & 0xffff0000u)}; }
                    const f32x4 v0 = b0 + acc[ai][bj][m][0], v1 = b1 + acc[ai][bj][m][1];
                    ss += ((v0[0] * v0[0] + v0[1] * v0[1]) + (v0[2] * v0[2] + v0[3] * v0[3])) + ((v1[0] * v1[0] + v1[1] * v1[1]) + (v1[2] * v1[2] + v1[3] * v1[3]));
                    u32x4 w; w.x = cvt_pk_bf16(v0[0], v0[1]); w.y = cvt_pk_bf16(v0[2], v0[3]); w.z = cvt_pk_bf16(v1[0], v1[1]); w.w = cvt_pk_bf16(v1[2], v1[3]);
                    *(u32x4*)(X + off + bj * HALF) = w; }
                ss += __shfl_xor(ss, 16); ss += __shfl_xor(ss, 32);
                if (fq == 0) ssp[(size_t)r * 16 + u.pn * 4 + wc] = ss; }
        }
    }
};

template <class Epi, class Sched, bool ALIGN_EPI = false, bool SP2 = false>
__device__ __forceinline__ void gemm_phase(PG8_LAS unsigned char* lds, const int tid, const Gemm g, const Sched& S, const Epi& E) {
    const int wid = __builtin_amdgcn_readfirstlane(tid >> 6), lane = tid & 63, wr = wid >> 2, wc = wid & 3, fr = lane & 15, fq = lane >> 4;
    const int K = g.K, nt = K / BK;
    unsigned voffA[2], voffB[2];
#pragma unroll
    for (int i = 0; i < 2; ++i) { int R, C; stage_rc(tid * 16 + i * 8192, R, C); const int Rb = Epi::PERM ? ((R & ~31) + perm32(R & 31)) : R;
        voffA[i] = (unsigned)(R * K + C) * 2u; voffB[i] = (unsigned)(Rb * K + C) * 2u; }
    const size_t kstep = (size_t)(BK * 2);
    const size_t hstep = (size_t)HALF * K * 2;
    const size_t tstep = 2 * hstep;
    const unsigned ldsw = (unsigned)wid * 1024u;
    const int aoff = lds_byte(wr * 64 + fr, fq * 8), boff = lds_byte(wc * 32 + fr, fq * 8);
#define PG8_SA(b, h) (((b) * 2 + (h)) * HTB)
#define PG8_SB(b, h) ((4 + (b) * 2 + (h)) * HTB)
#define PG8_STAGE(bufoff, gbase, voff) do { _Pragma("unroll") for (int _i = 0; _i < 2; ++_i) \
        __builtin_amdgcn_global_load_lds((const unsigned*)((const char*)(gbase) + (voff)[_i]), (PG8_LAS unsigned*)(lds + (bufoff) + ldsw + _i * 8192), 16, 0, 0); } while (0)
#define PG8_LDA(dst, b, h) do { _Pragma("unroll") for (int m = 0; m < 4; ++m) _Pragma("unroll") for (int k = 0; k < 2; ++k) dst[m][k] = *(const PG8_LAS bf16x8*)(lds + PG8_SA(b, h) + aoff + m * 2048 + k * 1024); } while (0)
#define PG8_LDB(dst, b, h) do { _Pragma("unroll") for (int n = 0; n < 2; ++n) _Pragma("unroll") for (int k = 0; k < 2; ++k) dst[n][k] = *(const PG8_LAS bf16x8*)(lds + PG8_SB(b, h) + boff + n * 2048 + k * 1024); } while (0)
#define PG8_MMA(ai, bj, At, Bt) do { __builtin_amdgcn_s_setprio(1); _Pragma("unroll") for (int m = 0; m < 4; ++m) _Pragma("unroll") for (int n = 0; n < 2; ++n) _Pragma("unroll") for (int k = 0; k < 2; ++k) \
        acc[ai][bj][m][n] = __builtin_amdgcn_mfma_f32_16x16x32_bf16(Bt[n][k], At[m][k], acc[ai][bj][m][n], 0, 0, 0); __builtin_amdgcn_s_setprio(0); } while (0)
#define PG8_WAIT_V(n) asm volatile("s_waitcnt vmcnt(" #n ")" ::: "memory")
#define PG8_WAIT_L(n) asm volatile("s_waitcnt lgkmcnt(" #n ")" ::: "memory")
#define PG8_BAR __builtin_amdgcn_s_barrier()
#define PG8_SCHED __builtin_amdgcn_sched_barrier(0)
    Unit cur, nxt; int ui = 0;
    if (!S.next(0, cur)) return;
    f32x4 acc[2][2][4][2];
#pragma unroll
    for (int a = 0; a < 2; ++a)
#pragma unroll
        for (int b = 0; b < 2; ++b)
#pragma unroll
            for (int m = 0; m < 4; ++m)
#pragma unroll
                for (int n = 0; n < 2; ++n) acc[a][b][m][n] = (f32x4){0.f, 0.f, 0.f, 0.f};
    bf16x8 At[4][2], B0[2][2], B1[2][2];
    const char* cA = (const char*)g.A + (size_t)cur.pm * tstep; const char* cB = (const char*)g.Bt + (size_t)cur.pn * tstep;
    S.a_ready(cur);
    typename Epi::State est; E.init(est, cur, wr, fr, fq);
    if constexpr (SP2) {
        PG8_STAGE(PG8_SB(0, 0), cB, voffB); PG8_STAGE(PG8_SB(0, 1), cB + hstep, voffB); PG8_STAGE(PG8_SA(0, 0), cA, voffA); PG8_STAGE(PG8_SA(0, 1), cA + hstep, voffA);
        if (wr == 1) PG8_BAR;
        PG8_WAIT_V(2); PG8_BAR;
        PG8_STAGE(PG8_SB(1, 0), cB + kstep, voffB); PG8_STAGE(PG8_SA(1, 0), cA + kstep, voffA); PG8_STAGE(PG8_SB(1, 1), cB + hstep + kstep, voffB);
        PG8_WAIT_V(6); PG8_BAR;
    } else {
        PG8_STAGE(PG8_SB(0, 0), cB, voffB); PG8_STAGE(PG8_SA(0, 0), cA, voffA); PG8_STAGE(PG8_SB(0, 1), cB + hstep, voffB); PG8_STAGE(PG8_SA(0, 1), cA + hstep, voffA);
        if (wr == 1) PG8_BAR;
        PG8_WAIT_V(4); PG8_BAR;
        PG8_STAGE(PG8_SB(1, 0), cB + kstep, voffB); PG8_STAGE(PG8_SA(1, 0), cA + kstep, voffA); PG8_STAGE(PG8_SB(1, 1), cB + hstep + kstep, voffB);
        PG8_WAIT_V(6); PG8_BAR;
    }
    for (;;) {
        const bool has_next = S.next(ui + 1, nxt);
        const char* nA = has_next ? (const char*)g.A + (size_t)nxt.pm * tstep : cA; const char* nB = has_next ? (const char*)g.Bt + (size_t)nxt.pn * tstep : cB;
        for (int t = 0; t < nt; t += 2) {
            const bool last = (t == nt - 2);
            const char* a1 = cA + (size_t)(t + 1) * kstep;
            const char* a2 = last ? nA : cA + (size_t)(t + 2) * kstep; const char* b2 = last ? nB : cB + (size_t)(t + 2) * kstep;
            const char* a3 = a2 + kstep; const char* b3 = b2 + kstep;
            if (last && has_next) S.a_ready(nxt);
            if constexpr (SP2) {
            PG8_LDB(B0, 0, 0); PG8_LDB(B1, 0, 1); PG8_SCHED; PG8_LDA(At, 0, 0); PG8_STAGE(PG8_SA(1, 1), a1 + hstep, voffA);
            PG8_WAIT_V(8); PG8_WAIT_L(0); PG8_BAR; PG8_MMA(0, 0, At, B0); PG8_MMA(0, 1, At, B1); PG8_BAR; PG8_SCHED;
            PG8_LDA(At, 0, 1); PG8_STAGE(PG8_SB(0, 0), b2, voffB); PG8_STAGE(PG8_SB(0, 1), b2 + hstep, voffB); PG8_STAGE(PG8_SA(0, 0), a2, voffA);
            PG8_WAIT_V(8); PG8_WAIT_L(0); PG8_BAR; PG8_MMA(1, 0, At, B0); PG8_MMA(1, 1, At, B1); PG8_BAR; PG8_SCHED;
            PG8_LDB(B0, 1, 0); PG8_LDB(B1, 1, 1); PG8_SCHED; PG8_LDA(At, 1, 0); PG8_STAGE(PG8_SA(0, 1), a2 + hstep, voffA);
            PG8_WAIT_V(8); PG8_WAIT_L(0); PG8_BAR; PG8_MMA(0, 0, At, B0); PG8_MMA(0, 1, At, B1); PG8_BAR; PG8_SCHED;
            PG8_LDA(At, 1, 1); PG8_STAGE(PG8_SB(1, 0), b3, voffB); PG8_STAGE(PG8_SB(1, 1), b3 + hstep, voffB); PG8_STAGE(PG8_SA(1, 0), a3, voffA);
            PG8_WAIT_V(8); PG8_WAIT_L(0); PG8_BAR; PG8_MMA(1, 0, At, B0); PG8_MMA(1, 1, At, B1); PG8_BAR; PG8_SCHED;
            } else {
            PG8_LDB(B0, 0, 0); PG8_SCHED; PG8_LDA(At, 0, 0); PG8_STAGE(PG8_SA(1, 1), a1 + hstep, voffA);
            PG8_WAIT_L(8); PG8_BAR; PG8_WAIT_L(0); PG8_MMA(0, 0, At, B0); PG8_BAR; PG8_SCHED;
            PG8_LDB(B1, 0, 1); PG8_STAGE(PG8_SB(0, 0), b2, voffB);
            PG8_BAR; PG8_WAIT_L(0); PG8_MMA(0, 1, At, B1); PG8_BAR;
            PG8_LDA(At, 0, 1); PG8_STAGE(PG8_SA(0, 0), a2, voffA);
            PG8_BAR; PG8_WAIT_L(0); PG8_MMA(1, 0, At, B0); PG8_BAR; PG8_SCHED;
            PG8_STAGE(PG8_SB(0, 1), b2 + hstep, voffB);
            PG8_WAIT_V(6); PG8_BAR; PG8_MMA(1, 1, At, B1); PG8_BAR;
            PG8_LDB(B0, 1, 0); PG8_SCHED; PG8_LDA(At, 1, 0); PG8_STAGE(PG8_SA(0, 1), a2 + hstep, voffA);
            PG8_WAIT_L(8); PG8_BAR; PG8_WAIT_L(0); PG8_MMA(0, 0, At, B0); PG8_BAR; PG8_SCHED;
            PG8_LDB(B1, 1, 1); PG8_STAGE(PG8_SB(1, 0), b3, voffB);
            PG8_BAR; PG8_WAIT_L(0); PG8_MMA(0, 1, At, B1); PG8_BAR;
            PG8_LDA(At, 1, 1); PG8_STAGE(PG8_SA(1, 0), a3, voffA);
            PG8_BAR; PG8_WAIT_L(0); PG8_MMA(1, 0, At, B0); PG8_BAR; PG8_SCHED;
            PG8_STAGE(PG8_SB(1, 1), b3 + hstep, voffB);
            PG8_WAIT_V(6); PG8_BAR; PG8_MMA(1, 1, At, B1); PG8_BAR;
            }
        }
        if constexpr (ALIGN_EPI) { if (wr == 0) PG8_BAR; }
        if constexpr (!Epi::AFTER_DRAIN) { E(acc, est, cur, nxt, has_next, wr, wc, fr, fq); S.done(cur); }
        if (!has_next) break;
#pragma unroll
        for (int a = 0; a < 2; ++a)
#pragma unroll
            for (int b = 0; b < 2; ++b)
#pragma unroll
                for (int m = 0; m < 4; ++m)
#pragma unroll
                    for (int n = 0; n < 2; ++n) acc[a][b][m][n] = (f32x4){0.f, 0.f, 0.f, 0.f};
        cur = nxt; cA = nA; cB = nB; ++ui;
        if constexpr (ALIGN_EPI) { if (wr == 1) PG8_BAR; }
    }
    PG8_WAIT_V(0);
    if constexpr (!ALIGN_EPI) { if (wr == 0) PG8_BAR; }
    PG8_BAR;
#undef PG8_SA
#undef PG8_SB
#undef PG8_STAGE
#undef PG8_LDA
#undef PG8_LDB
#undef PG8_MMA
#undef PG8_WAIT_V
#undef PG8_WAIT_L
#undef PG8_BAR
#undef PG8_SCHED
}
}


#define XB_TMO      128
#define XB_XCNT(j)  (256  + 64 * (j))
#define XB_XSUB(j)  (1280 + 64 * (j))
#define XB_XGEN(j)  (2304 + 64 * (j))
#define XB_TOP      3328
#define XB_TOPGEN   3392
#define XCD_BAR_WORDS 3456
#define XB_SPIN_CAP (1u << 18)
__device__ __forceinline__ unsigned xb_ld(unsigned* p)              { return __hip_atomic_load(p, __ATOMIC_RELAXED, __HIP_MEMORY_SCOPE_AGENT); }
__device__ __forceinline__ unsigned xb_add(unsigned* p, unsigned v) { return __hip_atomic_fetch_add(p, v, __ATOMIC_RELAXED, __HIP_MEMORY_SCOPE_AGENT); }
__device__ __forceinline__ unsigned xb_xcc_id() { return (unsigned)__builtin_amdgcn_s_getreg((3 << 11) | 20) & 0xFu; }
#define XB_SPIN(cond, bar) do { unsigned _sp = 0; while (cond) { __builtin_amdgcn_s_sleep(1); \
    if ((++_sp & 255u) == 0u) { if (xb_ld(&(bar)[XB_TMO])) break; if (_sp > XB_SPIN_CAP) { atomicAdd(&(bar)[XB_TMO], 1u); break; } } } } while (0)
struct XcdBarrier { unsigned* bar; unsigned x; volatile LAS unsigned* st; };
__device__ __forceinline__ XcdBarrier xcd_barrier_post(unsigned* bar, volatile LAS unsigned* st) {
    XcdBarrier b; b.bar = bar; b.x = xb_xcc_id(); b.st = st;
    if (threadIdx.x == 0) (void)xb_add(&bar[XB_XCNT(b.x)], 1u);
    return b;
}
__device__ __forceinline__ void xcd_barrier_complete(unsigned* bar, unsigned x, unsigned& nloc, unsigned& nx) {
    const unsigned G = gridDim.x * gridDim.y * gridDim.z;
    unsigned sum, cnt, mine, sp = 0u;
    for (;;) {
        sum = 0u; cnt = 0u; mine = 0u;
#pragma unroll
        for (unsigned j = 0; j < 16; ++j) { const unsigned c = xb_ld(&bar[XB_XCNT(j)]); sum += c; cnt += (c > 0u) ? 1u : 0u; mine = (j == x) ? c : mine; }
        if (sum == G) break;
        __builtin_amdgcn_s_sleep(1);
        if ((++sp & 255u) == 0u) { if (xb_ld(&bar[XB_TMO])) break; if (sp > XB_SPIN_CAP) { atomicAdd(&bar[XB_TMO], 1u); break; } }
    }
    nloc = mine > 0u ? mine : 1u; nx = cnt > 0u ? cnt : 1u;
}
__device__ __forceinline__ void xcd_barrier(const XcdBarrier& b) {
    asm volatile("s_waitcnt vmcnt(0)" ::: "memory");
    __syncthreads();
    if (threadIdx.x == 0) {
        unsigned* bar = b.bar;
        __builtin_amdgcn_s_waitcnt(0);
        asm volatile("buffer_inv sc1" ::: "memory");
        unsigned nloc = b.st[0], nx = b.st[1];
        if (nloc == 0u) { xcd_barrier_complete(bar, b.x, nloc, nx); b.st[0] = nloc; b.st[1] = nx; }
        const unsigned old = xb_add(&bar[XB_XSUB(b.x)], 1u);
        const unsigned gen = old / nloc;
        if (old + 1u == (gen + 1u) * nloc) {
            __builtin_amdgcn_fence(__ATOMIC_RELEASE, "agent");
            asm volatile("s_waitcnt vmcnt(0)" ::: "memory");
            const unsigned og = xb_add(&bar[XB_TOP], 1u);
            const unsigned tg = og / nx;
            if (og + 1u == (tg + 1u) * nx) (void)xb_add(&bar[XB_TOPGEN], 1u);
            else XB_SPIN(xb_ld(&bar[XB_TOPGEN]) == tg, bar);
            (void)xb_add(&bar[XB_XGEN(b.x)], 1u);
            asm volatile("" ::: "memory");
        } else {
            XB_SPIN(xb_ld(&bar[XB_XGEN(b.x)]) == gen, bar);
            asm volatile("s_waitcnt vmcnt(0)" ::: "memory");
        }
    }
    __syncthreads();
}

struct Args { const float* in[32]; float* out; unsigned char* ws; int ph_lo, ph_hi; };
enum { I_X = 0, I_NORM_MIX, I_NORM_FFN, I_W_UP, I_W_DOWN, I_NORM_FINAL, I_EVEN_W_IN, I_EVEN_W_OUT, I_GLA_W_ALPHA2, I_GLA_B_ALPHA, I_GLA_NORM,
       I_SGU_LN_G, I_SGU_LN_B, I_SGU_W, I_SGU_B, I_ODD_W_IN, I_ODD_W_OUT, I_RWKV_MU, I_RWKV_W0, I_RWKV_W2, I_RWKV_A0, I_RWKV_A2, I_RWKV_G2,
       I_RWKV_K_K, I_RWKV_K_A, I_RWKV_R_K, I_RWKV_GN_G, I_RWKV_GN_B, I_CONV_W, I_CONV_B, I_CONV_LN_G, I_CONV_LN_B };

struct Ctx { LAS unsigned char* lds; int tid, lane, wave, bid, nblk; };
__device__ __forceinline__ Ctx mk_ctx(LAS unsigned char* lds) { Ctx C; C.lds = lds; int t = threadIdx.x, b = blockIdx.x, g = gridDim.x; asm volatile("" : "+v"(t), "+s"(b), "+s"(g));
    C.tid = t; C.lane = t & 63; C.wave = __builtin_amdgcn_readfirstlane(t >> 6); C.bid = b; C.nblk = g; return C; }
typedef __attribute__((address_space(4))) const Args CArgs;
__device__ __forceinline__ CArgs* get_args() { CArgs* p = (CArgs*)__builtin_amdgcn_kernarg_segment_ptr(); asm volatile("" : "+s"(p)); return p; }

template <int MODE> __device__ __forceinline__ int colmap(int n) {
    if (MODE == 0) return n;
    if (MODE == 1) return n < 1536 ? n : (n < 2560 ? n + 16 : -2);
    return n < 1536 ? n : (n < 2560 ? n + 160 : (n < 2720 ? n - 1024 : -1));
}
template <int MODE> __device__ __forceinline__ void p0_transpose_item(const float* W, const float* gain, int K, int Nsrc, int Ndst, bf16_t* WT, LAS float* scr, int item, int lane) {
    const int nblk = Ndst / 32, kb = item / nblk, nb = item % nblk, k0 = 64 * kb, n0 = 32 * nb;
    const int src = colmap<MODE>(n0 + (lane & 31));
    if (MODE == 1 && n0 >= 2560) return;
    float wv_[32];
#pragma unroll
    for (int i = 0; i < 32; ++i) { const int kk = 2 * i + (lane >> 5); wv_[i] = src >= 0 ? W[(size_t)(k0 + kk) * Nsrc + src] : 0.f; }
    if (gain) {
#pragma unroll
        for (int i = 0; i < 32; ++i) wv_[i] *= gain[k0 + 2 * i + (lane >> 5)]; }
#pragma unroll
    for (int i = 0; i < 32; ++i) scr[(2 * i + (lane >> 5)) * 33 + (lane & 31)] = wv_[i];
    asm volatile("s_waitcnt lgkmcnt(0)" ::: "memory");
    const int c = lane & 7;
#pragma unroll
    for (int j = 0; j < 4; ++j) { const int n = (lane >> 3) + 8 * j; const LAS float* s = scr + (8 * c) * 33 + n;
        u32x4 o; o.x = pk2(s[0 * 33], s[1 * 33]); o.y = pk2(s[2 * 33], s[3 * 33]); o.z = pk2(s[4 * 33], s[5 * 33]); o.w = pk2(s[6 * 33], s[7 * 33]);
        *(u32x4*)(WT + (size_t)(n0 + n) * K + k0 + 8 * c) = o; }
    asm volatile("s_waitcnt lgkmcnt(0)" ::: "memory");
}
constexpr int I_IN = (D / 64) * (NP / 32), I_OUT = (D / 64) * (D / 32), I_UP = (D / 64) * (FF / 32), I_DN = (FF / 64) * (D / 32);
constexpr int PER_LAYER = I_IN + I_OUT + I_UP + I_DN;
__device__ __forceinline__ void p0_weights(const Ctx& C, CArgs& a, int lo, int hi, int gw, int NGW) {
    LAS float* scr = (LAS float*)(C.lds + C.wave * 16384);
    unsigned char* ws = a.ws;
    for (int it = lo + gw; it < hi; it += NGW) {
        const int layer = it / PER_LAYER; int r = it % PER_LAYER;
        if (r < I_IN) { if (layer == 0) p0_transpose_item<1>(a.in[I_EVEN_W_IN], a.in[I_NORM_MIX], D, 2576, NP, (bf16_t*)(ws + WS_WIN0), scr, r, C.lane);
                        else p0_transpose_item<2>(a.in[I_ODD_W_IN], a.in[I_NORM_MIX] + D, D, 2720, NP, (bf16_t*)(ws + WS_WIN1), scr, r, C.lane); continue; } r -= I_IN;
        if (r < I_OUT) { p0_transpose_item<0>(layer == 0 ? a.in[I_EVEN_W_OUT] : a.in[I_ODD_W_OUT], nullptr, D, D, D, (bf16_t*)(ws + (layer == 0 ? WS_WOUT0 : WS_WOUT1)), scr, r, C.lane); continue; } r -= I_OUT;
        if (r < I_UP) { p0_transpose_item<0>(a.in[I_W_UP] + (size_t)layer * D * FF, a.in[I_NORM_FFN] + layer * D, D, FF, FF, (bf16_t*)(ws + (layer == 0 ? WS_WUP0 : WS_WUP1)), scr, r, C.lane); continue; } r -= I_UP;
        p0_transpose_item<0>(a.in[I_W_DOWN] + (size_t)layer * FF * D, nullptr, FF, D, D, (bf16_t*)(ws + (layer == 0 ? WS_WDN0 : WS_WDN1)), scr, r, C.lane);
    }
}
__device__ __forceinline__ void p0_prologue(const Ctx& C, CArgs& a) {
    const int gw = C.bid * NWAVES + C.wave, NGW = C.nblk * NWAVES;
    unsigned char* ws = a.ws;
    p0_weights(C, a, 0, I_IN, gw, NGW);
    { const int gt = C.bid * NTHREADS + C.tid, NGT = C.nblk * NTHREADS; float* tab = (float*)(ws + WS_TAB);
      for (int i = gt; i < 512 * 32; i += NGT) { const int c = i >> 5, j = i & 31; tab[TAB_W2T / 4 + i] = a.in[I_RWKV_W2][j * 512 + c]; tab[TAB_A2T / 4 + i] = a.in[I_RWKV_A2][j * 512 + c];
          ((bf16_t*)(ws + WS_TAB + TAB_W2TB))[i] = (bf16_t)f2bf(a.in[I_RWKV_W2][j * 512 + c]); ((bf16_t*)(ws + WS_TAB + TAB_A2TB))[i] = (bf16_t)f2bf(a.in[I_RWKV_A2][j * 512 + c]);
          tab[TAB_CWT / 4 + i] = j < 31 ? a.in[I_CONV_W][j * 512 + c] : 0.f; }
      for (int i = gt; i < 512 * 96; i += NGT) { const int c = i / 96, j = i % 96; tab[TAB_G2T / 4 + i] = a.in[I_RWKV_G2][j * 512 + c]; ((bf16_t*)(ws + WS_TAB + TAB_G2TB))[i] = (bf16_t)f2bf(a.in[I_RWKV_G2][j * 512 + c]); }
      for (int i = gt; i < 256 * 128; i += NGT) { const int n = i >> 7, k8 = i & 127; float wa[16];
#pragma unroll
          for (int j = 0; j < 16; ++j) wa[j] = a.in[I_GLA_W_ALPHA2][j * 256 + n];
          unsigned o[4];
#pragma unroll
          for (int e = 0; e < 8; ++e) { const int k = 8 * k8 + e; const f32x4* wr = (const f32x4*)(a.in[I_EVEN_W_IN] + (size_t)k * 2576 + 1536); float acc = 0.f;
#pragma unroll
              for (int j4 = 0; j4 < 4; ++j4) { const f32x4 v = wr[j4]; acc += v[0] * wa[4 * j4] + v[1] * wa[4 * j4 + 1] + v[2] * wa[4 * j4 + 2] + v[3] * wa[4 * j4 + 3]; }
              acc *= a.in[I_NORM_MIX][k];
              if (e & 1) o[e >> 1] |= f2bf(acc) << 16; else o[e >> 1] = f2bf(acc); }
          *(u32x4*)((bf16_t*)(ws + WS_WIN0) + (size_t)(2560 + n) * D + 8 * k8) = (u32x4){o[0], o[1], o[2], o[3]}; }
      for (int i = gt; i < 4 * 128 * 128; i += NGT) { const int t = (i >> 7) & 127, sx = i & 127; ((bf16_t*)(ws + WS_TAB + TAB_SGUW))[i] = (bf16_t)f2bf(sx <= t ? a.in[I_SGU_W][i] : 0.f); } }
    const float* x = a.in[I_X]; bf16_t* X = (bf16_t*)(ws + WS_X); float* SSP = (float*)(ws + WS_SSP);
    for (int m = gw; m < M; m += 2 * NGW) {
        const int m2 = m + NGW; const bool has2 = m2 < M;
        const f32x4* xr = (const f32x4*)(x + (size_t)m * D) + C.lane; const f32x4* xr2 = (const f32x4*)(x + (size_t)(has2 ? m2 : m) * D) + C.lane; f32x4 v[4], v2[4]; float s = 0.f, s2 = 0.f;
#pragma unroll
        for (int j = 0; j < 4; ++j) { v[j] = __builtin_nontemporal_load(xr + 64 * j); v2[j] = __builtin_nontemporal_load(xr2 + 64 * j); }
#pragma unroll
        for (int j = 0; j < 4; ++j) { s += (v[j][0] * v[j][0] + v[j][1] * v[j][1]) + (v[j][2] * v[j][2] + v[j][3] * v[j][3]); s2 += (v2[j][0] * v2[j][0] + v2[j][1] * v2[j][1]) + (v2[j][2] * v2[j][2] + v2[j][3] * v2[j][3]); }
        s = wave_sum(s); s2 = wave_sum(s2);
        u32x2* o8 = (u32x2*)(X + (size_t)m * D) + C.lane;
#pragma unroll
        for (int j = 0; j < 4; ++j) { u32x2 w; w.x = pk2(v[j][0], v[j][1]); w.y = pk2(v[j][2], v[j][3]); o8[64 * j] = w; }
        if (C.lane < 16) SSP[(size_t)m * 16 + C.lane] = (C.lane == 0) ? s : 0.f;
        if (has2) { u32x2* o82 = (u32x2*)(X + (size_t)m2 * D) + C.lane;
#pragma unroll
            for (int j = 0; j < 4; ++j) { u32x2 w; w.x = pk2(v2[j][0], v2[j][1]); w.y = pk2(v2[j][2], v2[j][3]); o82[64 * j] = w; }
            if (C.lane < 16) SSP[(size_t)m2 * 16 + C.lane] = (C.lane == 0) ? s2 : 0.f; }
    }
}

constexpr int RP = 72;
__device__ __forceinline__ bf16x8 ldfrag(LAS unsigned char* lds, int base, int row, int col) { return *(const LAS bf16x8*)(lds + base + (row * RP + col) * 2); }
__device__ __forceinline__ bf16x8 ldfrag2(LAS unsigned char* lds, int base, int pitch, int row, int c0, int c1) {
    const u32x2 lo = *(const LAS u32x2*)(lds + base + (row * pitch + c0) * 2), hi = *(const LAS u32x2*)(lds + base + (row * pitch + c1) * 2);
    const u32x4 w = (u32x4){lo.x, lo.y, hi.x, hi.y}; return __builtin_bit_cast(bf16x8, w);
}
__device__ __forceinline__ bf16x8 ldfrag_lo(LAS unsigned char* lds, int base, int pitch, int row, int c0) {
    const u32x2 lo = *(const LAS u32x2*)(lds + base + (row * pitch + c0) * 2); const u32x4 w = (u32x4){lo.x, lo.y, 0u, 0u}; return __builtin_bit_cast(bf16x8, w);
}
__device__ __forceinline__ bf16x8 mkfrag(const f32x4 lo, const f32x4 hi) { const u32x4 w = (u32x4){pg8::cvt_pk_bf16(lo[0], lo[1]), pg8::cvt_pk_bf16(lo[2], lo[3]), pg8::cvt_pk_bf16(hi[0], hi[1]), pg8::cvt_pk_bf16(hi[2], hi[3])}; return __builtin_bit_cast(bf16x8, w); }
__device__ __forceinline__ bf16x8 mkfrag_lo(const f32x4 lo) { const u32x4 w = (u32x4){pg8::cvt_pk_bf16(lo[0], lo[1]), pg8::cvt_pk_bf16(lo[2], lo[3]), 0u, 0u}; return __builtin_bit_cast(bf16x8, w); }
#define MFMA16(a, b, c) __builtin_amdgcn_mfma_f32_16x16x32_bf16((a), (b), (c), 0, 0, 0)
#define DPP_ADD(v, ctrl) (v) += __int_as_float(__builtin_amdgcn_mov_dpp(__float_as_int(v), (ctrl), 0xF, 0xF, true))
__device__ __forceinline__ float wave_sum_dpp(float v) {
    DPP_ADD(v, 0xB1); DPP_ADD(v, 0x4E); DPP_ADD(v, 0x141); DPP_ADD(v, 0x140);
    { auto p = __builtin_amdgcn_permlane16_swap(__float_as_uint(v), __float_as_uint(v), false, false); v = __uint_as_float(p[0]) + __uint_as_float(p[1]); }
    { auto p = __builtin_amdgcn_permlane32_swap(__float_as_uint(v), __float_as_uint(v), false, false); v = __uint_as_float(p[0]) + __uint_as_float(p[1]); }
    return v;
}
__device__ __forceinline__ u32x4 widen_pair(const u32x2 a, const u32x2 b) {
    auto rx = __builtin_amdgcn_permlane16_swap(a.x, b.x, false, false); auto ry = __builtin_amdgcn_permlane16_swap(a.y, b.y, false, false);
    return (u32x4){rx[0], ry[0], rx[1], ry[1]};
}
__device__ __forceinline__ int pair_coff(int q) { return (q & 1) ? 16 + 4 * (q - 1) : 4 * q; }
constexpr int GP_ = 72;
__device__ __forceinline__ void gla_decay(const Ctx& C, CArgs& a, const bf16_t* P, int tok0, int h, LAS float* TOT, float (&bv)[8], float& total) {
    const int col = h * 64 + C.lane; const float ba = a.in[I_GLA_B_ALPHA][col];
    float z[8];
#pragma unroll
    for (int i = 0; i < 8; ++i) z[i] = ldbf(P + (size_t)(tok0 + 8 * C.wave + i) * NP + EC_Z + col);
    float pre = 0.f;
#pragma unroll
    for (int i = 0; i < 8; ++i) { pre += logsigmoidf_(z[i] + ba) * (1.0f / 16.0f); bv[i] = pre; }
    TOT[C.wave * 64 + C.lane] = pre;
    __syncthreads();
    float off = 0.f, tot = 0.f;
#pragma unroll
    for (int w = 0; w < 8; ++w) { const float tv = TOT[w * 64 + C.lane]; tot += tv; if (w < C.wave) off += tv; }
#pragma unroll
    for (int i = 0; i < 8; ++i) bv[i] += off;
    total = tot;
}
__device__ __forceinline__ void gla_load_vt(const Ctx& C, const bf16_t* P, int tok0, int h, LAS unsigned char* VT) {
    unsigned lo[4], hi[4];
#pragma unroll
    for (int i = 0; i < 8; ++i) { const bf16_t* pr = P + (size_t)(tok0 + 8 * C.wave + i) * NP + EC_V + h * 128 + C.lane; const unsigned x0 = pr[0], x1 = pr[64];
        if (i & 1) { lo[i >> 1] |= x0 << 16; hi[i >> 1] |= x1 << 16; } else { lo[i >> 1] = x0; hi[i >> 1] = x1; } }
    *(LAS u32x4*)(VT + (C.lane * GP_ + 8 * C.wave) * 2) = (u32x4){lo[0], lo[1], lo[2], lo[3]};
    *(LAS u32x4*)(VT + ((C.lane + 64) * GP_ + 8 * C.wave) * 2) = (u32x4){hi[0], hi[1], hi[2], hi[3]};
}
__device__ __forceinline__ void gla_a_unit(const Ctx& C, CArgs& a, int uid, f32x4 (&Srun)[4], float& dprod) {
    const int h = uid & 3, n = (uid >> 2) & 127, b = uid >> 9, tok0 = b * SEQ + n * 64;
    const bf16_t* P = (const bf16_t*)(a.ws + WS_P);
    LAS unsigned char* lds = C.lds; constexpr int L_VT_ = 0, L_KST_ = 128 * GP_ * 2, L_TOT_ = L_KST_ + 64 * GP_ * 2, L_DLS_ = L_TOT_ + 2048;
    const int q = C.lane >> 4, li = C.lane & 15, w = C.wave;
    float kv[8];
#pragma unroll
    for (int i = 0; i < 8; ++i) kv[i] = ldbf(P + (size_t)(tok0 + 8 * w + i) * NP + EC_K + h * 64 + C.lane);
    gla_load_vt(C, P, tok0, h, lds + L_VT_);
    float bv[8], total;
    gla_decay(C, a, P, tok0, h, (LAS float*)(lds + L_TOT_), bv, total);
    { unsigned o[4];
#pragma unroll
      for (int i = 0; i < 8; ++i) { const unsigned x = f2bf(kv[i] * __expf(total - bv[i])); if (i & 1) o[i >> 1] |= x << 16; else o[i >> 1] = x; }
      *(LAS u32x4*)(lds + L_KST_ + (C.lane * GP_ + 8 * w) * 2) = (u32x4){o[0], o[1], o[2], o[3]}; }
    const int ug = (b * 4 + h) * 128 + n;
    const float dl = __expf(total);
    if (w == 0) { ((float*)(a.ws + WS_GLA_DL))[ug * 64 + C.lane] = dprod; ((LAS float*)(lds + L_DLS_))[C.lane] = dl; }
    dprod *= dl;
    __syncthreads();
    bf16_t* ST = (bf16_t*)(a.ws + WS_GLA_ST) + (size_t)ug * 8192;
    const bf16x8 v0 = *(const LAS bf16x8*)(lds + L_VT_ + ((16 * w + li) * GP_ + 8 * q) * 2), v1 = *(const LAS bf16x8*)(lds + L_VT_ + ((16 * w + li) * GP_ + 32 + 8 * q) * 2);
    u32x2 sw[4];
#pragma unroll
    for (int dt = 0; dt < 4; ++dt) { f32x4 c4 = (f32x4){0.f, 0.f, 0.f, 0.f};
        c4 = MFMA16(*(const LAS bf16x8*)(lds + L_KST_ + ((16 * dt + li) * GP_ + 8 * q) * 2), v0, c4); c4 = MFMA16(*(const LAS bf16x8*)(lds + L_KST_ + ((16 * dt + li) * GP_ + 32 + 8 * q) * 2), v1, c4);
        sw[dt] = (u32x2){pg8::cvt_pk_bf16(Srun[dt][0], Srun[dt][1]), pg8::cvt_pk_bf16(Srun[dt][2], Srun[dt][3])};
        const f32x4 dl4 = *(const LAS f32x4*)(lds + L_DLS_ + (16 * dt + 4 * q) * 4);
        Srun[dt] = Srun[dt] * dl4 + c4; }
    { bf16_t* srow = ST + (16 * w + li) * 64 + pair_coff(q); *(u32x4*)(srow) = widen_pair(sw[0], sw[1]); *(u32x4*)(srow + 32) = widen_pair(sw[2], sw[3]); }
    __syncthreads();
}
__device__ __forceinline__ void gla_a_group(LAS unsigned char* ldsb, CArgs& a, int gidx) {
    const int bh = gidx >> 4, g = gidx & 15, b = bh >> 2, h = bh & 3;
    f32x4 Srun[4]; float dprod = 1.f;
#pragma unroll
    for (int dt = 0; dt < 4; ++dt) Srun[dt] = (f32x4){0.f, 0.f, 0.f, 0.f};
#pragma unroll 1
    for (int j = 0; j < 8; ++j) { const Ctx Cu = mk_ctx(ldsb); gla_a_unit(Cu, a, (b << 9) | ((8 * g + j) << 2) | h, Srun, dprod); }
    const Ctx C = mk_ctx(ldsb); const int q = C.lane >> 4, li = C.lane & 15, w = C.wave;
    bf16_t* GL = (bf16_t*)(a.ws + WS_GLA_GL) + (size_t)gidx * 8192;
#pragma unroll
    for (int dt = 0; dt < 4; ++dt) *(u32x2*)(GL + (16 * w + li) * 64 + 16 * dt + 4 * q) = (u32x2){pg8::cvt_pk_bf16(Srun[dt][0], Srun[dt][1]), pg8::cvt_pk_bf16(Srun[dt][2], Srun[dt][3])};
    if (w == 0) ((float*)(a.ws + WS_GLA_GD))[gidx * 64 + C.lane] = dprod;
}
struct GlaCRaw { unsigned q[8], k[8], z[8], v0[8], v1[8]; u32x4 st[2]; f32x4 dc0, dc1; u32x2 gw[4]; };
__device__ __forceinline__ void gla_c_issue(const Ctx& C, CArgs& a, int uid, GlaCRaw& R) {
    const int h = uid & 3, n = (uid >> 2) & 127, b = uid >> 9, tok0 = b * SEQ + n * 64, ug = (b * 4 + h) * 128 + n;
    const bf16_t* P = (const bf16_t*)(a.ws + WS_P); const int q = C.lane >> 4, li = C.lane & 15, w = C.wave;
#pragma unroll
    for (int i = 0; i < 8; ++i) { const bf16_t* pr = P + (size_t)(tok0 + 8 * w + i) * NP + C.lane;
        R.q[i] = pr[EC_Q + h * 64]; R.k[i] = pr[EC_K + h * 64]; R.z[i] = pr[EC_Z + h * 64]; R.v0[i] = pr[EC_V + h * 128]; R.v1[i] = pr[EC_V + h * 128 + 64]; }
    { const u32x4* ST = (const u32x4*)((const bf16_t*)(a.ws + WS_GLA_ST) + (size_t)ug * 8192); R.st[0] = ST[C.tid]; R.st[1] = ST[C.tid + 512];
      const f32x4* dcp = (const f32x4*)((const float*)(a.ws + WS_GLA_DL) + (size_t)ug * 64 + 8 * (C.tid & 7)); R.dc0 = dcp[0]; R.dc1 = dcp[1]; }
#pragma unroll
    for (int vt = 0; vt < 4; ++vt) R.gw[vt] = *(const u32x2*)(P + (size_t)(tok0 + 16 * (w & 3) + li) * NP + EC_G + h * 128 + 16 * (4 * (w >> 2) + vt) + 4 * q);
}
__device__ __forceinline__ void gla_c_unit(const Ctx& C, CArgs& a, int uid, int next_uid, const float (&carry)[2][8], GlaCRaw& R) {
    const int h = uid & 3, n = (uid >> 2) & 127, b = uid >> 9, tok0 = b * SEQ + n * 64;
    LAS unsigned char* lds = C.lds;
    constexpr int L_VT_ = 0, L_SB_ = 128 * GP_ * 2, L_QD_ = 2 * 128 * GP_ * 2, L_KD_ = L_QD_ + 64 * GP_ * 2, L_TOT_ = L_KD_ + 64 * GP_ * 2, L_PS_ = L_TOT_ + 2048;
    const int q = C.lane >> 4, li = C.lane & 15, w = C.wave;
    u32x2 gwv[4]; f32x4 gnv[4];
#pragma unroll
    for (int vt = 0; vt < 4; ++vt) { gwv[vt] = R.gw[vt]; gnv[vt] = *(const f32x4*)(a.in[I_GLA_NORM] + h * 128 + 16 * (4 * (w >> 2) + vt) + 4 * q); }
    const float ba = a.in[I_GLA_B_ALPHA][h * 64 + C.lane];
    { const int d8 = C.tid & 7;
#pragma unroll
      for (int k = 0; k < 2; ++k) { const int p = C.tid + 512 * k, v = p >> 3; float f[8]; unpack8(R.st[k], f);
#pragma unroll
          for (int e = 0; e < 8; ++e) f[e] += carry[k][e] * (e < 4 ? R.dc0[e] : R.dc1[e - 4]);
          *(LAS u32x4*)(lds + L_SB_ + (v * GP_ + 8 * d8) * 2) = (u32x4){pg8::cvt_pk_bf16(f[0], f[1]), pg8::cvt_pk_bf16(f[2], f[3]), pg8::cvt_pk_bf16(f[4], f[5]), pg8::cvt_pk_bf16(f[6], f[7])}; } }
    *(LAS u32x4*)(lds + L_VT_ + (C.lane * GP_ + 8 * w) * 2) = (u32x4){R.v0[0] | (R.v0[1] << 16), R.v0[2] | (R.v0[3] << 16), R.v0[4] | (R.v0[5] << 16), R.v0[6] | (R.v0[7] << 16)};
    *(LAS u32x4*)(lds + L_VT_ + ((C.lane + 64) * GP_ + 8 * w) * 2) = (u32x4){R.v1[0] | (R.v1[1] << 16), R.v1[2] | (R.v1[3] << 16), R.v1[4] | (R.v1[5] << 16), R.v1[6] | (R.v1[7] << 16)};
    float bv[8]; { LAS float* TOT = (LAS float*)(lds + L_TOT_); float pre = 0.f;
#pragma unroll
      for (int i = 0; i < 8; ++i) { pre += logsigmoidf_(bf2f(R.z[i]) + ba) * (1.0f / 16.0f); bv[i] = pre; }
      TOT[w * 64 + C.lane] = pre;
      __syncthreads();
      float off = 0.f;
#pragma unroll
      for (int ww = 0; ww < 8; ++ww) { const float tv = TOT[ww * 64 + C.lane]; if (ww < w) off += tv; }
#pragma unroll
      for (int i = 0; i < 8; ++i) bv[i] += off; }
#pragma unroll
    for (int i = 0; i < 8; ++i) { const int t = 8 * w + i;
        *((LAS bf16_t*)(lds + L_QD_) + t * GP_ + C.lane) = (bf16_t)f2bf(bf2f(R.q[i]) * 0.125f * __expf(bv[i]));
        *((LAS bf16_t*)(lds + L_KD_) + t * GP_ + C.lane) = (bf16_t)f2bf(bf2f(R.k[i]) * __expf(-bv[i])); }
    if (next_uid >= 0) gla_c_issue(C, a, next_uid, R);
    __syncthreads();
    const int ct = w & 3, vh = w >> 2;
    const bf16x8 qf0 = *(const LAS bf16x8*)(lds + L_QD_ + ((16 * ct + li) * GP_ + 8 * q) * 2), qf1 = *(const LAS bf16x8*)(lds + L_QD_ + ((16 * ct + li) * GP_ + 32 + 8 * q) * 2);
    f32x4 at[4];
#pragma unroll
    for (int st = 0; st < 4; ++st) { at[st] = (f32x4){0.f, 0.f, 0.f, 0.f};
        if (st <= ct) { at[st] = MFMA16(*(const LAS bf16x8*)(lds + L_KD_ + ((16 * st + li) * GP_ + 8 * q) * 2), qf0, at[st]); at[st] = MFMA16(*(const LAS bf16x8*)(lds + L_KD_ + ((16 * st + li) * GP_ + 32 + 8 * q) * 2), qf1, at[st]);
#pragma unroll
            for (int r = 0; r < 4; ++r) if (16 * st + 4 * q + r > 16 * ct + li) at[st][r] = 0.f; } }
    const bf16x8 ab0 = mkfrag(at[0], at[1]), ab1 = mkfrag(at[2], at[3]);
    f32x4 o[4]; float ss = 0.f;
#pragma unroll
    for (int vt = 0; vt < 4; ++vt) { const int vrow = 16 * (4 * vh + vt) + li; f32x4 c4 = (f32x4){0.f, 0.f, 0.f, 0.f};
        c4 = MFMA16(ldfrag2(lds, L_VT_, GP_, vrow, 4 * q, 16 + 4 * q), ab0, c4);
        if (ct >= 2) c4 = MFMA16(ldfrag2(lds, L_VT_, GP_, vrow, 32 + 4 * q, 48 + 4 * q), ab1, c4);
        c4 = MFMA16(*(const LAS bf16x8*)(lds + L_SB_ + (vrow * GP_ + 8 * q) * 2), qf0, c4); c4 = MFMA16(*(const LAS bf16x8*)(lds + L_SB_ + (vrow * GP_ + 32 + 8 * q) * 2), qf1, c4);
        o[vt] = c4; ss += (c4[0] * c4[0] + c4[1] * c4[1]) + (c4[2] * c4[2] + c4[3] * c4[3]); }
    { auto p1 = __builtin_amdgcn_permlane16_swap(__float_as_uint(ss), __float_as_uint(ss), false, false); ss = __uint_as_float(p1[0]) + __uint_as_float(p1[1]);
      auto p2 = __builtin_amdgcn_permlane32_swap(__float_as_uint(ss), __float_as_uint(ss), false, false); ss = __uint_as_float(p2[0]) + __uint_as_float(p2[1]); }
    LAS float* PS = (LAS float*)(lds + L_PS_);
    if (q == 0) PS[(16 * ct + li) * 2 + vh] = ss;
    __syncthreads();
    const float tot = PS[(16 * ct + li) * 2] + PS[(16 * ct + li) * 2 + 1];
    const float rstd = 1.0f / sqrtf(tot * (1.0f / 128.0f) + RMS_EPS);
    const size_t m = (size_t)(tok0 + 16 * ct + li);
    u32x2 ow[4];
#pragma unroll
    for (int vt = 0; vt < 4; ++vt) {
        const u32x2 gw = gwv[vt]; const f32x4 gn = gnv[vt];
        const f32x4 gvv = (f32x4){bf2f(gw.x & 0xffffu), __uint_as_float(gw.x & 0xffff0000u), bf2f(gw.y & 0xffffu), __uint_as_float(gw.y & 0xffff0000u)};
        f32x4 r4;
#pragma unroll
        for (int e = 0; e < 4; ++e) r4[e] = o[vt][e] * rstd * gn[e] * silu_fast(gvv[e]);
        ow[vt] = (u32x2){pg8::cvt_pk_bf16(r4[0], r4[1]), pg8::cvt_pk_bf16(r4[2], r4[3])}; }
    { bf16_t* orow = (bf16_t*)(a.ws + WS_MIX) + m * D + h * 128 + 64 * vh + pair_coff(q);
      *(u32x4*)(orow) = widen_pair(ow[0], ow[1]); *(u32x4*)(orow + 32) = widen_pair(ow[2], ow[3]); }
    __syncthreads();
}
__device__ __forceinline__ void gla_c_group(LAS unsigned char* ldsb, CArgs& a, int gidx) {
    const int bh = gidx >> 4, g = gidx & 15, b = bh >> 2, h = bh & 3;
    float carry[2][8], prod[8]; GlaCRaw R;
    { const Ctx C = mk_ctx(ldsb); const int d8 = C.tid & 7;
      gla_c_issue(C, a, (b << 9) | ((8 * g) << 2) | h, R);
#pragma unroll
      for (int e = 0; e < 8; ++e) { carry[0][e] = 0.f; carry[1][e] = 0.f; prod[e] = 1.f; }
      for (int j0 = g - 1; j0 >= 0; j0 -= 4) {
          u32x4 l0[4], l1[4]; f32x4 da[4], db[4];
#pragma unroll
          for (int x = 0; x < 4; ++x) { const int j = j0 - x; if (j >= 0) { const int gj = (bh << 4) | j; const u32x4* GL = (const u32x4*)((const bf16_t*)(a.ws + WS_GLA_GL) + (size_t)gj * 8192); l0[x] = GL[C.tid]; l1[x] = GL[C.tid + 512];
                  const f32x4* gd = (const f32x4*)((const float*)(a.ws + WS_GLA_GD) + gj * 64 + 8 * d8); da[x] = gd[0]; db[x] = gd[1]; } }
#pragma unroll
          for (int x = 0; x < 4; ++x) { const int j = j0 - x; if (j >= 0) { float f0[8], f1[8]; unpack8(l0[x], f0); unpack8(l1[x], f1);
#pragma unroll
                  for (int e = 0; e < 8; ++e) { carry[0][e] += f0[e] * prod[e]; carry[1][e] += f1[e] * prod[e]; prod[e] *= (e < 4 ? da[x][e] : db[x][e - 4]); } } }
      } }
#pragma unroll 1
    for (int j = 0; j < 8; ++j) { const Ctx Cu = mk_ctx(ldsb); gla_c_unit(Cu, a, (b << 9) | ((8 * g + j) << 2) | h, j < 7 ? ((b << 9) | ((8 * g + j + 1) << 2) | h) : -1, carry, R); }
}
__device__ __forceinline__ float gelu_fast(float x) { const float u = 1.5957691216057308f * (x + 0.044715f * x * x * x); return x * fsigmoid(u); }
__device__ __forceinline__ void sgu_unit(const Ctx& C, CArgs& a, int uid) {
    const int tok0 = uid * 128;
    const bf16_t* P = (const bf16_t*)(a.ws + WS_P); bf16_t* MIX = (bf16_t*)(a.ws + WS_MIX);
    LAS unsigned char* lds = C.lds;
    constexpr int SP = 136, L_WL = 0, L_VHT = 128 * SP * 2, L_STS = 2 * 128 * SP * 2;
    LAS float* STS = (LAS float*)(lds + L_STS);
    const int q = C.lane >> 4, li = C.lane & 15, w = C.wave;
    u32x4 wr[4], sr[4];
#define SGU_ISSUE(g_) do { const unsigned char* wsrc_ = a.ws + WS_TAB + TAB_SGUW + (size_t)(g_) * 32768; \
        _Pragma("unroll") for (int k = 0; k < 4; ++k) { const int p_ = C.tid + 512 * k; wr[k] = *(const u32x4*)(wsrc_ + p_ * 16); } \
        _Pragma("unroll") for (int k = 0; k < 4; ++k) { const int it_ = C.tid + 512 * k, sx_ = it_ >> 4, c8_ = it_ & 15; sr[k] = *(const u32x4*)(P + (size_t)(tok0 + sx_) * NP + EC_SV + (g_) * 128 + 8 * c8_); } } while (0)
    { u32x4 st[16];
#pragma unroll
      for (int i = 0; i < 16; ++i) st[i] = *(const u32x4*)(P + (size_t)(tok0 + 16 * w + i) * NP + EC_SV + 8 * C.lane);
      SGU_ISSUE(0);
#pragma unroll
      for (int i = 0; i < 16; ++i) { const int t = 16 * w + i; float f[8]; unpack8(st[i], f); float s = 0.f;
#pragma unroll
        for (int j = 0; j < 8; ++j) { f[j] = gelu_fast(f[j]); s += f[j]; }
        const float mean = wave_sum_dpp(s) * (1.0f / 512.0f); float qq = 0.f;
#pragma unroll
        for (int j = 0; j < 8; ++j) { const float d = f[j] - mean; qq += d * d; }
        const float var = wave_sum_dpp(qq) * (1.0f / 512.0f);
        if (C.lane == 0) { STS[2 * t] = mean; STS[2 * t + 1] = 1.0f / sqrtf(var + LN_EPS); } } }
    __syncthreads();
#pragma unroll 1
    for (int g = 0; g < 4; ++g) {
#pragma unroll
        for (int k = 0; k < 4; ++k) { const int p = C.tid + 512 * k, row = p >> 4, c16 = p & 15; *(LAS u32x4*)(lds + L_WL + row * (SP * 2) + c16 * 16) = wr[k]; }
#pragma unroll
        for (int k = 0; k < 4; ++k) { const int it = C.tid + 512 * k, sx = it >> 4, c8 = it & 15; float f[8]; unpack8(sr[k], f);
            const float mean = STS[2 * sx], rstd = STS[2 * sx + 1]; const float* lg = a.in[I_SGU_LN_G] + g * 128 + 8 * c8; const float* lb = a.in[I_SGU_LN_B] + g * 128 + 8 * c8;
            const int sxs = (sx & 7) | ((((sx >> 3) ^ ((c8 >> 1) & 7))) << 3);
#pragma unroll
            for (int j = 0; j < 8; ++j) *((LAS bf16_t*)(lds + L_VHT) + (8 * c8 + j) * SP + sxs) = (bf16_t)f2bf((gelu_fast(f[j]) - mean) * rstd * lg[j] + lb[j]); }
        const int ct4 = w >> 2;
        u32x2 uu[2][4]; float bias2[2];
#pragma unroll
        for (int tp = 0; tp < 2; ++tp) { const int tt = tp == 0 ? (w & 3) : 7 - (w & 3); const size_t m = (size_t)(tok0 + 16 * tt + li); bias2[tp] = a.in[I_SGU_B][g * 128 + 16 * tt + li];
#pragma unroll
            for (int ct = 0; ct < 4; ++ct) uu[tp][ct] = *(const u32x2*)(P + m * NP + EC_U + g * 128 + 16 * (4 * ct4 + ct) + 4 * q); }
        if (g < 3) SGU_ISSUE(g + 1);
        __syncthreads();
#pragma unroll
        for (int tp = 0; tp < 2; ++tp) { const int tt = tp == 0 ? (w & 3) : 7 - (w & 3); const int nks = (tt + 2) >> 1;
            bf16x8 wf[4];
#pragma unroll
            for (int ks = 0; ks < 4; ++ks) if (ks < nks) wf[ks] = *(const LAS bf16x8*)(lds + L_WL + ((16 * tt + li) * SP + 32 * ks + 8 * q) * 2);
            const size_t m = (size_t)(tok0 + 16 * tt + li); const float bias = bias2[tp];
            u32x2 ow[4];
#pragma unroll
            for (int ct = 0; ct < 4; ++ct) { const int ctile = 4 * ct4 + ct; f32x4 acc = (f32x4){0.f, 0.f, 0.f, 0.f};
#pragma unroll
                for (int ks = 0; ks < 4; ++ks) if (ks < nks) acc = MFMA16(*(const LAS bf16x8*)(lds + L_VHT + ((16 * ctile + li) * SP + 8 * ((4 * ks + q) ^ (ctile & 7))) * 2), wf[ks], acc);
                const u32x2 uw = uu[tp][ct];
                const f32x4 uv = (f32x4){bf2f(uw.x & 0xffffu), __uint_as_float(uw.x & 0xffff0000u), bf2f(uw.y & 0xffffu), __uint_as_float(uw.y & 0xffff0000u)};
                f32x4 o;
#pragma unroll
                for (int e = 0; e < 4; ++e) o[e] = (acc[e] + bias) * gelu_fast(uv[e]);
                ow[ct] = (u32x2){pg8::cvt_pk_bf16(o[0], o[1]), pg8::cvt_pk_bf16(o[2], o[3])}; }
            { bf16_t* orow = MIX + m * D + 512 + g * 128 + 64 * ct4 + pair_coff(q);
              *(u32x4*)(orow) = widen_pair(ow[0], ow[1]); *(u32x4*)(orow + 32) = widen_pair(ow[2], ow[3]); } }
        __syncthreads();
    }
#undef SGU_ISSUE
}

__device__ __forceinline__ float lerp_tok(const bf16_t* P, size_t m, int col, float mu) {
    const float cur = ldbf(P + m * NP + col); const float prev = ((m & (SEQ - 1)) != 0) ? ldbf(P + (m - 1) * NP + col) : 0.f;
    return cur + (prev - cur) * mu;
}
constexpr int CV_ZR = 118;
__device__ __forceinline__ void conv_unit(const Ctx& C, CArgs& a, int b, int t0, int T) {
    const size_t mb = (size_t)b * SEQ; const int nrows = T + 30;
    const bf16_t* P = (const bf16_t*)(a.ws + WS_P); bf16_t* MIX = (bf16_t*)(a.ws + WS_MIX);
    LAS bf16_t* Z = (LAS bf16_t*)C.lds; LAS float* YG = (LAS float*)(C.lds + CV_ZR * 512 * 2);
    static_assert(CV_ZR * 1024 + 8 * 512 * 4 <= LDS_BYTES - 64, "conv LDS");
    u32x4 wa[2][3], wg[2][3];
#define CV_ISSUE(bt_) do { _Pragma("unroll") for (int k = 0; k < 3; ++k) { const int i = C.tid + 512 * (3 * (bt_) + k); const int j = i >> 6, c8 = i & 63, t = t0 - 30 + j; \
            wa[(bt_) & 1][k] = (u32x4){0u, 0u, 0u, 0u}; wg[(bt_) & 1][k] = (u32x4){0u, 0u, 0u, 0u}; \
            if (j < nrows && t >= 0) { const bf16_t* pr = P + (mb + t) * NP; wa[(bt_) & 1][k] = __builtin_nontemporal_load((const u32x4*)(pr + OC_CA + 8 * c8)); wg[(bt_) & 1][k] = __builtin_nontemporal_load((const u32x4*)(pr + OC_CG + 8 * c8)); } } } while (0)
    CV_ISSUE(0);
#pragma unroll
    for (int bt = 0; bt < 5; ++bt) {
        if (bt < 4) CV_ISSUE(bt + 1);
#pragma unroll
        for (int k = 0; k < 3; ++k) { const int i = C.tid + 512 * (3 * bt + k); const int j = i >> 6, c8 = i & 63;
            if (j < nrows) { float fa[8], fg[8]; unpack8(wa[bt & 1][k], fa); unpack8(wg[bt & 1][k], fg); u32x4 o;
                o.x = pk2(fa[0] * fsigmoid(fg[0]), fa[1] * fsigmoid(fg[1])); o.y = pk2(fa[2] * fsigmoid(fg[2]), fa[3] * fsigmoid(fg[3]));
                o.z = pk2(fa[4] * fsigmoid(fg[4]), fa[5] * fsigmoid(fg[5])); o.w = pk2(fa[6] * fsigmoid(fg[6]), fa[7] * fsigmoid(fg[7]));
                *(LAS u32x4*)(Z + j * 512 + 8 * c8) = o; } }
    }
#undef CV_ISSUE
    __syncthreads();
    const int c = C.tid; float w[31];
    { const f32x4* wp = (const f32x4*)((const float*)(a.ws + WS_TAB + TAB_CWT) + c * 32);
#pragma unroll
      for (int j = 0; j < 8; ++j) { const f32x4 v = wp[j]; w[4 * j] = v[0]; w[4 * j + 1] = v[1]; w[4 * j + 2] = v[2]; if (j < 7) w[4 * j + 3] = v[3]; } }
    const float cb = a.in[I_CONV_B][c];
    f32x4 lg0 = *(const f32x4*)(a.in[I_CONV_LN_G] + 8 * C.lane), lg1 = *(const f32x4*)(a.in[I_CONV_LN_G] + 8 * C.lane + 4), lb0 = *(const f32x4*)(a.in[I_CONV_LN_B] + 8 * C.lane), lb1 = *(const f32x4*)(a.in[I_CONV_LN_B] + 8 * C.lane + 4);
    const int ngrp = (T + 7) >> 3;
#pragma unroll 1
    for (int grp = 0; grp < ngrp; ++grp) {
        float zw[38];
#pragma unroll
        for (int j = 0; j < 38; ++j) zw[j] = bf2f((unsigned)Z[(8 * grp + j) * 512 + c]);
#pragma unroll
        for (int q = 0; q < 8; ++q) { float y = cb;
#pragma unroll
            for (int j = 0; j < 31; ++j) y += w[j] * zw[q + j];
            YG[q * 512 + c] = y; }
        __syncthreads();
        if (8 * grp + C.wave < T) { const int tk = C.wave;
          const f32x4 v0 = *(const LAS f32x4*)(YG + tk * 512 + 8 * C.lane), v1 = *(const LAS f32x4*)(YG + tk * 512 + 8 * C.lane + 4);
          const float s = ((v0[0] + v0[1]) + (v0[2] + v0[3])) + ((v1[0] + v1[1]) + (v1[2] + v1[3]));
          const float mean = wave_sum_dpp(s) * (1.0f / 512.0f);
          const f32x4 d0 = v0 - mean, d1 = v1 - mean;
          const float q2 = ((d0[0] * d0[0] + d0[1] * d0[1]) + (d0[2] * d0[2] + d0[3] * d0[3])) + ((d1[0] * d1[0] + d1[1] * d1[1]) + (d1[2] * d1[2] + d1[3] * d1[3]));
          const float rstd = 1.0f / sqrtf(wave_sum_dpp(q2) * (1.0f / 512.0f) + LN_EPS);
          const size_t m = mb + t0 + 8 * grp + tk;
          const f32x4 o0 = d0 * rstd * lg0 + lb0, o1 = d1 * rstd * lg1 + lb1;
          u32x4 ow; ow.x = pk2(silu_fast(o0[0]), silu_fast(o0[1])); ow.y = pk2(silu_fast(o0[2]), silu_fast(o0[3])); ow.z = pk2(silu_fast(o1[0]), silu_fast(o1[1])); ow.w = pk2(silu_fast(o1[2]), silu_fast(o1[3]));
          *(u32x4*)(MIX + m * D + 512 + 8 * C.lane) = ow; }
        __syncthreads();
    }
}
constexpr int RMAT = 64 * RP * 2;
constexpr int L_PT = 0, L_RT = RMAT, L_BH = 2 * RMAT, L_KH = 3 * RMAT, L_BT = 4 * RMAT, L_KT = 5 * RMAT, L_VT = 6 * RMAT, L_NAPB = 7 * RMAT, L_NAPK = 8 * RMAT,
              L_ARB = 9 * RMAT, L_ARK = 10 * RMAT, L_WMT = 11 * RMAT, L_U0T = 12 * RMAT, L_BV = 13 * RMAT, L_AII = 14 * RMAT, L_TII = L_AII + 4096, L_REND = L_TII + 2560;
constexpr int L_TOT = L_AII;
constexpr int L_XWB = L_RT, L_XAB = L_RT + 5120, L_XWO = L_KH, L_XAO = L_NAPB;
constexpr int L_RAW = L_ARK, L_XRAW = L_PT;
static_assert(L_RAW + 65 * 192 * 2 <= L_BV && 65 * 64 * 2 <= RMAT, "raw tiles");
static_assert(L_REND <= LDS_BYTES - 64, "rwkv LDS map");
struct PrepK { float w0; f32x4 mx0, mx1; f32x4 m0v, m1v, k0v, k1v, v0v, v1v, a0a, a0b, ks0, ks1, ka0, ka1, rk0, rk1; bf16x8 lrf[4]; int colb, ldsb, rstride; };
__device__ __forceinline__ void prep_load_consts(const Ctx& C, CArgs& a, int h, PrepK& K) {
    const float* mu = a.in[I_RWKV_MU]; const int q = C.lane >> 4, li = C.lane & 15, w = C.wave;
    K.w0 = a.in[I_RWKV_W0][h * 64 + C.lane];
    const int g8 = C.tid & 7; K.mx0 = *(const f32x4*)(mu + 1536 + 8 * g8); K.mx1 = *(const f32x4*)(mu + 1536 + 8 * g8 + 4);
    const int chB = h * 64 + 8 * (C.tid & 7);
    K.m0v = *(const f32x4*)(mu + chB); K.m1v = *(const f32x4*)(mu + chB + 4); K.k0v = *(const f32x4*)(mu + 512 + chB); K.k1v = *(const f32x4*)(mu + 512 + chB + 4); K.v0v = *(const f32x4*)(mu + 1024 + chB); K.v1v = *(const f32x4*)(mu + 1024 + chB + 4);
    K.a0a = *(const f32x4*)(a.in[I_RWKV_A0] + chB); K.a0b = *(const f32x4*)(a.in[I_RWKV_A0] + chB + 4);
    K.ks0 = *(const f32x4*)(a.in[I_RWKV_K_K] + chB); K.ks1 = *(const f32x4*)(a.in[I_RWKV_K_K] + chB + 4); K.ka0 = *(const f32x4*)(a.in[I_RWKV_K_A] + chB); K.ka1 = *(const f32x4*)(a.in[I_RWKV_K_A] + chB + 4);
    K.rk0 = *(const f32x4*)(a.in[I_RWKV_R_K] + chB); K.rk1 = *(const f32x4*)(a.in[I_RWKV_R_K] + chB + 4);
    { const bf16_t* tb = (const bf16_t*)(a.ws + WS_TAB + ((w >> 2) == 0 ? TAB_W2TB : TAB_A2TB)) + (size_t)(h * 64 + li) * 32 + 8 * q;
#pragma unroll
      for (int nt = 0; nt < 4; ++nt) K.lrf[nt] = *(const bf16x8*)(tb + nt * 16 * 32); }
    const int p = C.tid & 31;
    K.colb = p < 24 ? (p >> 3) * 512 + h * 64 + 8 * (p & 7) : OC_XW + 8 * (p - 24);
    K.ldsb = p < 24 ? L_RAW + ((p >> 3) * 64 + 8 * (p & 7)) * 2 : L_XRAW + 8 * (p - 24) * 2;
    K.rstride = p < 24 ? 384 : 128;
}
__device__ __forceinline__ void prep_load_raw(const Ctx& C, CArgs& a, int uid, const PrepK& K, u32x4 (&pf)[5]) {
    const int n = (uid >> 3) & 127, b = uid >> 10; const size_t m0 = (size_t)b * SEQ + n * 64;
    const bf16_t* base = (const bf16_t*)(a.ws + WS_P) + (m0 + (C.tid >> 5)) * NP + K.colb;
#pragma unroll
    for (int k = 0; k < 4; ++k) pf[k] = *(const u32x4*)(base + (size_t)(16 * k) * NP);
    pf[4] = (u32x4){0u, 0u, 0u, 0u};
    if (C.tid < 32 && n != 0) pf[4] = *(const u32x4*)((const bf16_t*)(a.ws + WS_P) + (m0 - 1) * NP + K.colb);
}
__device__ __forceinline__ void rwkv_prep_unit(const Ctx& C, CArgs& a, int uid, int next_uid, const PrepK& K, u32x4 (&pf)[5]) {
    const int h = uid & 7, n = (uid >> 3) & 127, b = uid >> 10; const size_t m0 = (size_t)b * SEQ + n * 64;
    LAS unsigned char* lds = C.lds;
    LAS float* AII = (LAS float*)(lds + L_AII);
    const int q = C.lane >> 4, li = C.lane & 15, w = C.wave;
    const float w0 = K.w0;
    const f32x4 m0v = K.m0v, m1v = K.m1v, k0v = K.k0v, k1v = K.k1v, v0v = K.v0v, v1v = K.v1v, a0a = K.a0a, a0b = K.a0b, ks0 = K.ks0, ks1 = K.ks1, ka0 = K.ka0, ka1 = K.ka1, rk0 = K.rk0, rk1 = K.rk1;
    LAS bf16_t* RAW = (LAS bf16_t*)(lds + L_RAW);
    LAS float* TOT = (LAS float*)(lds + L_TOT);
    { LAS unsigned char* dst = lds + K.ldsb + (1 + (C.tid >> 5)) * K.rstride;
#pragma unroll
      for (int k = 0; k < 4; ++k) *(LAS u32x4*)(dst + 16 * k * K.rstride) = pf[k];
      if (C.tid < 32) *(LAS u32x4*)(lds + K.ldsb) = pf[4]; }
    if (next_uid >= 0) prep_load_raw(C, a, next_uid, K, pf);
    __syncthreads();
    { const int t = C.tid >> 3, g8 = C.tid & 7; float cur[8], prv[8];
      unpack8(*(const LAS u32x4*)(lds + L_XRAW + ((t + 1) * 64 + 8 * g8) * 2), cur); unpack8(*(const LAS u32x4*)(lds + L_XRAW + (t * 64 + 8 * g8) * 2), prv);
      float o[8];
#pragma unroll
      for (int e = 0; e < 8; ++e) { const float v = cur[e] + (prv[e] - cur[e]) * (e < 4 ? K.mx0[e] : K.mx1[e - 4]); o[e] = g8 < 4 ? ftanh(v) : v; }
      *(LAS u32x4*)(lds + (g8 < 4 ? L_XWB : L_XAB) + (t * 40 + 8 * (g8 & 3)) * 2) = (u32x4){pg8::cvt_pk_bf16(o[0], o[1]), pg8::cvt_pk_bf16(o[2], o[3]), pg8::cvt_pk_bf16(o[4], o[5]), pg8::cvt_pk_bf16(o[6], o[7])}; }
    __syncthreads();
    { const int mat = w >> 2, mt = w & 3;
      const bf16x8 af = *(const LAS bf16x8*)(lds + (mat == 0 ? L_XWB : L_XAB) + ((16 * mt + li) * 40 + 8 * q) * 2);
      LAS float* xo = (LAS float*)(lds + (mat == 0 ? L_XWO : L_XAO));
#pragma unroll
      for (int nt = 0; nt < 4; ++nt) { f32x4 c4 = (f32x4){0.f, 0.f, 0.f, 0.f}; c4 = MFMA16(af, K.lrf[nt], c4);
#pragma unroll
          for (int r = 0; r < 4; ++r) xo[(16 * mt + 4 * q + r) * 64 + 16 * nt + li] = c4[r]; } }
    __syncthreads();
    {
        float gl[8];
        { const LAS float* xwo = (const LAS float*)(lds + L_XWO) + C.lane;
          float pre = 0.f;
#pragma unroll
          for (int i = 0; i < 8; ++i) { pre += -0.6065306597126334f * fsigmoid(w0 + xwo[(8 * w + i) * 64]); gl[i] = pre; }
          TOT[w * 64 + C.lane] = pre; }
        __syncthreads();
        float off = 0.f, gC = 0.f;
#pragma unroll
        for (int ww = 0; ww < 8; ++ww) { const float tv = TOT[ww * 64 + C.lane]; gC += tv; if (ww < w) off += tv; }
        if (w == 0) { ((float*)((unsigned char*)a.out + OUT_R_GC))[(size_t)uid * 64 + C.lane] = __expf(gC); TOT[512 + C.lane] = gC; }
        LAS float* G = (LAS float*)(lds + L_XWO) + C.lane;
#pragma unroll
        for (int i = 0; i < 8; ++i) G[(8 * w + i) * 64] = off + gl[i];
    }
    __syncthreads();
    {
        const int t = C.tid >> 3, c8 = C.tid & 7;
        float rr[8], kk8[8], vv[8], av[8], g[8], gp[8], gc8[8];
        { float cur[8], prv[8];
          unpack8(*(const LAS u32x4*)(RAW + (t + 1) * 192 + 8 * c8), cur); unpack8(*(const LAS u32x4*)(RAW + t * 192 + 8 * c8), prv);
#pragma unroll
          for (int e = 0; e < 8; ++e) rr[e] = cur[e] + (prv[e] - cur[e]) * (e < 4 ? m0v[e] : m1v[e - 4]);
          unpack8(*(const LAS u32x4*)(RAW + (t + 1) * 192 + 64 + 8 * c8), cur); unpack8(*(const LAS u32x4*)(RAW + t * 192 + 64 + 8 * c8), prv);
#pragma unroll
          for (int e = 0; e < 8; ++e) kk8[e] = cur[e] + (prv[e] - cur[e]) * (e < 4 ? k0v[e] : k1v[e - 4]);
          unpack8(*(const LAS u32x4*)(RAW + (t + 1) * 192 + 128 + 8 * c8), cur); unpack8(*(const LAS u32x4*)(RAW + t * 192 + 128 + 8 * c8), prv);
#pragma unroll
          for (int e = 0; e < 8; ++e) vv[e] = cur[e] + (prv[e] - cur[e]) * (e < 4 ? v0v[e] : v1v[e - 4]); }
        { const LAS f32x4* xa = (const LAS f32x4*)((const LAS float*)(lds + L_XAO) + t * 64 + 8 * c8); const f32x4 x0 = xa[0], x1 = xa[1];
#pragma unroll
          for (int e = 0; e < 4; ++e) { av[e] = fsigmoid(a0a[e] + x0[e]); av[4 + e] = fsigmoid(a0b[e] + x1[e]); }
          const LAS f32x4* gq = (const LAS f32x4*)((const LAS float*)(lds + L_XWO) + t * 64 + 8 * c8); const f32x4 g0 = gq[0], g1 = gq[1];
          f32x4 p0 = (f32x4){0.f, 0.f, 0.f, 0.f}, p1 = p0; if (t > 0) { p0 = gq[-16]; p1 = gq[-15]; }
          const LAS f32x4* gcq = (const LAS f32x4*)(TOT + 512 + 8 * c8); const f32x4 c0 = gcq[0], c1 = gcq[1];
#pragma unroll
          for (int e = 0; e < 4; ++e) { g[e] = g0[e]; g[4 + e] = g1[e]; gp[e] = p0[e]; gp[4 + e] = p1[e]; gc8[e] = c0[e]; gc8[4 + e] = c1[e]; } }
        __syncthreads();
        float kkv[8], kp[8]; float n2 = 0.f, bon = 0.f;
#pragma unroll
        for (int e = 0; e < 8; ++e) { const float kks_ = e < 4 ? ks0[e] : ks1[e - 4], ka_ = e < 4 ? ka0[e] : ka1[e - 4], rk_ = e < 4 ? rk0[e] : rk1[e - 4];
            kkv[e] = kk8[e] * kks_; n2 += kkv[e] * kkv[e]; kp[e] = kk8[e] * (1.0f + (av[e] - 1.0f) * ka_); bon += rr[e] * kp[e] * rk_; }
        DPP_ADD(n2, 0xB1); DPP_ADD(n2, 0x4E); DPP_ADD(n2, 0x141); DPP_ADD(bon, 0xB1); DPP_ADD(bon, 0x4E); DPP_ADD(bon, 0x141);
        const float rn = __builtin_amdgcn_rsqf(fmaxf(n2, 1e-24f));
        float o_pt[8], o_rt[8], o_bh[8], o_kh[8], o_bv[8];
        LAS bf16_t* BTp = (LAS bf16_t*)(lds + L_BT) + (8 * c8) * RP + t; LAS bf16_t* KTp = (LAS bf16_t*)(lds + L_KT) + (8 * c8) * RP + t; LAS bf16_t* VTp = (LAS bf16_t*)(lds + L_VT) + (8 * c8) * RP + t;
        float t_bt[8], t_kt[8];
#pragma unroll
        for (int e = 0; e < 8; ++e) { const float kn = kkv[e] * rn, bbv = kn * av[e]; const float eg = __expf(g[e]), eng = __builtin_amdgcn_rcpf(eg), egp = __expf(gp[e]), egc = __expf(gc8[e] - g[e]);
            o_pt[e] = kn * egp; o_rt[e] = rr[e] * eg; o_bh[e] = bbv * eng; o_kh[e] = kp[e] * eng; o_bv[e] = bon * vv[e]; t_bt[e] = bbv * egc; t_kt[e] = kp[e] * egc; }
#pragma unroll
        for (int e = 0; e < 8; e += 2) { const unsigned pb = pg8::cvt_pk_bf16(t_bt[e], t_bt[e + 1]), pk = pg8::cvt_pk_bf16(t_kt[e], t_kt[e + 1]), pv = pg8::cvt_pk_bf16(vv[e], vv[e + 1]);
            BTp[e * RP] = (bf16_t)(pb & 0xffffu); BTp[(e + 1) * RP] = (bf16_t)(pb >> 16); KTp[e * RP] = (bf16_t)(pk & 0xffffu); KTp[(e + 1) * RP] = (bf16_t)(pk >> 16); VTp[e * RP] = (bf16_t)(pv & 0xffffu); VTp[(e + 1) * RP] = (bf16_t)(pv >> 16); }
        const int ro = (t * RP + 8 * c8) * 2;
#define PK8(o) (u32x4){pg8::cvt_pk_bf16(o[0], o[1]), pg8::cvt_pk_bf16(o[2], o[3]), pg8::cvt_pk_bf16(o[4], o[5]), pg8::cvt_pk_bf16(o[6], o[7])}
        *(LAS u32x4*)(lds + L_PT + ro) = PK8(o_pt); *(LAS u32x4*)(lds + L_RT + ro) = PK8(o_rt); *(LAS u32x4*)(lds + L_BH + ro) = PK8(o_bh); *(LAS u32x4*)(lds + L_KH + ro) = PK8(o_kh); *(LAS u32x4*)(lds + L_BV + ro) = PK8(o_bv);
#undef PK8
    }
    __syncthreads();
    {
        const int mat = w >> 1, half = w & 1;
        const int xb = mat < 2 ? L_PT : L_RT, yb = (mat & 1) ? L_KH : L_BH;
        const int ob = mat == 0 ? L_NAPB : (mat == 1 ? L_NAPK : (mat == 2 ? L_ARB : L_ARK));
        const bool strict = mat < 2;
        auto row_tiles = [&](auto MTc) { constexpr int mt = decltype(MTc)::value;
            const bf16x8 a0f = ldfrag(lds, xb, 16 * mt + li, 8 * q), a1f = ldfrag(lds, xb, 16 * mt + li, 32 + 8 * q);
            LAS unsigned char* orow = lds + ob + ((16 * mt + li) * RP + 4 * q) * 2;
#pragma unroll
            for (int nt = 0; nt < 4; ++nt) {
                if (nt > mt) { *(LAS u32x2*)(orow + 32 * nt) = (u32x2){0u, 0u}; continue; }
                f32x4 v4 = (f32x4){0.f, 0.f, 0.f, 0.f};
                v4 = MFMA16(ldfrag(lds, yb, 16 * nt + li, 8 * q), a0f, v4); v4 = MFMA16(ldfrag(lds, yb, 16 * nt + li, 32 + 8 * q), a1f, v4);
                if (nt == mt) {
#pragma unroll
                    for (int r = 0; r < 4; ++r) { const bool keep = strict ? (4 * q + r < li) : (4 * q + r <= li); v4[r] = keep ? v4[r] : 0.f; }
                    if (mat == 0) *(LAS f32x4*)(AII + (mt * 16 + li) * 16 + 4 * q) = v4; }
                *(LAS u32x2*)(orow + 32 * nt) = strict ? (u32x2){pg8::cvt_pk_bf16(-v4[0], -v4[1]), pg8::cvt_pk_bf16(-v4[2], -v4[3])} : (u32x2){pg8::cvt_pk_bf16(v4[0], v4[1]), pg8::cvt_pk_bf16(v4[2], v4[3])}; } };
        if (half == 0) { row_tiles(std::integral_constant<int, 0>{}); row_tiles(std::integral_constant<int, 3>{}); }
        else           { row_tiles(std::integral_constant<int, 1>{}); row_tiles(std::integral_constant<int, 2>{}); }
    }
    __syncthreads();
    f32x4 acc[4];
    if (w < 4) {
#pragma unroll
        for (int mt = 0; mt < 4; ++mt)
#pragma unroll
            for (int r = 0; r < 4; ++r) acc[mt][r] = bf2f((unsigned)*((const LAS bf16_t*)(lds + L_PT) + (16 * mt + 4 * q + r) * RP + 16 * w + li));
    } else {
        const int vs = w - 4;
        const bf16x8 b0 = ldfrag(lds, L_VT, 16 * vs + li, 8 * q), b1 = ldfrag(lds, L_VT, 16 * vs + li, 32 + 8 * q);
#pragma unroll
        for (int mt = 0; mt < 4; ++mt) { acc[mt] = (f32x4){0.f, 0.f, 0.f, 0.f};
            acc[mt] = MFMA16(ldfrag(lds, L_NAPK, 16 * mt + li, 8 * q), b0, acc[mt]); acc[mt] = MFMA16(ldfrag(lds, L_NAPK, 16 * mt + li, 32 + 8 * q), b1, acc[mt]); }
    }
    if (w == 0) {
        const int blk = q, c = li; float T[16];
#pragma unroll
        for (int r = 0; r < 16; ++r) { float tv = (r == c) ? 1.f : 0.f; const LAS f32x4* rowp = (const LAS f32x4*)(AII + (blk * 16 + r) * 16);
#pragma unroll
            for (int s4 = 0; s4 < 4; ++s4) { if (4 * s4 < r) { const f32x4 av = rowp[s4];
#pragma unroll
                for (int e = 0; e < 4; ++e) if (4 * s4 + e < r) tv -= av[e] * T[4 * s4 + e]; } }
            T[r] = tv; *((LAS bf16_t*)(lds + L_TII) + (blk * 16 + r) * 20 + c) = (bf16_t)f2bf(tv); }
    }
    __syncthreads();
    {
        const f32x4 z4 = (f32x4){0.f, 0.f, 0.f, 0.f};
        f32x4 X0, X1, X2, X3;
        X0 = MFMA16(ldfrag_lo(lds, L_TII, 20, li, 4 * q), mkfrag_lo(acc[0]), z4);
        acc[1] = MFMA16(ldfrag2(lds, L_NAPB, RP, 16 + li, 4 * q, 16 + 4 * q), mkfrag_lo(X0), acc[1]);
        X1 = MFMA16(ldfrag_lo(lds, L_TII, 20, 16 + li, 4 * q), mkfrag_lo(acc[1]), z4);
        const bf16x8 x01 = mkfrag(X0, X1);
        acc[2] = MFMA16(ldfrag2(lds, L_NAPB, RP, 32 + li, 4 * q, 16 + 4 * q), x01, acc[2]);
        X2 = MFMA16(ldfrag_lo(lds, L_TII, 20, 32 + li, 4 * q), mkfrag_lo(acc[2]), z4);
        acc[3] = MFMA16(ldfrag2(lds, L_NAPB, RP, 48 + li, 4 * q, 16 + 4 * q), x01, acc[3]);
        acc[3] = MFMA16(ldfrag2(lds, L_NAPB, RP, 48 + li, 32 + 4 * q, 48 + 4 * q), mkfrag_lo(X2), acc[3]);
        X3 = MFMA16(ldfrag_lo(lds, L_TII, 20, 48 + li, 4 * q), mkfrag_lo(acc[3]), z4);
        const int ob = (w < 4 ? L_WMT : L_U0T) + ((16 * (w & 3) + li) * RP + 4 * q) * 2;
        *(LAS u32x2*)(lds + ob) = (u32x2){pg8::cvt_pk_bf16(X0[0], X0[1]), pg8::cvt_pk_bf16(X0[2], X0[3])};
        *(LAS u32x2*)(lds + ob + 32) = (u32x2){pg8::cvt_pk_bf16(X1[0], X1[1]), pg8::cvt_pk_bf16(X1[2], X1[3])};
        *(LAS u32x2*)(lds + ob + 64) = (u32x2){pg8::cvt_pk_bf16(X2[0], X2[1]), pg8::cvt_pk_bf16(X2[2], X2[3])};
        *(LAS u32x2*)(lds + ob + 96) = (u32x2){pg8::cvt_pk_bf16(X3[0], X3[1]), pg8::cvt_pk_bf16(X3[2], X3[3])};
    }
    __syncthreads();
    {
        const int outp = w >> 1, half = w & 1;
        u32x2 keep[4];
#pragma unroll
        for (int mm = 0; mm < 2; ++mm) { const int mt = 2 * half + mm;
            if (outp == 0 || outp == 2) {
                const int rb = outp == 0 ? L_BT : L_ARB;
                const bf16x8 b0 = ldfrag(lds, rb, 16 * mt + li, 8 * q), b1 = ldfrag(lds, rb, 16 * mt + li, 32 + 8 * q);
                bf16_t* dst = (bf16_t*)(a.ws + (outp == 0 ? WS_R_GP : WS_R_RP)) + (size_t)uid * 4096 + (16 * mt + li) * 64;
#pragma unroll
                for (int g = 0; g < 2; ++g) { f32x4 d[2];
#pragma unroll
                    for (int e = 0; e < 2; ++e) { const int nt = 2 * g + e; f32x4 c4 = (f32x4){0.f, 0.f, 0.f, 0.f};
                        c4 = MFMA16(ldfrag(lds, L_WMT, 16 * nt + li, 8 * q), b0, c4); c4 = MFMA16(ldfrag(lds, L_WMT, 16 * nt + li, 32 + 8 * q), b1, c4);
                        if (outp == 2) { const u32x2 rw = *(const LAS u32x2*)(lds + L_RT + ((16 * mt + li) * RP + 16 * nt + 4 * q) * 2);
                            d[e] = (f32x4){bf2f(rw.x & 0xffffu) - c4[0], __uint_as_float(rw.x & 0xffff0000u) - c4[1], bf2f(rw.y & 0xffffu) - c4[2], __uint_as_float(rw.y & 0xffff0000u) - c4[3]}; }
                        else d[e] = -c4; }
                    const u32x4 wv = (u32x4){pg8::cvt_pk_bf16(d[0][0], d[0][1]), pg8::cvt_pk_bf16(d[0][2], d[0][3]), pg8::cvt_pk_bf16(d[1][0], d[1][1]), pg8::cvt_pk_bf16(d[1][2], d[1][3])};
                    *(u32x4*)(dst + 32 * g + 8 * q) = wv; }
            } else {
                const int ab0 = outp == 1 ? L_BT : L_ARB, ab1 = outp == 1 ? L_KT : L_ARK;
                const bf16x8 a00 = ldfrag(lds, ab0, 16 * mt + li, 8 * q), a01 = ldfrag(lds, ab0, 16 * mt + li, 32 + 8 * q), a10 = ldfrag(lds, ab1, 16 * mt + li, 8 * q), a11 = ldfrag(lds, ab1, 16 * mt + li, 32 + 8 * q);
                u32x4* dst = (u32x4*)(a.ws + (outp == 1 ? WS_R_HADD : WS_R_Y0)) + (size_t)uid * 512;
#pragma unroll
                for (int nt = 0; nt < 4; ++nt) { f32x4 c4 = (f32x4){0.f, 0.f, 0.f, 0.f};
                    if (outp == 1) { c4 = MFMA16(a00, ldfrag(lds, L_U0T, 16 * nt + li, 8 * q), c4); c4 = MFMA16(a01, ldfrag(lds, L_U0T, 16 * nt + li, 32 + 8 * q), c4);
                                     c4 = MFMA16(a10, ldfrag(lds, L_VT, 16 * nt + li, 8 * q), c4); c4 = MFMA16(a11, ldfrag(lds, L_VT, 16 * nt + li, 32 + 8 * q), c4); }
                    else {
                                     c4 = MFMA16(ldfrag(lds, L_U0T, 16 * nt + li, 8 * q), a00, c4); c4 = MFMA16(ldfrag(lds, L_U0T, 16 * nt + li, 32 + 8 * q), a01, c4);
                                     c4 = MFMA16(ldfrag(lds, L_VT, 16 * nt + li, 8 * q), a10, c4); c4 = MFMA16(ldfrag(lds, L_VT, 16 * nt + li, 32 + 8 * q), a11, c4); }
                    const u32x2 rv = (u32x2){pg8::cvt_pk_bf16(c4[0], c4[1]), pg8::cvt_pk_bf16(c4[2], c4[3])};
                    if (mm == 0) keep[nt] = rv; else dst[(nt * 2 + half) * 64 + C.lane] = (u32x4){keep[nt].x, keep[nt].y, rv.x, rv.y}; }
            } }
        { const int nt = w >> 1; u32x4* bvf = (u32x4*)((unsigned char*)a.out + OUT_R_BVF) + (size_t)uid * 512;
          const u32x2 b0 = *(const LAS u32x2*)(lds + L_BV + ((16 * (2 * (w & 1)) + li) * RP + 16 * nt + 4 * q) * 2), b1 = *(const LAS u32x2*)(lds + L_BV + ((16 * (2 * (w & 1) + 1) + li) * RP + 16 * nt + 4 * q) * 2);
          bvf[(nt * 2 + (w & 1)) * 64 + C.lane] = (u32x4){b0.x, b0.y, b1.x, b1.y}; }
    }
    __syncthreads();
}
#ifndef WGM_IN
#define WGM_IN 4
#endif
#ifndef WGM_UP
#define WGM_UP 4
#endif
#ifndef WGM_N4
#define WGM_N4 2
#endif
#ifndef R2_SPLIT
#define R2_SPLIT 2
#endif
#ifndef R2_AUX
#define R2_AUX 0
#endif
#ifndef R2_HELP
#define R2_HELP 1
#endif
static_assert(!R2_HELP || R2_SPLIT == 2, "helper waves: 2 idle waves, 4 KiB of H_add per chunk");
constexpr int R2_NSB = 32 * R2_SPLIT, R2_NCW = 4 / R2_SPLIT, R2_NH = 2 * R2_NCW, R2_NHD = R2_HELP ? 0 : R2_NH, R2_NJ = 16 + R2_NHD + 1, R2_KMAX = (R2_NJ + 3) / 4;
constexpr int R2_OG = 0, R2_OR = 8192, R2_OC = 16384, R2_SLOT = R2_OC + 256;
constexpr int R2_HSZ = R2_NH * 1024, R2_NHS = 3;
constexpr int R2_NSLOT = (LDS_BYTES - 64 - R2_NHS * R2_HSZ) / R2_SLOT < 8 ? (LDS_BYTES - 64 - R2_NHS * R2_HSZ) / R2_SLOT : 8;
constexpr int R2_HR = R2_NSLOT * R2_SLOT;
static_assert(R2_HELP == 1, "the H_add ring is filled by the helper waves");
static_assert(R2_NSLOT >= 3 && (R2_NSLOT - 2) * R2_KMAX <= 63, "R2 ring");
__device__ __forceinline__ void rwkv_scan(const Ctx& C, CArgs& a) {
    if (C.bid >= R2_NSB) return;
    const int h = C.bid & 7, rest_ = C.bid >> 3, part = rest_ % R2_SPLIT, b = rest_ / R2_SPLIT, q = C.lane >> 4, li = C.lane & 15, w = C.wave;
    LAS unsigned char* lds = C.lds;
    unsigned char* ws = a.ws;
    if (w >= 4) {
        const int lw = w - 4;
        const unsigned char* src[R2_KMAX]; unsigned ustr[R2_KMAX]; unsigned ldo[R2_KMAX]; bool act[R2_KMAX];
        const bool full = (R2_NJ % 4 == 0) || lw < (R2_NJ % 4);
#pragma unroll
        for (int k = 0; k < R2_KMAX; ++k) { const int j = lw + 4 * k;
            if (j < 16) { const int isR = j >= 8, jj = j - 8 * isR, p = 64 * jj + C.lane, row = p >> 3, c16 = (p & 7) ^ ((row >> 1) & 7);
                src[k] = ws + (isR ? WS_R_RP : WS_R_GP) + row * 128 + c16 * 16; ustr[k] = 8192u; ldo[k] = (unsigned)((isR ? R2_OR : R2_OG) + jj * 1024); act[k] = true; }
            else { src[k] = (const unsigned char*)a.out + OUT_R_GC + (C.lane & 15) * 16; ustr[k] = 256u; ldo[k] = (unsigned)R2_OC; act[k] = (C.lane < 16) && (j < R2_NJ); } }
#define R2_ISSUE(n_, slot_) do { const size_t uid_ = ((size_t)b << 10) | ((size_t)(n_) << 3) | (size_t)h; \
        _Pragma("unroll") for (int k = 0; k < R2_KMAX; ++k) { if (act[k]) __builtin_amdgcn_global_load_lds((const unsigned*)(src[k] + uid_ * ustr[k]), (LAS unsigned*)(lds + (slot_) * R2_SLOT + ldo[k]), 16, 0, R2_AUX); } } while (0)
#pragma unroll
        for (int i = 0; i < R2_NSLOT - 1; ++i) R2_ISSUE(i, i);
        int slot = R2_NSLOT - 1;
#pragma unroll 1
        for (int n = 0; n < 128; ++n) {
            if (full) asm volatile("s_waitcnt vmcnt(%0)" :: "n"((R2_NSLOT - 2) * R2_KMAX) : "memory");
            else asm volatile("s_waitcnt vmcnt(%0)" :: "n"((R2_NSLOT - 2) * (R2_KMAX - 1)) : "memory");
            __builtin_amdgcn_s_barrier();
            const int nn = n + R2_NSLOT - 1 < 128 ? n + R2_NSLOT - 1 : 127;
            R2_ISSUE(nn, slot);
            slot = slot + 1 == R2_NSLOT ? 0 : slot + 1;
        }
        asm volatile("s_waitcnt vmcnt(0)" ::: "memory");
#undef R2_ISSUE
        return;
    }
    if (w >= R2_NCW) {
#if R2_HELP
        const int hl = (w - R2_NCW) * 64 + C.lane;
        const unsigned char* hsrc = ws + WS_R_HADD + (size_t)(R2_NH * part) * 1024 + hl * 16;
        u32x4 hq[4][2];
#define R2_HLOAD(d_, n_) do { const size_t uid_ = ((size_t)b << 10) | ((size_t)((n_) < 128 ? (n_) : 127) << 3) | (size_t)h; \
        hq[d_][0] = __builtin_nontemporal_load((const u32x4*)(hsrc + uid_ * 8192)); hq[d_][1] = __builtin_nontemporal_load((const u32x4*)(hsrc + uid_ * 8192 + 2048)); } while (0)
#define R2_HPUT(d_, slot_) do { LAS unsigned char* hd_ = lds + R2_HR + (slot_) * R2_HSZ + hl * 16; *(LAS u32x4*)(hd_) = hq[d_][0]; *(LAS u32x4*)(hd_ + 2048) = hq[d_][1]; } while (0)
#pragma unroll
        for (int d = 0; d < 4; ++d) R2_HLOAD(d, d);
        R2_HPUT(0, 0); R2_HLOAD(0, 4);
        int wslot = 1;
#pragma unroll 1
        for (int n0 = 0; n0 < 128; n0 += 4) {
#pragma unroll
            for (int r = 0; r < 4; ++r) { const int n = n0 + r;
                asm volatile("s_waitcnt lgkmcnt(0)" ::: "memory");
                __builtin_amdgcn_s_barrier();
                if (n + 1 < 128) R2_HPUT((r + 1) & 3, wslot);
                R2_HLOAD((r + 1) & 3, n + 5);
                wslot = wslot + 1 == R2_NHS ? 0 : wslot + 1; }
        }
#undef R2_HLOAD
#undef R2_HPUT
        return;
#else
#pragma unroll 1
        for (int n = 0; n < 128; ++n) __builtin_amdgcn_s_barrier();
        return;
#endif
    }
    const int s = part * R2_NCW + w;
    u32x4* YF = (u32x4*)((unsigned char*)a.out + OUT_R_Y);
    u32x2 ykeep = (u32x2){0u, 0u};
    f32x4 H[4];
#pragma unroll
    for (int mt = 0; mt < 4; ++mt) H[mt] = (f32x4){0.f, 0.f, 0.f, 0.f};
    int cslot = 0, hslot = 0;
#pragma unroll 1
    for (int n = 0; n < 128; ++n) {
        __builtin_amdgcn_s_barrier();
        asm volatile("" ::: "memory");
        LAS unsigned char* sl = lds + cslot * R2_SLOT; cslot = cslot + 1 == R2_NSLOT ? 0 : cslot + 1;
        LAS unsigned char* hsl = lds + R2_HR + hslot * R2_HSZ; hslot = hslot + 1 == R2_NHS ? 0 : hslot + 1;
        const bf16x8 hb0 = mkfrag(H[0], H[1]), hb1 = mkfrag(H[2], H[3]);
        const size_t uid = ((size_t)b << 10) | ((size_t)n << 3) | (size_t)h;
#pragma unroll
        for (int mt = 0; mt < 4; ++mt) {
            const int x0 = (q ^ (li >> 1)) * 16, x1 = ((4 + q) ^ (li >> 1)) * 16;
            const bf16x8 g0 = *(const LAS bf16x8*)(sl + R2_OG + (16 * mt + li) * 128 + x0), g1 = *(const LAS bf16x8*)(sl + R2_OG + (16 * mt + li) * 128 + x1);
            const bf16x8 r0 = *(const LAS bf16x8*)(sl + R2_OR + (16 * mt + li) * 128 + x0), r1 = *(const LAS bf16x8*)(sl + R2_OR + (16 * mt + li) * 128 + x1);
            const u32x2 ha = *(const LAS u32x2*)(hsl + ((w * 2 + (mt >> 1)) * 64 + C.lane) * 16 + (mt & 1) * 8);
            const f32x4 gc = *(const LAS f32x4*)(sl + R2_OC + (16 * mt + 4 * q) * 4);
            f32x4 hn = gc * H[mt] + (f32x4){bf2f(ha.x & 0xffffu), __uint_as_float(ha.x & 0xffff0000u), bf2f(ha.y & 0xffffu), __uint_as_float(ha.y & 0xffff0000u)};
            hn = MFMA16(g0, hb0, hn); hn = MFMA16(g1, hb1, hn);
            f32x4 yv = (f32x4){0.f, 0.f, 0.f, 0.f};
            yv = MFMA16(hb0, r0, yv); yv = MFMA16(hb1, r1, yv);
            { const u32x2 yw = (u32x2){pg8::cvt_pk_bf16(yv[0], yv[1]), pg8::cvt_pk_bf16(yv[2], yv[3])};
              if ((mt & 1) == 0) ykeep = yw; else YF[uid * 512 + (s * 2 + (mt >> 1)) * 64 + C.lane] = (u32x4){ykeep.x, ykeep.y, yw.x, yw.y}; }
            H[mt] = hn; }
        asm volatile("s_waitcnt lgkmcnt(0)" ::: "memory");
    }
}
__device__ __forceinline__ void rwkv_post_phase(const Ctx& C, CArgs& a) {
    LAS unsigned char* lds = C.lds; const int h = C.wave, q = C.lane >> 4, li = C.lane & 15;
    const bf16_t* P = (const bf16_t*)(a.ws + WS_P); const float* mu = a.in[I_RWKV_MU];
    LAS bf16_t* XR = (LAS bf16_t*)lds;
    LAS bf16_t* XGB = (LAS bf16_t*)(lds + 65 * 96 * 2);
    bf16x8 gf[4][3];
#pragma unroll
    for (int nt = 0; nt < 4; ++nt)
#pragma unroll
        for (int ks = 0; ks < 3; ++ks) gf[nt][ks] = *(const bf16x8*)((const bf16_t*)(a.ws + WS_TAB + TAB_G2TB) + (size_t)(h * 64 + 16 * nt + li) * 96 + 32 * ks + 8 * q);
    f32x4 gg[4], gb[4];
#pragma unroll
    for (int nt = 0; nt < 4; ++nt) { gg[nt] = *(const f32x4*)(a.in[I_RWKV_GN_G] + h * 64 + 16 * nt + 4 * q); gb[nt] = *(const f32x4*)(a.in[I_RWKV_GN_B] + h * 64 + 16 * nt + 4 * q); }
    const u32x4* YF = (const u32x4*)((const unsigned char*)a.out + OUT_R_Y); const u32x4* BVF = (const u32x4*)((const unsigned char*)a.out + OUT_R_BVF); bf16_t* MIX = (bf16_t*)(a.ws + WS_MIX);
#pragma unroll 1
    for (int u = C.bid; u < 512; u += C.nblk) {
        const size_t m0 = (size_t)u * 64; const bool seq0 = (m0 & (SEQ - 1)) == 0;
        const size_t uid = ((size_t)(u >> 7) << 10) | ((size_t)(u & 127) << 3) | (size_t)h;
        for (int i = C.tid; i < 65 * 12; i += NTHREADS) { const int j = i / 12, c8 = i % 12; u32x4 v = (u32x4){0u, 0u, 0u, 0u}; if (j > 0 || !seq0) v = *(const u32x4*)(P + (m0 - 1 + j) * NP + OC_XG + 8 * c8); *(LAS u32x4*)(XR + j * 96 + 8 * c8) = v; }
        u32x2 yf[4][4], y0f[4][4], bf[4][4]; const u32x4* Y0F = (const u32x4*)(a.ws + WS_R_Y0);
#pragma unroll
        for (int mp = 0; mp < 2; ++mp)
#pragma unroll
            for (int nt = 0; nt < 4; ++nt) { const size_t fi = uid * 512 + (nt * 2 + mp) * 64 + C.lane; const u32x4 ya = __builtin_nontemporal_load(YF + fi), yb = __builtin_nontemporal_load(Y0F + fi), bb = __builtin_nontemporal_load(BVF + fi);
                yf[2 * mp][nt] = (u32x2){ya.x, ya.y}; yf[2 * mp + 1][nt] = (u32x2){ya.z, ya.w}; y0f[2 * mp][nt] = (u32x2){yb.x, yb.y}; y0f[2 * mp + 1][nt] = (u32x2){yb.z, yb.w};
                bf[2 * mp][nt] = (u32x2){bb.x, bb.y}; bf[2 * mp + 1][nt] = (u32x2){bb.z, bb.w}; }
        __syncthreads();
        for (int i = C.tid; i < 64 * 96; i += NTHREADS) { const int t = i / 96, j = i % 96; const float cur = bf2f((unsigned)XR[(t + 1) * 96 + j]), prev = bf2f((unsigned)XR[t * 96 + j]);
            XGB[t * 104 + j] = (bf16_t)f2bf(fsigmoid(cur + (prev - cur) * mu[1600 + j])); }
        __syncthreads();
#pragma unroll
        for (int mt = 0; mt < 4; ++mt) {
            bf16x8 xf[3];
#pragma unroll
            for (int ks = 0; ks < 3; ++ks) xf[ks] = *(const LAS bf16x8*)(XGB + (16 * mt + li) * 104 + 32 * ks + 8 * q);
            f32x4 g[4], y[4]; float sm = 0.f;
#pragma unroll
            for (int nt = 0; nt < 4; ++nt) { f32x4 c4 = (f32x4){0.f, 0.f, 0.f, 0.f};
#pragma unroll
                for (int ks = 0; ks < 3; ++ks) c4 = MFMA16(gf[nt][ks], xf[ks], c4);
                g[nt] = c4;
                const u32x2 yw = yf[mt][nt], y0w = y0f[mt][nt];
                y[nt] = (f32x4){bf2f(yw.x & 0xffffu) + bf2f(y0w.x & 0xffffu), __uint_as_float(yw.x & 0xffff0000u) + __uint_as_float(y0w.x & 0xffff0000u), bf2f(yw.y & 0xffffu) + bf2f(y0w.y & 0xffffu), __uint_as_float(yw.y & 0xffff0000u) + __uint_as_float(y0w.y & 0xffff0000u)};
                sm += (y[nt][0] + y[nt][1]) + (y[nt][2] + y[nt][3]); }
            { auto p1 = __builtin_amdgcn_permlane16_swap(__float_as_uint(sm), __float_as_uint(sm), false, false); sm = __uint_as_float(p1[0]) + __uint_as_float(p1[1]);
              auto p2 = __builtin_amdgcn_permlane32_swap(__float_as_uint(sm), __float_as_uint(sm), false, false); sm = __uint_as_float(p2[0]) + __uint_as_float(p2[1]); }
            const float mean = sm * (1.0f / 64.0f); float sq = 0.f;
#pragma unroll
            for (int nt = 0; nt < 4; ++nt) { y[nt] = y[nt] - mean; sq += (y[nt][0] * y[nt][0] + y[nt][1] * y[nt][1]) + (y[nt][2] * y[nt][2] + y[nt][3] * y[nt][3]); }
            { auto p1 = __builtin_amdgcn_permlane16_swap(__float_as_uint(sq), __float_as_uint(sq), false, false); sq = __uint_as_float(p1[0]) + __uint_as_float(p1[1]);
              auto p2 = __builtin_amdgcn_permlane32_swap(__float_as_uint(sq), __float_as_uint(sq), false, false); sq = __uint_as_float(p2[0]) + __uint_as_float(p2[1]); }
            const float rstd = 1.0f / sqrtf(sq * (1.0f / 64.0f) + GN_EPS);
            bf16_t* orow = MIX + (m0 + 16 * mt + li) * D + h * 64 + pair_coff(q);
            u32x2 ow[4];
#pragma unroll
            for (int nt = 0; nt < 4; ++nt) { const u32x2 bw = bf[mt][nt]; const f32x4 bv = (f32x4){bf2f(bw.x & 0xffffu), __uint_as_float(bw.x & 0xffff0000u), bf2f(bw.y & 0xffffu), __uint_as_float(bw.y & 0xffff0000u)};
                const f32x4 o = (y[nt] * rstd * gg[nt] + gb[nt] + bv) * g[nt];
                ow[nt] = (u32x2){pg8::cvt_pk_bf16(o[0], o[1]), pg8::cvt_pk_bf16(o[2], o[3])}; }
            *(u32x4*)(orow) = widen_pair(ow[0], ow[1]); *(u32x4*)(orow + 32) = widen_pair(ow[2], ow[3]);
        }
        __syncthreads();
    }
}
__device__ __forceinline__ void final_norm(const Ctx& C, CArgs& a) {
    const int gw = C.bid * NWAVES + C.wave, NGW = C.nblk * NWAVES; const float* ssp = (const float*)(a.ws + WS_SSP); const bf16_t* X = (const bf16_t*)(a.ws + WS_X);
    f32x4 gv[4];
#pragma unroll
    for (int j = 0; j < 4; ++j) gv[j] = *((const f32x4*)a.in[I_NORM_FINAL] + C.lane + 64 * j);
    for (int m = gw; m < M; m += 2 * NGW) { const int m2 = (m + NGW < M) ? m + NGW : m;
        const float rs = pg8::row_rstd(ssp, m), rs2 = pg8::row_rstd(ssp, m2); const u32x2* xr = (const u32x2*)(X + (size_t)m * D) + C.lane; const u32x2* xr2 = (const u32x2*)(X + (size_t)m2 * D) + C.lane;
        u32x2 b1[4], b2[4];
#pragma unroll
        for (int j = 0; j < 4; ++j) { b1[j] = __builtin_nontemporal_load(xr + 64 * j); b2[j] = __builtin_nontemporal_load(xr2 + 64 * j); }
        f32x4* orow = (f32x4*)(a.out + (size_t)m * D) + C.lane; f32x4* orow2 = (f32x4*)(a.out + (size_t)m2 * D) + C.lane;
#pragma unroll
        for (int j = 0; j < 4; ++j) { const f32x4 v = (f32x4){bf2f(b1[j].x & 0xffffu), __uint_as_float(b1[j].x & 0xffff0000u), bf2f(b1[j].y & 0xffffu), __uint_as_float(b1[j].y & 0xffff0000u)}; __builtin_nontemporal_store(v * gv[j] * rs, orow + 64 * j); }
        if (m2 != m) {
#pragma unroll
            for (int j = 0; j < 4; ++j) { const f32x4 v = (f32x4){bf2f(b2[j].x & 0xffffu), __uint_as_float(b2[j].x & 0xffff0000u), bf2f(b2[j].y & 0xffffu), __uint_as_float(b2[j].y & 0xffff0000u)}; __builtin_nontemporal_store(v * gv[j] * rs2, orow2 + 64 * j); } } }
}

constexpr int N_PHASES = 16;
__global__ void __launch_bounds__(NTHREADS, 2) fwd_kernel(Args args) {
    extern __shared__ __attribute__((aligned(16))) unsigned char lds_raw[];
    LAS unsigned char* const lds = (LAS unsigned char*)lds_raw;
#if ONE_LAUNCH
    constexpr int lo = 0, hi = N_PHASES;
#else
    const int lo = get_args()->ph_lo, hi = get_args()->ph_hi;
#endif
#if ONE_LAUNCH
    cg::grid_group grid = cg::this_grid();
    volatile LAS unsigned* const bst = (volatile LAS unsigned*)(lds + LDS_BYTES - 64);
    if (threadIdx.x < 16) bst[threadIdx.x] = 0u;
    __syncthreads();
    if (get_args()->ph_lo < 0) grid.sync();
    (void)xcd_barrier_post((unsigned*)(get_args()->ws + WS_CTL), bst);
#define SEAM(k) do { if ((k) + 1 < hi) { XcdBarrier xb_; xb_.bar = (unsigned*)(get_args()->ws + WS_CTL); xb_.x = xb_xcc_id(); xb_.st = (volatile LAS unsigned*)(lds + LDS_BYTES - 64); xcd_barrier(xb_); } } while (0)
#else
#define SEAM(k) do { } while (0)
#endif
#define IN(k) (lo <= (k) && (k) < hi)
    if (PHK(0) && IN(0)) { const Ctx C = mk_ctx(lds); p0_prologue(C, *get_args()); SEAM(0); }
#define LAYER_BODY(layer) { \
        const int pb = 1 + 7 * layer; \
        if (PHK(1) && IN(pb)) { \
            CArgs& A = *get_args(); unsigned char* ws = A.ws; const Ctx C = mk_ctx(lds); \
            pg8::Gemm g{(const bf16_t*)(ws + WS_X), (const bf16_t*)(ws + (layer == 0 ? WS_WIN0 : WS_WIN1)), M, NP, D}; pg8::StaticOrder S; S.init(M, NP, C.nblk, C.bid, WGM_IN); \
            pg8::EpiProj<0> E{(bf16_t*)(ws + WS_P), NP, (const float*)(ws + WS_SSP)}; \
            pg8::gemm_phase<pg8::EpiProj<0>, pg8::StaticOrder, true, true>(C.lds, C.tid, g, S, E); \
            { const int nun = (M / 256) * (NP / 256), extra = nun % C.nblk;        \
              const int nidle = extra ? C.nblk - extra : C.nblk, me = extra ? C.bid - extra : C.bid; \
              if (me >= 0) { const int lo_ = layer == 0 ? I_IN : PER_LAYER + I_IN, hi_ = layer == 0 ? PER_LAYER + I_IN : 2 * PER_LAYER; __syncthreads(); p0_weights(C, A, lo_, hi_, me * NWAVES + C.wave, nidle * NWAVES); } } \
            SEAM(pb); \
        } \
        if (IN(pb + 1)) { \
            CArgs& A = *get_args(); const Ctx C = mk_ctx(lds); \
            if (layer == 0) { if (PHK(2)) { for (int u = C.bid; u < 256; u += C.nblk) { const Ctx Cu = mk_ctx(lds); if (PHK(12)) sgu_unit(Cu, A, u); } for (int gi = C.bid; gi < 256; gi += C.nblk) gla_a_group(lds, A, gi); } } \
            else { if (PHK(3)) { u32x4 pf[5]; PrepK K; int hcur = -1;   \
                for (int u = C.bid + ((4095 - C.bid) / C.nblk) * C.nblk; u >= 0; u -= C.nblk) { const Ctx Cu = mk_ctx(lds); if ((u & 7) != hcur) { hcur = u & 7; prep_load_consts(Cu, A, hcur, K); prep_load_raw(Cu, A, u, K, pf); } const int nu = u - C.nblk; rwkv_prep_unit(Cu, A, u, (nu >= 0 && (nu & 7) == hcur) ? nu : -1, K, pf); } } } \
            SEAM(pb + 1); \
        } \
        if (IN(pb + 2)) { \
            CArgs& A = *get_args(); const Ctx C = mk_ctx(lds); \
            if (layer == 0) { } else { if (PHK(5)) { if (C.bid < R2_NSB || C.nblk <= R2_NSB) rwkv_scan(C, A); if (C.bid >= R2_NSB || C.nblk <= R2_NSB) { const int nb = C.nblk > R2_NSB ? C.nblk - R2_NSB : C.nblk; if (C.nblk - R2_NSB == 192) {   \
                    for (int u = C.bid - R2_NSB; u < 384; u += 192) { const Ctx Cu = mk_ctx(lds); const int b_ = u / 96, u96 = u % 96, tri = u96 / 3, r_ = u96 % 3; \
                        for (int rr = 0; rr < REP_CONV; ++rr) conv_unit(Cu, A, b_, tri * 256 + (r_ == 0 ? 0 : r_ == 1 ? 86 : 171), r_ == 0 ? 86 : 85); } } \
                else for (int u = (C.nblk > R2_NSB ? C.bid - R2_NSB : C.bid); u < 512; u += nb) { const Ctx Cu = mk_ctx(lds); conv_unit(Cu, A, u >> 7, (u & 127) * 64, 64); } } } } \
            if (layer == 1) SEAM(pb + 2); \
        } \
        if (IN(pb + 3)) { \
            CArgs& A = *get_args(); const Ctx C = mk_ctx(lds); \
            if (layer == 0) { if (PHK(6)) for (int gi = C.bid; gi < 256; gi += C.nblk) gla_c_group(lds, A, gi); } \
            else { if (PHK(7)) rwkv_post_phase(C, A); } \
            SEAM(pb + 3); \
        } \
        if (PHK(8) && IN(pb + 4)) { \
            CArgs& A = *get_args(); unsigned char* ws = A.ws; const Ctx C = mk_ctx(lds); \
            pg8::Gemm g{(const bf16_t*)(ws + WS_MIX), (const bf16_t*)(ws + (layer == 0 ? WS_WOUT0 : WS_WOUT1)), M, D, D}; pg8::StaticOrder S; S.init(M, D, C.nblk, C.bid, WGM_N4); \
            if (layer == 0) { pg8::EpiRes<true> E{A.in[I_X], (bf16_t*)(ws + WS_X), (float*)(ws + WS_SSP)}; pg8::gemm_phase<pg8::EpiRes<true>, pg8::StaticOrder, true, true>(C.lds, C.tid, g, S, E); } \
            else { pg8::EpiRes<false> E{nullptr, (bf16_t*)(ws + WS_X), (float*)(ws + WS_SSP)}; pg8::gemm_phase<pg8::EpiRes<false>, pg8::StaticOrder, true, true>(C.lds, C.tid, g, S, E); } \
            SEAM(pb + 4); \
        } \
        if (PHK(9) && IN(pb + 5)) { \
            CArgs& A = *get_args(); unsigned char* ws = A.ws; const Ctx C = mk_ctx(lds); \
            pg8::Gemm g{(const bf16_t*)(ws + WS_X), (const bf16_t*)(ws + (layer == 0 ? WS_WUP0 : WS_WUP1)), M, FF, D}; pg8::StaticOrder S; S.init(M, FF, C.nblk, C.bid, WGM_UP); \
            pg8::EpiProj<1> E{(bf16_t*)(ws + WS_H), FF, (const float*)(ws + WS_SSP)}; \
            pg8::gemm_phase<pg8::EpiProj<1>, pg8::StaticOrder, true, true>(C.lds, C.tid, g, S, E); \
            SEAM(pb + 5); \
        } \
        if (PHK(10) && IN(pb + 6)) { \
            CArgs& A = *get_args(); unsigned char* ws = A.ws; const Ctx C = mk_ctx(lds); \
            pg8::Gemm g{(const bf16_t*)(ws + WS_H), (const bf16_t*)(ws + (layer == 0 ? WS_WDN0 : WS_WDN1)), M, D, FF}; pg8::StaticOrder S; S.init(M, D, C.nblk, C.bid, WGM_N4); \
            pg8::EpiRes<false> E{nullptr, (bf16_t*)(ws + WS_X), (float*)(ws + WS_SSP)}; pg8::gemm_phase<pg8::EpiRes<false>, pg8::StaticOrder, true, true>(C.lds, C.tid, g, S, E); \
            SEAM(pb + 6); \
        } \
    }
    LAYER_BODY(0)
    LAYER_BODY(1)
#undef LAYER_BODY
    if (PHK(11) && IN(15)) { const Ctx C = mk_ctx(lds); final_norm(C, *get_args()); }
#undef IN
#undef SEAM
}

extern "C" void kernel_launch(void* const* d_in, const int* in_sizes, int n_in, void* d_out, int out_size, void* d_ws, size_t ws_size, hipStream_t stream) {
    static int grid = 0;
    if (grid == 0) {
        if (n_in != 32 || in_sizes[0] != M * D || out_size != M * D || ws_size < WS_END) { fprintf(stderr, "kernel_launch: unexpected shapes (n_in %d, in0 %d, out %d, ws %zu); nothing launched\n", n_in, n_in > 0 ? in_sizes[0] : -1, out_size, ws_size); grid = -1; return; }
        int dev = 0, cus = 0, per_cu = 0;
        if (hipGetDevice(&dev) != hipSuccess || hipDeviceGetAttribute(&cus, hipDeviceAttributeMultiprocessorCount, dev) != hipSuccess) { grid = -1; return; }
        if (hipFuncSetAttribute((const void*)fwd_kernel, hipFuncAttributeMaxDynamicSharedMemorySize, LDS_BYTES) != hipSuccess) { fprintf(stderr, "kernel_launch: hipFuncSetAttribute failed\n"); grid = -1; return; }
        if (hipOccupancyMaxActiveBlocksPerMultiprocessor(&per_cu, (const void*)fwd_kernel, NTHREADS, LDS_BYTES) != hipSuccess || per_cu < 1) { fprintf(stderr, "kernel_launch: occupancy query says %d blocks per CU\n", per_cu); per_cu = 1; }
        (void)hipGetLastError();
        grid = cus;
    }
    if (grid < 0) return;
    Args a{};
    for (int i = 0; i < 32; ++i) a.in[i] = (const float*)d_in[i];
    a.out = (float*)d_out; a.ws = (unsigned char*)d_ws;
#if ONE_LAUNCH
    a.ph_lo = 0; a.ph_hi = N_PHASES;
    if (hipMemsetAsync((char*)d_ws + WS_CTL, 0, 16384, stream) != hipSuccess) { fprintf(stderr, "kernel_launch: hipMemsetAsync failed\n"); return; }
    void* kargs[] = { &a };
    hipError_t e = hipLaunchCooperativeKernel((const void*)fwd_kernel, dim3(grid), dim3(NTHREADS), kargs, LDS_BYTES, stream);
    if (e != hipSuccess) fprintf(stderr, "kernel_launch: cooperative launch failed: %s (grid %d)\n", hipGetErrorString(e), grid);
#else
    for (int ph = 0; ph < N_PHASES; ++ph) {
        a.ph_lo = ph; a.ph_hi = ph + 1;
        hipLaunchKernelGGL(fwd_kernel, dim3(grid), dim3(NTHREADS), LDS_BYTES, stream, a);
        if ((REPEAT_PH >> ph) & 1) hipLaunchKernelGGL(fwd_kernel, dim3(grid), dim3(NTHREADS), LDS_BYTES, stream, a);
    }
#endif
}
```
